# Optimizing an MI355X kernel written in HIP

```python
import math
import jax, jax.numpy as jnp
from jax import lax
import numpy as np

D_MODEL = 1024
BATCH = 4
SEQ = 8192
DEPTH = 2

MEM_LEN = 256
DA_HEADS = 8
DA_HEAD_DIM = 64
DA_V_DIM = 2 * DA_HEAD_DIM
DA_WIDTH = DA_HEADS * DA_V_DIM
QK_WIDTH = DA_HEADS * 2 * DA_HEAD_DIM
LAMBDA_INIT_SCALE = 0.1
CONV_WIDTH = 512
CONV_K = 3
MEM_HEADS = 4
MEM_HEAD_DIM = 128
MEM_WIDTH = MEM_HEADS * MEM_HEAD_DIM
N_BRANCH = 3
ROPE_THETA = 10000.0
Q_BLOCK = 128
N_EXPERTS = 16
N_GROUPS = 4
EXPERTS_PER_GROUP = N_EXPERTS // N_GROUPS
TOP_K = 2
D_FF_EXPERT = 512
EXPERT_BLOCK = 128
LN_EPS = 1e-5
RMS_EPS = 1e-5
DEEPNORM_ALPHA = (2 * DEPTH) ** 0.25
DEEPNORM_BETA = (8 * DEPTH) ** -0.25

IN_SIZES = (QK_WIDTH, QK_WIDTH, DA_WIDTH, CONV_WIDTH, CONV_WIDTH, CONV_WIDTH, MEM_WIDTH, N_BRANCH * D_MODEL)
IN_COLS = sum(IN_SIZES)
IN_SPLITS = tuple(sum(IN_SIZES[:i + 1]) for i in range(len(IN_SIZES) - 1))

kernel_name = 'hybrid_diffattn_shortconv_memxattn_grouped_moe'


def layer_norm(x, g, b):
    x32 = x.astype(jnp.float32)
    mu = jnp.mean(x32, axis=-1, keepdims=True)
    var = jnp.mean(jnp.square(x32 - mu), axis=-1, keepdims=True)
    y = (x32 - mu) * lax.rsqrt(var + LN_EPS) * g.astype(jnp.float32) + b.astype(jnp.float32)
    return y.astype(x.dtype)


def rope(t, cos, sin):
    half = t.shape[-1] // 2
    t1, t2 = t[..., :half], t[..., half:]
    cos = cos.astype(t.dtype)
    sin = sin.astype(t.dtype)
    return jnp.concatenate([t1 * cos - t2 * sin, t2 * cos + t1 * sin], axis=-1)


def diff_attention(q, k, v, lam, lam_init, subln_g):
    B, S = q.shape[0], q.shape[1]
    qh = jnp.transpose(q, (0, 2, 3, 1, 4))
    kh = jnp.transpose(k, (0, 2, 3, 1, 4))
    vh = jnp.transpose(v, (0, 2, 1, 3))
    scale = DA_HEAD_DIM ** -0.5
    outs = []
    for blk in range(S // Q_BLOCK):
        s0 = blk * Q_BLOCK
        end = s0 + Q_BLOCK
        qb = qh[:, :, :, s0:end]
        kb = kh[:, :, :, :end]
        sc = jnp.einsum('bhcqd,bhckd->bhcqk', qb, kb).astype(jnp.float32) * scale
        causal = jnp.arange(end)[None, :] <= (s0 + jnp.arange(Q_BLOCK))[:, None]
        sc = jnp.where(causal, sc, -jnp.inf)
        p = jax.nn.softmax(sc, axis=-1)
        a = p[:, :, 0] - lam * p[:, :, 1]
        outs.append(jnp.einsum('bhqk,bhkd->bhqd', a.astype(v.dtype), vh[:, :, :end]))
    o = jnp.concatenate(outs, axis=2).astype(jnp.float32)
    o = o * lax.rsqrt(jnp.mean(jnp.square(o), axis=-1, keepdims=True) + RMS_EPS)
    o = o * subln_g.astype(jnp.float32) * (1.0 - lam_init)
    o = jnp.transpose(o, (0, 2, 1, 3)).astype(v.dtype)
    return o.reshape(B, S, DA_WIDTH)


def short_gated_conv(bg, cg, u, w):
    z = cg * u
    S = z.shape[1]
    zp = jnp.pad(z, ((0, 0), (CONV_K - 1, 0), (0, 0)))
    y = w[0] * zp[:, 0:S]
    for tap in range(1, CONV_K):
        y = y + w[tap] * zp[:, tap:tap + S]
    return bg * y


def memory_attention(qm, mem, w_kv):
    B, S = qm.shape[0], qm.shape[1]
    M = mem.shape[1]
    kv = mem @ w_kv
    km = kv[..., :MEM_WIDTH].reshape(B, M, MEM_HEADS, MEM_HEAD_DIM)
    vm = kv[..., MEM_WIDTH:].reshape(B, M, MEM_HEADS, MEM_HEAD_DIM)
    q = qm.reshape(B, S, MEM_HEADS, MEM_HEAD_DIM)
    sc = jnp.einsum('bshd,bmhd->bhsm', q, km).astype(jnp.float32) * (MEM_HEAD_DIM ** -0.5)
    p = jax.nn.softmax(sc, axis=-1)
    o = jnp.einsum('bhsm,bmhd->bshd', p.astype(vm.dtype), vm)
    return o.reshape(B, S, MEM_WIDTH)


def grouped_moe(x2d, w_router, router_bias, w_gate, w_up, w_down):
    T, D = x2d.shape
    logits = (x2d @ w_router).astype(jnp.float32) + router_bias.astype(jnp.float32)
    scores = jax.nn.softmax(logits, axis=-1)
    grouped = scores.reshape(T, N_GROUPS, EXPERTS_PER_GROUP)
    g_idx = jnp.argmax(jnp.max(grouped, axis=-1), axis=-1)
    in_group = jnp.take_along_axis(grouped, g_idx[:, None, None], axis=1)[:, 0]
    top_vals, top_idx = lax.top_k(in_group, TOP_K)
    experts = g_idx[:, None] * EXPERTS_PER_GROUP + top_idx
    weights = top_vals / jnp.sum(top_vals, axis=-1, keepdims=True)

    A = T * TOP_K
    e_flat = experts.reshape(A).astype(jnp.int32)
    tok_flat = jnp.repeat(jnp.arange(T, dtype=jnp.int32), TOP_K)
    gate_flat = weights.reshape(A).astype(x2d.dtype)
    order = jnp.argsort(e_flat)
    e_sorted = e_flat[order]
    counts = jnp.zeros((N_EXPERTS,), jnp.int32).at[e_flat].add(1)
    start = jnp.cumsum(counts) - counts
    padded = ((counts + EXPERT_BLOCK - 1) // EXPERT_BLOCK) * EXPERT_BLOCK
    pad_end = jnp.cumsum(padded)
    pad_start = pad_end - padded
    dest = pad_start[e_sorted] + (jnp.arange(A, dtype=jnp.int32) - start[e_sorted])
    P = ((A + EXPERT_BLOCK - 1) // EXPERT_BLOCK) * EXPERT_BLOCK + N_EXPERTS * EXPERT_BLOCK
    n_blocks = P // EXPERT_BLOCK
    buf_tok = jnp.full((P,), T, jnp.int32).at[dest].set(tok_flat[order])
    buf_gate = jnp.zeros((P,), x2d.dtype).at[dest].set(gate_flat[order])
    blk_start = jnp.arange(n_blocks, dtype=jnp.int32) * EXPERT_BLOCK
    blk_expert = jnp.minimum(jnp.searchsorted(pad_end, blk_start, side='right'), N_EXPERTS - 1).astype(jnp.int32)
    x_pad = jnp.concatenate([x2d, jnp.zeros((1, D), x2d.dtype)], axis=0)
    xb = x_pad[buf_tok].reshape(n_blocks, EXPERT_BLOCK, D)

    def expert_block(args):
        xblk, e = args
        h = jax.nn.silu(xblk @ w_gate[e]) * (xblk @ w_up[e])
        return h @ w_down[e]

    yb = lax.map(expert_block, (xb, blk_expert))
    y = yb.reshape(P, D) * buf_gate[:, None]
    return jax.ops.segment_sum(y, buf_tok, num_segments=T + 1)[:T]


def setup_inputs(seed: int = 0) -> dict:
    key = jax.random.key(seed)
    ks = jax.random.split(key, 26)
    f32 = jnp.float32

    def nrm(k, shape, fan_in, scale=1.0):
        return jax.random.normal(k, shape, f32) * (scale * fan_in ** -0.5)

    x = jax.random.normal(ks[0], (BATCH, SEQ, D_MODEL), f32)
    mem = jax.random.normal(ks[1], (BATCH, MEM_LEN, D_MODEL), f32)
    positions = (jax.random.randint(ks[2], (BATCH, 1), 0, 4096, jnp.int32)
                 + jnp.arange(SEQ, dtype=jnp.int32)[None, :])
    col_scale = jnp.concatenate([
        jnp.ones((2 * QK_WIDTH,), f32),
        jnp.full((DA_WIDTH,), DEEPNORM_BETA, f32),
        jnp.ones((IN_COLS - 2 * QK_WIDTH - DA_WIDTH,), f32)])
    w_in = nrm(ks[3], (DEPTH, D_MODEL, IN_COLS), D_MODEL) * col_scale
    lambda_q1 = LAMBDA_INIT_SCALE * jax.random.normal(ks[4], (DEPTH, DA_HEAD_DIM), f32)
    lambda_k1 = LAMBDA_INIT_SCALE * jax.random.normal(ks[5], (DEPTH, DA_HEAD_DIM), f32)
    lambda_q2 = LAMBDA_INIT_SCALE * jax.random.normal(ks[6], (DEPTH, DA_HEAD_DIM), f32)
    lambda_k2 = LAMBDA_INIT_SCALE * jax.random.normal(ks[7], (DEPTH, DA_HEAD_DIM), f32)
    diff_subln_g = 1.0 + 0.02 * jax.random.normal(ks[8], (DEPTH, DA_V_DIM), f32)
    conv_w = nrm(ks[9], (DEPTH, CONV_K, CONV_WIDTH), CONV_K)
    w_mem_kv = nrm(ks[10], (DEPTH, D_MODEL, 2 * MEM_WIDTH), D_MODEL)
    w_br_attn = nrm(ks[11], (DEPTH, DA_WIDTH, D_MODEL), DA_WIDTH, DEEPNORM_BETA)
    w_br_conv = nrm(ks[12], (DEPTH, CONV_WIDTH, D_MODEL), CONV_WIDTH, DEEPNORM_BETA)
    w_br_mem = nrm(ks[13], (DEPTH, MEM_WIDTH, D_MODEL), MEM_WIDTH, DEEPNORM_BETA)
    w_out = nrm(ks[14], (DEPTH, D_MODEL, D_MODEL), D_MODEL, DEEPNORM_BETA)
    ln1_g = 1.0 + 0.02 * jax.random.normal(ks[15], (DEPTH, D_MODEL), f32)
    ln1_b = 0.02 * jax.random.normal(ks[16], (DEPTH, D_MODEL), f32)
    ln2_g = 1.0 + 0.02 * jax.random.normal(ks[17], (DEPTH, D_MODEL), f32)
    ln2_b = 0.02 * jax.random.normal(ks[18], (DEPTH, D_MODEL), f32)
    w_router = nrm(ks[19], (D_MODEL, N_EXPERTS), D_MODEL)
    router_bias = 0.01 * jax.random.normal(ks[20], (N_EXPERTS,), f32)
    w_exp_gate = nrm(ks[21], (DEPTH, N_EXPERTS, D_MODEL, D_FF_EXPERT), D_MODEL, DEEPNORM_BETA)
    w_exp_up = nrm(ks[22], (DEPTH, N_EXPERTS, D_MODEL, D_FF_EXPERT), D_MODEL, DEEPNORM_BETA)
    w_exp_down = nrm(ks[23], (DEPTH, N_EXPERTS, D_FF_EXPERT, D_MODEL), D_FF_EXPERT, DEEPNORM_BETA)
    return {'x': x, 'mem': mem, 'positions': positions, 'w_in': w_in,
            'lambda_q1': lambda_q1, 'lambda_k1': lambda_k1, 'lambda_q2': lambda_q2, 'lambda_k2': lambda_k2,
            'diff_subln_g': diff_subln_g, 'conv_w': conv_w, 'w_mem_kv': w_mem_kv,
            'w_br_attn': w_br_attn, 'w_br_conv': w_br_conv, 'w_br_mem': w_br_mem, 'w_out': w_out,
            'ln1_g': ln1_g, 'ln1_b': ln1_b, 'ln2_g': ln2_g, 'ln2_b': ln2_b,
            'w_router': w_router, 'router_bias': router_bias,
            'w_exp_gate': w_exp_gate, 'w_exp_up': w_exp_up, 'w_exp_down': w_exp_down}


def reference(x, mem, positions, w_in, lambda_q1, lambda_k1, lambda_q2, lambda_k2, diff_subln_g,
              conv_w, w_mem_kv, w_br_attn, w_br_conv, w_br_mem, w_out,
              ln1_g, ln1_b, ln2_g, ln2_b, w_router, router_bias,
              w_exp_gate, w_exp_up, w_exp_down):
    B, S, D = x.shape
    inv_freq = ROPE_THETA ** (-jnp.arange(0, DA_HEAD_DIM, 2, dtype=jnp.float32) / DA_HEAD_DIM)
    ang = positions.astype(jnp.float32)[..., None] * inv_freq
    cos = jnp.cos(ang)[:, :, None, :]
    sin = jnp.sin(ang)[:, :, None, :]

    for l in range(DEPTH):
        lam_init = 0.8 - 0.6 * math.exp(-0.3 * l)
        proj = x @ w_in[l]
        q, k, v, cb, cc, cu, qm, gates = jnp.split(proj, IN_SIZES and IN_SPLITS, axis=-1)

        q = rope(q.reshape(B, S, DA_HEADS * 2, DA_HEAD_DIM), cos, sin).reshape(B, S, DA_HEADS, 2, DA_HEAD_DIM)
        k = rope(k.reshape(B, S, DA_HEADS * 2, DA_HEAD_DIM), cos, sin).reshape(B, S, DA_HEADS, 2, DA_HEAD_DIM)
        v = v.reshape(B, S, DA_HEADS, DA_V_DIM)
        lam = (jnp.exp(jnp.sum(lambda_q1[l].astype(jnp.float32) * lambda_k1[l].astype(jnp.float32)))
               - jnp.exp(jnp.sum(lambda_q2[l].astype(jnp.float32) * lambda_k2[l].astype(jnp.float32)))
               + lam_init)
        y_attn = diff_attention(q, k, v, lam, lam_init, diff_subln_g[l])

        y_conv = short_gated_conv(cb, cc, cu, conv_w[l])

        y_mem = memory_attention(qm, mem, w_mem_kv[l])

        g = jax.nn.sigmoid(gates.reshape(B, S, N_BRANCH, D))
        merged = (g[:, :, 0] * (y_attn @ w_br_attn[l])
                  + g[:, :, 1] * (y_conv @ w_br_conv[l])
                  + g[:, :, 2] * (y_mem @ w_br_mem[l]))
        mix = merged @ w_out[l]
        x = layer_norm(DEEPNORM_ALPHA * x + mix, ln1_g[l], ln1_b[l])

        f = grouped_moe(x.reshape(B * S, D), w_router, router_bias,
                        w_exp_gate[l], w_exp_up[l], w_exp_down[l]).reshape(B, S, D)
        x = layer_norm(DEEPNORM_ALPHA * x + f, ln2_g[l], ln2_b[l])
    return x
```

```cpp
#define MK_PER_PHASE 1
#include <hip/hip_runtime.h>
#include <cstdio>
#include <cstdint>
namespace pg8 {
#define PG8_LAS __attribute__((address_space(3)))
typedef unsigned short bf16_t;
typedef short bf16x8 __attribute__((ext_vector_type(8)));
typedef float f32x4 __attribute__((ext_vector_type(4)));
typedef unsigned u32x4 __attribute__((ext_vector_type(4)));
constexpr int BM = 256, BK = 64, HALF = 128, HTB = HALF * BK * 2  , STAGE_BYTES = 8 * HTB, NXCD = 8, WGM = 8;

__host__ __device__ __forceinline__ int lds_byte(int r, int c) { const int st = (r >> 4) * 2 + (c >> 5), rr = r & 15, cc = c & 31, ob = rr * 64 + cc * 2; return st * 1024 + (ob ^ (((ob >> 9) & 1) << 5)); }
__host__ __device__ __forceinline__ void stage_rc(int b, int& R, int& C) { const int st = b / 1024, sb = b % 1024, swz = sb ^ (((sb >> 9) & 1) << 5); R = (st >> 1) * 16 + swz / 64; C = (st & 1) * 32 + (swz % 64) / 2; }
__host__ __device__ __forceinline__ int perm32(int rho) { const int n = rho >> 4, i = rho & 15; return 8 * (i >> 2) + 4 * n + (i & 3); }

struct Unit { int pm, pn; };
struct Gemm { const bf16_t* A; const bf16_t* Bt; int M, N, K; };

struct StaticOrder {
    int nM, nN, nwg, G, c;
    __host__ __device__ void init(int M, int N, int G_, int c_) { nM = M / BM; nN = N / BM; nwg = nM * nN; G = G_; c = c_; }
    __host__ __device__ bool next(int i, Unit& u) const {
        const long L = (long)i * G + c; if (L >= nwg) return false;
        int wgid = (int)L; { const int q = nwg / NXCD, r = nwg % NXCD, xcd = wgid % NXCD, off = wgid / NXCD; wgid = (xcd < r ? xcd * (q + 1) : r * (q + 1) + (xcd - r) * q) + off; }
        const int nig = WGM * nN, gid = wgid / nig, fm = gid * WGM, gsz = (nM - fm) < WGM ? (nM - fm) : WGM;
        u.pm = fm + ((wgid % nig) % gsz); u.pn = (wgid % nig) / gsz; return true;
    }
    __device__ __forceinline__ void a_ready(const Unit&) const {}
    __device__ __forceinline__ void done(const Unit&) const {}
};

typedef float f32x2c_t __attribute__((ext_vector_type(2))); typedef __bf16 bf16x2c_t __attribute__((ext_vector_type(2)));
__device__ __forceinline__ unsigned cvt_pk_bf16(float lo, float hi) { f32x2c_t v = {lo, hi}; bf16x2c_t b = __builtin_convertvector(v, bf16x2c_t); return __builtin_bit_cast(unsigned, b); }
typedef float f32x2 __attribute__((ext_vector_type(2)));
__device__ __forceinline__ f32x2 gelu_pk(f32x2 v) {
    const f32x2 av = __builtin_elementwise_abs(v), d = av * 0.2316418882f + 1.0f;
    f32x2 t; t.x = __builtin_amdgcn_rcpf(d.x); t.y = __builtin_amdgcn_rcpf(d.y);
    f32x2 q = t * 0.5307027145f + (-0.7265760135f); q = q * t + 0.7107068705f; q = q * t + (-0.142248368f); q = q * t + 0.127414796f; q = q * t;
    const f32x2 s = (v * v) * (-0.72134752044f);
    f32x2 e; e.x = __builtin_amdgcn_exp2f(s.x); e.y = __builtin_amdgcn_exp2f(s.y);
    const f32x2 m = v * (q * e), r = v - m;
    f32x2 o; o.x = v.x < 0.f ? m.x : r.x; o.y = v.y < 0.f ? m.y : r.y; return o;
}

template <int ACT  > struct EpiBf16 {
    static constexpr bool PERM = true, AFTER_DRAIN = false; static_assert(ACT == 0 || ACT == 1, "EpiBf16: ACT is 0 (none) or 1 (gelu_pk)");
    bf16_t* O; int ldc; const float* bias; int split_cols; size_t split_stride; float scale0;
    __device__ __forceinline__ void operator()(const f32x4 (&acc)[2][2][4][2], const Unit& u, int wr, int wc, int fr, int fq) const {
        const int row0 = u.pm * BM + wr * 64 + fr; int colt = u.pn * BM; bf16_t* base = O;
        float sc = 1.f; if (split_cols) { const int t = colt / split_cols; base += (size_t)t * split_stride; colt -= t * split_cols; if (t == 0) sc = scale0; }
        const int col0 = colt + wc * 32 + 8 * fq, bcol0 = u.pn * BM + wc * 32 + 8 * fq;
        f32x4 bv[2][2];
#pragma unroll
        for (int bj = 0; bj < 2; ++bj)
#pragma unroll
            for (int n = 0; n < 2; ++n) bv[bj][n] = bias ? *(const f32x4*)(bias + bcol0 + bj * HALF + 4 * n) : (f32x4){0.f, 0.f, 0.f, 0.f};
#pragma unroll
        for (int ai = 0; ai < 2; ++ai)
#pragma unroll
            for (int m = 0; m < 4; ++m) { bf16_t* rowp = base + (size_t)(row0 + ai * HALF + m * 16) * ldc + col0;
#pragma unroll
                for (int bj = 0; bj < 2; ++bj) { f32x4 v0 = acc[ai][bj][m][0] + bv[bj][0], v1 = acc[ai][bj][m][1] + bv[bj][1];
                    if (ACT == 1) { f32x2 a = gelu_pk((f32x2){v0[0], v0[1]}), b = gelu_pk((f32x2){v0[2], v0[3]}), c = gelu_pk((f32x2){v1[0], v1[1]}), d = gelu_pk((f32x2){v1[2], v1[3]});
                        v0 = (f32x4){a.x, a.y, b.x, b.y}; v1 = (f32x4){c.x, c.y, d.x, d.y}; }
                    v0 = v0 * sc; v1 = v1 * sc; u32x4 w; w.x = cvt_pk_bf16(v0[0], v0[1]); w.y = cvt_pk_bf16(v0[2], v0[3]); w.z = cvt_pk_bf16(v1[0], v1[1]); w.w = cvt_pk_bf16(v1[2], v1[3]);
                    *(u32x4*)(rowp + bj * HALF) = w; } }
    }
};

struct PanelStats {
    unsigned* xbuf;
    unsigned* cnt;
    unsigned* tmo;
    int ntn; float eps;
    unsigned code;
    __device__ __forceinline__ bool run(const f32x4 (&v)[2][2][4][2], const Unit& u, int wr, int wc, int fr, int fq, PG8_LAS unsigned char* lds, int wid, int lane) const {
        typedef float f32x2v __attribute__((ext_vector_type(2)));
        PG8_LAS f32x2v* P = (PG8_LAS f32x2v*)lds;
        PG8_LAS f32x2v* S = (PG8_LAS f32x2v*)(lds + 8192);
        PG8_LAS unsigned* flag = (PG8_LAS unsigned*)(lds + 8192 + 2048);
#pragma unroll
        for (int ai = 0; ai < 2; ++ai)
#pragma unroll
            for (int m = 0; m < 4; ++m) {
                float s = 0.f;
#pragma unroll
                for (int bj = 0; bj < 2; ++bj)
#pragma unroll
                    for (int n = 0; n < 2; ++n) { const f32x4 x = v[ai][bj][m][n]; s += (x[0] + x[1]) + (x[2] + x[3]); }
                s += __shfl_xor(s, 16); s += __shfl_xor(s, 32);
                const float mw = s * (1.0f / 64.0f); float q = 0.f;
#pragma unroll
                for (int bj = 0; bj < 2; ++bj)
#pragma unroll
                    for (int n = 0; n < 2; ++n) { const f32x4 d = v[ai][bj][m][n] - mw; q += (d[0] * d[0] + d[1] * d[1]) + (d[2] * d[2] + d[3] * d[3]); }
                q += __shfl_xor(q, 16); q += __shfl_xor(q, 32);
                if (fq == 0) P[(ai * HALF + wr * 64 + m * 16 + fr) * 4 + wc] = (f32x2v){mw, q};
            }
        asm volatile("s_waitcnt lgkmcnt(0)" ::: "memory"); __builtin_amdgcn_s_barrier(); asm volatile("" ::: "memory");
#if defined(BROKEN_EXCHANGE_NO_WAIT)
#warning BROKEN CONTROL BUILD: the row-statistics exchange does not wait; results are wrong by design
        if (blockIdx.x >= 64) { const long long t0_ = clock64(); while (clock64() - t0_ < 60000) __builtin_amdgcn_s_sleep(8); }
#endif
        const int row = wid * 32 + (lane & 31);
        if (lane < 32) {
            const f32x2v a = P[row * 4 + 0], b = P[row * 4 + 1], c = P[row * 4 + 2], d = P[row * 4 + 3];
            const float mt = (a.x + b.x + c.x + d.x) * 0.25f;
            const float da = a.x - mt, db = b.x - mt, dc = c.x - mt, dd = d.x - mt;
            const float m2 = (a.y + b.y) + (c.y + d.y) + 64.0f * ((da * da + db * db) + (dc * dc + dd * dd));
            unsigned long long* slot = (unsigned long long*)xbuf + ((size_t)(u.pm * BM + row) * 4 + u.pn);
            __hip_atomic_store(slot, ((unsigned long long)__float_as_uint(m2) << 32) | __float_as_uint(mt), __ATOMIC_RELAXED, __HIP_MEMORY_SCOPE_AGENT);
        }
        asm volatile("s_waitcnt vmcnt(0)" ::: "memory");
        if (lane == 0) __hip_atomic_fetch_add(cnt + 64 * u.pm, 1u, __ATOMIC_RELAXED, __HIP_MEMORY_SCOPE_AGENT);
        if (wid == 0) {
            bool dead = false; const unsigned long long t0 = __builtin_amdgcn_s_memrealtime(); const unsigned want = 8u * (unsigned)ntn;
            for (;;) {
#if defined(BROKEN_EXCHANGE_NO_WAIT)
                break;
#endif
                if ((unsigned)__builtin_amdgcn_readfirstlane(__hip_atomic_load(cnt + 64 * u.pm, __ATOMIC_RELAXED, __HIP_MEMORY_SCOPE_AGENT)) >= want) break;
                if (__builtin_amdgcn_s_memrealtime() - t0 > 2000000ull) {
                    if (lane == 0) { unsigned expect = 0u; __hip_atomic_compare_exchange_strong(tmo + 1, &expect, code | (unsigned)(u.pm & 0xff), __ATOMIC_RELAXED, __ATOMIC_RELAXED, __HIP_MEMORY_SCOPE_AGENT);
                                     __hip_atomic_store(tmo, 1u, __ATOMIC_RELAXED, __HIP_MEMORY_SCOPE_AGENT); }
                    dead = true; break; }
                __builtin_amdgcn_s_sleep(2);
            }
            __builtin_amdgcn_fence(__ATOMIC_ACQUIRE, "agent");
            if (lane == 0) flag[0] = dead ? 1u : 0u;
        }
        asm volatile("s_waitcnt vmcnt(0) lgkmcnt(0)" ::: "memory"); __builtin_amdgcn_s_barrier(); asm volatile("" ::: "memory");
        const bool bad = flag[0] != 0u;
        if (lane < 32) {
            const unsigned long long* slot = (const unsigned long long*)xbuf + (size_t)(u.pm * BM + row) * 4; float mt[4], m2[4]; float ms = 0.f;
#pragma unroll
            for (int t = 0; t < 4; ++t) { if (t < ntn) { const unsigned long long w = __hip_atomic_load(slot + t, __ATOMIC_RELAXED, __HIP_MEMORY_SCOPE_AGENT); mt[t] = __uint_as_float((unsigned)w); m2[t] = __uint_as_float((unsigned)(w >> 32)); } else { mt[t] = 0.f; m2[t] = 0.f; } ms += mt[t]; }
            const float mean = ms / (float)ntn; float q = 0.f;
#pragma unroll
            for (int t = 0; t < 4; ++t) if (t < ntn) { const float dm = mt[t] - mean; q += m2[t] + 256.0f * dm * dm; }
            S[row] = (f32x2v){mean, 1.0f / sqrtf(q / (256.0f * (float)ntn) + eps)};
        }
        asm volatile("s_waitcnt lgkmcnt(0)" ::: "memory"); __builtin_amdgcn_s_barrier(); asm volatile("" ::: "memory");
        return bad;
    }
};
struct EpiLnRes {
    static constexpr bool PERM = false, AFTER_DRAIN = true;
    const float* base; float* out; int ldc; const float* bias; PanelStats st; unsigned poison;
    __device__ __forceinline__ void fused(f32x4 (&acc)[2][2][4][2], const Unit& u, int wr, int wc, int fr, int fq, PG8_LAS unsigned char* lds, int wid, int lane) const {
        typedef float f32x2v __attribute__((ext_vector_type(2)));
        const PG8_LAS f32x2v* S = (const PG8_LAS f32x2v*)(lds + 8192);
        const int col0 = u.pn * BM + wc * 32 + 4 * fq;
#pragma unroll
        for (int bj = 0; bj < 2; ++bj)
#pragma unroll
            for (int n = 0; n < 2; ++n) { const f32x4 bv = bias ? *(const f32x4*)(bias + col0 + bj * HALF + n * 16) : (f32x4){0.f, 0.f, 0.f, 0.f};
#pragma unroll
                for (int ai = 0; ai < 2; ++ai)
#pragma unroll
                    for (int m = 0; m < 4; ++m) acc[ai][bj][m][n] += bv; }
        f32x4 pre[4][2][2];
#pragma unroll
        for (int m = 0; m < 4; ++m) { const size_t off = (size_t)(u.pm * BM + wr * 64 + m * 16 + fr) * ldc + col0;
#pragma unroll
            for (int bj = 0; bj < 2; ++bj)
#pragma unroll
                for (int n = 0; n < 2; ++n) pre[m][bj][n] = *(const f32x4*)(base + off + bj * HALF + n * 16); }
        const bool bad = st.run(acc, u, wr, wc, fr, fq, lds, wid, lane) || poison != 0u;
        const float qnan = __builtin_nanf("");
#pragma unroll
        for (int ai = 0; ai < 2; ++ai)
#pragma unroll
            for (int m = 0; m < 4; ++m) { const int r = ai * HALF + wr * 64 + m * 16 + fr; const f32x2v sr = S[r]; const size_t off = (size_t)(u.pm * BM + r) * ldc + col0;
#pragma unroll
                for (int bj = 0; bj < 2; ++bj)
#pragma unroll
                    for (int n = 0; n < 2; ++n) { const f32x4 bs = ai == 0 ? pre[m][bj][n] : *(const f32x4*)(base + off + bj * HALF + n * 16); f32x4 o = bs + (acc[ai][bj][m][n] - sr.x) * sr.y;
                        if (bad) o = (f32x4){qnan, qnan, qnan, qnan}; *(f32x4*)(out + off + bj * HALF + n * 16) = o; }
                if (m & 1) asm volatile("" ::: "memory"); }
    }
};
struct EpiLnResLn {
    static constexpr bool PERM = false, AFTER_DRAIN = true;
    const float* base; float* out; bf16_t* xn; int ldc; const float* bias; PanelStats st1, st2; unsigned poison;
    __device__ __forceinline__ void fused(f32x4 (&acc)[2][2][4][2], const Unit& u, int wr, int wc, int fr, int fq, PG8_LAS unsigned char* lds, int wid, int lane) const {
        typedef float f32x2v __attribute__((ext_vector_type(2))); typedef unsigned u32x2v __attribute__((ext_vector_type(2)));
        const PG8_LAS f32x2v* S = (const PG8_LAS f32x2v*)(lds + 8192);
        const int col0 = u.pn * BM + wc * 32 + 4 * fq;
#pragma unroll
        for (int bj = 0; bj < 2; ++bj)
#pragma unroll
            for (int n = 0; n < 2; ++n) { const f32x4 bv = bias ? *(const f32x4*)(bias + col0 + bj * HALF + n * 16) : (f32x4){0.f, 0.f, 0.f, 0.f};
#pragma unroll
                for (int ai = 0; ai < 2; ++ai)
#pragma unroll
                    for (int m = 0; m < 4; ++m) acc[ai][bj][m][n] += bv; }
        bool bad = st1.run(acc, u, wr, wc, fr, fq, lds, wid, lane) || poison != 0u;
        const float qnan = __builtin_nanf("");
#pragma unroll
        for (int ai = 0; ai < 2; ++ai)
#pragma unroll
            for (int m = 0; m < 4; ++m) { const int r = ai * HALF + wr * 64 + m * 16 + fr; const f32x2v sr = S[r]; const size_t off = (size_t)(u.pm * BM + r) * ldc + col0;
#pragma unroll
                for (int bj = 0; bj < 2; ++bj)
#pragma unroll
                    for (int n = 0; n < 2; ++n) { const f32x4 bs = *(const f32x4*)(base + off + bj * HALF + n * 16); acc[ai][bj][m][n] = bs + (acc[ai][bj][m][n] - sr.x) * sr.y; }
                asm volatile("" : "+v"(acc[ai][0][m][0]), "+v"(acc[ai][0][m][1]), "+v"(acc[ai][1][m][0]), "+v"(acc[ai][1][m][1]));
                if (m & 1) asm volatile("" ::: "memory"); }
        const bool bad1 = bad;
        bad = st2.run(acc, u, wr, wc, fr, fq, lds, wid, lane) || bad;
#pragma unroll
        for (int ai = 0; ai < 2; ++ai)
#pragma unroll
            for (int m = 0; m < 4; ++m) { const int r = ai * HALF + wr * 64 + m * 16 + fr; const f32x2v sr = S[r]; const size_t off = (size_t)(u.pm * BM + r) * ldc + col0;
#pragma unroll
                for (int bj = 0; bj < 2; ++bj)
#pragma unroll
                    for (int n = 0; n < 2; ++n) { const f32x4 x1 = acc[ai][bj][m][n]; *(f32x4*)(out + off + bj * HALF + n * 16) = bad1 ? (f32x4){qnan, qnan, qnan, qnan} : x1;
                        const f32x4 o = (x1 - sr.x) * sr.y; u32x2v w; w.x = cvt_pk_bf16(o[0], o[1]); w.y = cvt_pk_bf16(o[2], o[3]);
                        if (bad) { w.x = 0x7fc07fc0u; w.y = 0x7fc07fc0u; } *(u32x2v*)(xn + off + bj * HALF + n * 16) = w; }
                asm volatile("" ::: "memory"); }
    }
};

template <class Epi, class Sched, bool ALIGN_EPI = false, bool SP2 = false>
__device__ __forceinline__ void gemm_phase(PG8_LAS unsigned char* lds, const Gemm g, const Sched& S, const Epi& E) {
    int tid_ = threadIdx.x; asm volatile("" : "+v"(tid_));
    const int tid = tid_, wid = __builtin_amdgcn_readfirstlane(tid >> 6), lane = tid & 63, wr = wid >> 2, wc = wid & 3, fr = lane & 15, fq = lane >> 4;
    const int K = g.K, nt = K / BK;
    unsigned voffA[2], voffB[2];
#pragma unroll
    for (int i = 0; i < 2; ++i) { int R, C; stage_rc(tid * 16 + i * 8192, R, C); const int Rb = Epi::PERM ? ((R & ~31) + perm32(R & 31)) : R;
        voffA[i] = (unsigned)(R * K + C) * 2u; voffB[i] = (unsigned)(Rb * K + C) * 2u; }
    const size_t kstep = (size_t)(BK * 2);
    const size_t hstep = (size_t)HALF * K * 2;
    const size_t tstep = 2 * hstep;
    const unsigned ldsw = (unsigned)wid * 1024u;
    const int aoff = lds_byte(wr * 64 + fr, fq * 8), boff = lds_byte(wc * 32 + fr, fq * 8);
#define PG8_SA(b, h) (((b) * 2 + (h)) * HTB)
#define PG8_SB(b, h) ((4 + (b) * 2 + (h)) * HTB)
#define PG8_STAGE(bufoff, gbase, voff) do { _Pragma("unroll") for (int _i = 0; _i < 2; ++_i) \
        __builtin_amdgcn_global_load_lds((const unsigned*)((const char*)(gbase) + (voff)[_i]), (PG8_LAS unsigned*)(lds + (bufoff) + ldsw + _i * 8192), 16, 0, 0); } while (0)
#define PG8_LDA(dst, b, h) do { _Pragma("unroll") for (int m = 0; m < 4; ++m) _Pragma("unroll") for (int k = 0; k < 2; ++k) dst[m][k] = *(const PG8_LAS bf16x8*)(lds + PG8_SA(b, h) + aoff + m * 2048 + k * 1024); } while (0)
#define PG8_LDB(dst, b, h) do { _Pragma("unroll") for (int n = 0; n < 2; ++n) _Pragma("unroll") for (int k = 0; k < 2; ++k) dst[n][k] = *(const PG8_LAS bf16x8*)(lds + PG8_SB(b, h) + boff + n * 2048 + k * 1024); } while (0)
#define PG8_MMA(ai, bj, At, Bt) do { __builtin_amdgcn_s_setprio(1); _Pragma("unroll") for (int m = 0; m < 4; ++m) _Pragma("unroll") for (int n = 0; n < 2; ++n) _Pragma("unroll") for (int k = 0; k < 2; ++k) \
        acc[ai][bj][m][n] = __builtin_amdgcn_mfma_f32_16x16x32_bf16(Bt[n][k], At[m][k], acc[ai][bj][m][n], 0, 0, 0); __builtin_amdgcn_s_setprio(0); } while (0)
#define PG8_WAIT_V(n) asm volatile("s_waitcnt vmcnt(" #n ")" ::: "memory")
#define PG8_WAIT_L(n) asm volatile("s_waitcnt lgkmcnt(" #n ")" ::: "memory")
#define PG8_BAR __builtin_amdgcn_s_barrier()
#define PG8_SCHED __builtin_amdgcn_sched_barrier(0)
    Unit cur, nxt; int ui = 0;
    if (!S.next(0, cur)) return;
    f32x4 acc[2][2][4][2];
#pragma unroll
    for (int a = 0; a < 2; ++a)
#pragma unroll
        for (int b = 0; b < 2; ++b)
#pragma unroll
            for (int m = 0; m < 4; ++m)
#pragma unroll
                for (int n = 0; n < 2; ++n) acc[a][b][m][n] = (f32x4){0.f, 0.f, 0.f, 0.f};
    bf16x8 At[4][2], B0[2][2], B1[2][2];
    const char* cA = (const char*)g.A + (size_t)cur.pm * tstep; const char* cB = (const char*)g.Bt + (size_t)cur.pn * tstep;
    S.a_ready(cur);
    if constexpr (SP2) {
        PG8_STAGE(PG8_SB(0, 0), cB, voffB); PG8_STAGE(PG8_SB(0, 1), cB + hstep, voffB); PG8_STAGE(PG8_SA(0, 0), cA, voffA); PG8_STAGE(PG8_SA(0, 1), cA + hstep, voffA);
        if (wr == 1) PG8_BAR;
        PG8_WAIT_V(2); PG8_BAR;
        PG8_STAGE(PG8_SB(1, 0), cB + kstep, voffB); PG8_STAGE(PG8_SA(1, 0), cA + kstep, voffA); PG8_STAGE(PG8_SB(1, 1), cB + hstep + kstep, voffB);
        PG8_WAIT_V(6); PG8_BAR;
    } else {
        PG8_STAGE(PG8_SB(0, 0), cB, voffB); PG8_STAGE(PG8_SA(0, 0), cA, voffA); PG8_STAGE(PG8_SB(0, 1), cB + hstep, voffB); PG8_STAGE(PG8_SA(0, 1), cA + hstep, voffA);
        if (wr == 1) PG8_BAR;
        PG8_WAIT_V(4); PG8_BAR;
        PG8_STAGE(PG8_SB(1, 0), cB + kstep, voffB); PG8_STAGE(PG8_SA(1, 0), cA + kstep, voffA); PG8_STAGE(PG8_SB(1, 1), cB + hstep + kstep, voffB);
        PG8_WAIT_V(6); PG8_BAR;
    }
    for (;;) {
        const bool has_next = S.next(ui + 1, nxt);
        const char* nA = has_next ? (const char*)g.A + (size_t)nxt.pm * tstep : cA; const char* nB = has_next ? (const char*)g.Bt + (size_t)nxt.pn * tstep : cB;
        for (int t = 0; t < nt; t += 2) {
            const bool last = (t == nt - 2);
            const char* a1 = cA + (size_t)(t + 1) * kstep;
            const char* a2 = last ? nA : cA + (size_t)(t + 2) * kstep; const char* b2 = last ? nB : cB + (size_t)(t + 2) * kstep;
            const char* a3 = a2 + kstep; const char* b3 = b2 + kstep;
            if (last && has_next) S.a_ready(nxt);
            if constexpr (SP2) {
            PG8_LDB(B0, 0, 0); PG8_LDB(B1, 0, 1); PG8_SCHED; PG8_LDA(At, 0, 0); PG8_STAGE(PG8_SA(1, 1), a1 + hstep, voffA);
            PG8_WAIT_V(8); PG8_WAIT_L(0); PG8_BAR; PG8_MMA(0, 0, At, B0); PG8_MMA(0, 1, At, B1); PG8_BAR; PG8_SCHED;
            PG8_LDA(At, 0, 1); PG8_STAGE(PG8_SB(0, 0), b2, voffB); PG8_STAGE(PG8_SB(0, 1), b2 + hstep, voffB); PG8_STAGE(PG8_SA(0, 0), a2, voffA);
            PG8_WAIT_V(8); PG8_WAIT_L(0); PG8_BAR; PG8_MMA(1, 0, At, B0); PG8_MMA(1, 1, At, B1); PG8_BAR; PG8_SCHED;
            PG8_LDB(B0, 1, 0); PG8_LDB(B1, 1, 1); PG8_SCHED; PG8_LDA(At, 1, 0); PG8_STAGE(PG8_SA(0, 1), a2 + hstep, voffA);
            PG8_WAIT_V(8); PG8_WAIT_L(0); PG8_BAR; PG8_MMA(0, 0, At, B0); PG8_MMA(0, 1, At, B1); PG8_BAR; PG8_SCHED;
            PG8_LDA(At, 1, 1); PG8_STAGE(PG8_SB(1, 0), b3, voffB); PG8_STAGE(PG8_SB(1, 1), b3 + hstep, voffB); PG8_STAGE(PG8_SA(1, 0), a3, voffA);
            PG8_WAIT_V(8); PG8_WAIT_L(0); PG8_BAR; PG8_MMA(1, 0, At, B0); PG8_MMA(1, 1, At, B1); PG8_BAR; PG8_SCHED;
            } else {
            PG8_LDB(B0, 0, 0); PG8_SCHED; PG8_LDA(At, 0, 0); PG8_STAGE(PG8_SA(1, 1), a1 + hstep, voffA);
            PG8_WAIT_L(8); PG8_BAR; PG8_WAIT_L(0); PG8_MMA(0, 0, At, B0); PG8_BAR; PG8_SCHED;
            PG8_LDB(B1, 0, 1); PG8_STAGE(PG8_SB(0, 0), b2, voffB);
            PG8_BAR; PG8_WAIT_L(0); PG8_MMA(0, 1, At, B1); PG8_BAR;
            PG8_LDA(At, 0, 1); PG8_STAGE(PG8_SA(0, 0), a2, voffA);
            PG8_BAR; PG8_WAIT_L(0); PG8_MMA(1, 0, At, B0); PG8_BAR; PG8_SCHED;
            PG8_STAGE(PG8_SB(0, 1), b2 + hstep, voffB);
            PG8_WAIT_V(6); PG8_BAR; PG8_MMA(1, 1, At, B1); PG8_BAR;
            PG8_LDB(B0, 1, 0); PG8_SCHED; PG8_LDA(At, 1, 0); PG8_STAGE(PG8_SA(0, 1), a2 + hstep, voffA);
            PG8_WAIT_L(8); PG8_BAR; PG8_WAIT_L(0); PG8_MMA(0, 0, At, B0); PG8_BAR; PG8_SCHED;
            PG8_LDB(B1, 1, 1); PG8_STAGE(PG8_SB(1, 0), b3, voffB);
            PG8_BAR; PG8_WAIT_L(0); PG8_MMA(0, 1, At, B1); PG8_BAR;
            PG8_LDA(At, 1, 1); PG8_STAGE(PG8_SA(1, 0), a3, voffA);
            PG8_BAR; PG8_WAIT_L(0); PG8_MMA(1, 0, At, B0); PG8_BAR; PG8_SCHED;
            PG8_STAGE(PG8_SB(1, 1), b3 + hstep, voffB);
            PG8_WAIT_V(6); PG8_BAR; PG8_MMA(1, 1, At, B1); PG8_BAR;
            }
        }
        if constexpr (ALIGN_EPI) { if (wr == 0) PG8_BAR; }
        if constexpr (!Epi::AFTER_DRAIN) { E(acc, cur, wr, wc, fr, fq); S.done(cur); }
        if (!has_next) break;
#pragma unroll
        for (int a = 0; a < 2; ++a)
#pragma unroll
            for (int b = 0; b < 2; ++b)
#pragma unroll
                for (int m = 0; m < 4; ++m)
#pragma unroll
                    for (int n = 0; n < 2; ++n) acc[a][b][m][n] = (f32x4){0.f, 0.f, 0.f, 0.f};
        cur = nxt; cA = nA; cB = nB; ++ui;
        if constexpr (ALIGN_EPI) { if (wr == 1) PG8_BAR; }
    }
    PG8_WAIT_V(0);
    if constexpr (!ALIGN_EPI) { if (wr == 0) PG8_BAR; }
    PG8_BAR;
    if constexpr (Epi::AFTER_DRAIN) { E.fused(acc, cur, wr, wc, fr, fq, lds, wid, lane); S.done(cur); }
#undef PG8_SA
#undef PG8_SB
#undef PG8_STAGE
#undef PG8_LDA
#undef PG8_LDB
#undef PG8_MMA
#undef PG8_WAIT_V
#undef PG8_WAIT_L
#undef PG8_BAR
#undef PG8_SCHED
}
}
namespace pg8 {
__device__ __forceinline__ u32x4 pack8(const f32x4& a, const f32x4& b) { u32x4 w; w.x = cvt_pk_bf16(a[0], a[1]); w.y = cvt_pk_bf16(a[2], a[3]); w.z = cvt_pk_bf16(b[0], b[1]); w.w = cvt_pk_bf16(b[2], b[3]); return w; }
__device__ __forceinline__ f32x4 bf_lo4(const u32x4& w) { return (f32x4){__uint_as_float(w.x << 16), __uint_as_float(w.x & 0xffff0000u), __uint_as_float(w.y << 16), __uint_as_float(w.y & 0xffff0000u)}; }
__device__ __forceinline__ f32x4 bf_hi4(const u32x4& w) { return (f32x4){__uint_as_float(w.z << 16), __uint_as_float(w.z & 0xffff0000u), __uint_as_float(w.w << 16), __uint_as_float(w.w & 0xffff0000u)}; }
__device__ __forceinline__ float sigmoid_f(float x) { return __builtin_amdgcn_rcpf(1.0f + __builtin_amdgcn_exp2f(-1.4426950408889634f * x)); }
__device__ __forceinline__ f32x4 sigmoid4(const f32x4& v) { return (f32x4){sigmoid_f(v[0]), sigmoid_f(v[1]), sigmoid_f(v[2]), sigmoid_f(v[3])}; }

constexpr float QSCALE = 0.125f * 1.4426950408889634f;
constexpr float QMSCALE = 0.08838834764831845f * 1.4426950408889634f;

struct EpiP1 {
    static constexpr bool PERM = true, AFTER_DRAIN = false;
    bf16_t *Q, *K, *V, *CB, *Z, *QM, *G; const float *cosT, *sinT;
    __device__ __forceinline__ void operator()(const f32x4 (&acc)[2][2][4][2], const Unit& u, int wr, int wc, int fr, int fq) const {
        const int pn = u.pn; const int row0 = u.pm * BM + wr * 64 + fr;
        if (pn < 8) {
            bf16_t* base = (pn < 4 ? Q : K) + (pn & 3) * 256 + wc * 64 + 8 * fq; const float sc = pn < 4 ? QSCALE : 1.0f;
#pragma unroll
            for (int ai = 0; ai < 2; ++ai)
#pragma unroll
                for (int m = 0; m < 4; ++m) { const int row = row0 + ai * HALF + m * 16;
                    const float* cp = cosT + (size_t)row * 32 + 8 * fq; const float* sp = sinT + (size_t)row * 32 + 8 * fq;
                    const f32x4 c0 = *(const f32x4*)cp, c1 = *(const f32x4*)(cp + 4), s0 = *(const f32x4*)sp, s1 = *(const f32x4*)(sp + 4);
                    const f32x4 lo0 = acc[ai][0][m][0], lo1 = acc[ai][0][m][1], hi0 = acc[ai][1][m][0], hi1 = acc[ai][1][m][1];
                    const f32x4 a0 = (lo0 * c0 - hi0 * s0) * sc, a1 = (lo1 * c1 - hi1 * s1) * sc, b0 = (hi0 * c0 + lo0 * s0) * sc, b1 = (hi1 * c1 + lo1 * s1) * sc;
                    bf16_t* rp = base + (size_t)row * 1024; *(u32x4*)rp = pack8(a0, a1); *(u32x4*)(rp + 32) = pack8(b0, b1); }
        } else if (pn < 14) {
            bf16_t* base; int ldc;
            if (pn < 12) { base = V + (pn - 8) * 256; ldc = 1024; } else { base = CB + (pn - 12) * 256; ldc = 512; }
            base += wc * 32 + 8 * fq;
#pragma unroll
            for (int ai = 0; ai < 2; ++ai)
#pragma unroll
                for (int m = 0; m < 4; ++m) { bf16_t* rp = base + (size_t)(row0 + ai * HALF + m * 16) * ldc;
#pragma unroll
                    for (int bj = 0; bj < 2; ++bj) *(u32x4*)(rp + bj * HALF) = pack8(acc[ai][bj][m][0], acc[ai][bj][m][1]); }
        } else if (pn < 18) {
            bf16_t* base = Z + (pn - 14) * 128 + wc * 32 + 8 * fq;
#pragma unroll
            for (int ai = 0; ai < 2; ++ai)
#pragma unroll
                for (int m = 0; m < 4; ++m) { bf16_t* rp = base + (size_t)(row0 + ai * HALF + m * 16) * 512;
                    *(u32x4*)rp = pack8(acc[ai][0][m][0] * acc[ai][1][m][0], acc[ai][0][m][1] * acc[ai][1][m][1]); }
        } else if (pn < 20) {
            bf16_t* base = QM + (pn - 18) * 256 + wc * 32 + 8 * fq;
#pragma unroll
            for (int ai = 0; ai < 2; ++ai)
#pragma unroll
                for (int m = 0; m < 4; ++m) { bf16_t* rp = base + (size_t)(row0 + ai * HALF + m * 16) * 512;
#pragma unroll
                    for (int bj = 0; bj < 2; ++bj) *(u32x4*)(rp + bj * HALF) = pack8(acc[ai][bj][m][0] * QMSCALE, acc[ai][bj][m][1] * QMSCALE); }
        } else {
            bf16_t* base = G + (pn - 20) * 256 + wc * 32 + 8 * fq;
#pragma unroll
            for (int ai = 0; ai < 2; ++ai)
#pragma unroll
                for (int m = 0; m < 4; ++m) { bf16_t* rp = base + (size_t)(row0 + ai * HALF + m * 16) * 3072;
#pragma unroll
                    for (int bj = 0; bj < 2; ++bj) *(u32x4*)(rp + bj * HALF) = pack8(sigmoid4(acc[ai][bj][m][0]), sigmoid4(acc[ai][bj][m][1])); }
        }
    }
};

template <bool FIRST> struct EpiGate {
    static constexpr bool PERM = true, AFTER_DRAIN = false;
    bf16_t* Mg; const bf16_t* G; int gi;
    __device__ __forceinline__ void operator()(const f32x4 (&acc)[2][2][4][2], const Unit& u, int wr, int wc, int fr, int fq) const {
        const int row0 = u.pm * BM + wr * 64 + fr, col0 = u.pn * BM + wc * 32 + 8 * fq;
#pragma unroll
        for (int ai = 0; ai < 2; ++ai)
#pragma unroll
            for (int m = 0; m < 4; ++m) { const size_t row = (size_t)(row0 + ai * HALF + m * 16);
#pragma unroll
                for (int bj = 0; bj < 2; ++bj) { const int col = col0 + bj * HALF;
                    const u32x4 gv = *(const u32x4*)(G + row * 3072 + gi * 1024 + col);
                    f32x4 v0 = acc[ai][bj][m][0] * bf_lo4(gv), v1 = acc[ai][bj][m][1] * bf_hi4(gv);
                    bf16_t* mp = Mg + row * 1024 + col;
                    if (!FIRST) { const u32x4 pv = __builtin_nontemporal_load((const u32x4*)mp); v0 += bf_lo4(pv); v1 += bf_hi4(pv); }
                    *(u32x4*)mp = pack8(v0, v1); } }
    }
};

struct EpiSwiglu {
    static constexpr bool PERM = true, AFTER_DRAIN = false;
    bf16_t* H;
    __device__ __forceinline__ void operator()(const f32x4 (&acc)[2][2][4][2], const Unit& u, int wr, int wc, int fr, int fq) const {
        const int row0 = u.pm * BM + wr * 64 + fr; bf16_t* base = H + (u.pn & 3) * 128 + wc * 32 + 8 * fq;
#pragma unroll
        for (int ai = 0; ai < 2; ++ai)
#pragma unroll
            for (int m = 0; m < 4; ++m) { bf16_t* rp = base + (size_t)(row0 + ai * HALF + m * 16) * 512;
                const f32x4 g0 = acc[ai][0][m][0], g1 = acc[ai][0][m][1];
                *(u32x4*)rp = pack8(g0 * sigmoid4(g0) * acc[ai][1][m][0], g1 * sigmoid4(g1) * acc[ai][1][m][1]); }
    }
};
struct EpiScatter {
    static constexpr bool PERM = true, AFTER_DRAIN = false;
    bf16_t* Yc; const int* rowinfo; const float* roww;
    __device__ __forceinline__ void operator()(const f32x4 (&acc)[2][2][4][2], const Unit& u, int wr, int wc, int fr, int fq) const {
        const int row0 = u.pm * BM + wr * 64 + fr, col0 = (u.pn & 3) * BM + wc * 32 + 8 * fq;
#pragma unroll
        for (int ai = 0; ai < 2; ++ai)
#pragma unroll
            for (int m = 0; m < 4; ++m) { const int row = row0 + ai * HALF + m * 16; const int info = rowinfo[row]; const float w = roww[row];
                if (info >= 0) { bf16_t* rp = Yc + (size_t)info * 1024 + col0;
#pragma unroll
                    for (int bj = 0; bj < 2; ++bj) *(u32x4*)(rp + bj * HALF) = pack8(acc[ai][bj][m][0] * w, acc[ai][bj][m][1] * w); } }
    }
};
struct MoeOrder {
    int ntiles, vcu, G; const PG8_LAS int* tile_e;
    __device__ __forceinline__ bool next(int i, Unit& u) const {
        const int L = i * G + vcu; if (L >= ntiles * 4) return false;
        u.pm = L >> 2; u.pn = __builtin_amdgcn_readfirstlane(tile_e[L >> 2]) * 4 + (L & 3); return true;
    }
    __device__ __forceinline__ void a_ready(const Unit&) const {}
    __device__ __forceinline__ void done(const Unit&) const {}
};
}
#include <hip/hip_bf16.h>
#include <cmath>
namespace attn_body {
using bf16=__hip_bfloat16;
using bf16x8=__attribute__((ext_vector_type(8)))short;
using s16x4=__attribute__((ext_vector_type(4)))short;
using f32x16=__attribute__((ext_vector_type(16)))float;
using u32x4=__attribute__((ext_vector_type(4)))unsigned;
constexpr int BATCH=2,NHEAD=16,SEQ=8192,D=64,DM=NHEAD*D;
constexpr int NW=8,QBLK=32,QB=QBLK*NW,KVBLK=64,NQB=SEQ/QB;
constexpr int ATTN_PITCH=DM, ATTN_UNIT_ROWS=QB;
__device__ __forceinline__ int crow(int r,int hi){return (r&3)+8*(r>>2)+4*hi;}
#define SBAR() __builtin_amdgcn_sched_barrier(0)
__device__ __forceinline__ void cmask(f32x16&p0,f32x16&p1,int jb,int qrel,int hi){
  const float NEG=-INFINITY; int kb=64*jb+4*hi;
  #pragma unroll
  for(int r=0;r<16;++r){int kv=kb+(r&3)+8*(r>>2); if(kv>qrel)p0[r]=NEG; if(kv+32>qrel)p1[r]=NEG;}
}

constexpr int NSLOT=3, SLOTB=8192;
constexpr int LDS_K=0, LDS_V=NSLOT*SLOTB, LDS_WS=2*NSLOT*SLOTB, LDS_OST=LDS_WS+NW*64*4, LDS_BYTES=LDS_OST+NW*4096;
constexpr float C2=0.125f*1.4426950408889634f;
__device__ __forceinline__ void glds16(const void*gsrc,unsigned lds_dst){unsigned keep;
  asm volatile("s_mov_b32 %0, m0\n\ts_mov_b32 m0, %2\n\ts_nop 0\n\tglobal_load_lds_dwordx4 %1, off\n\ts_mov_b32 m0, %0":"=&s"(keep):"v"(gsrc),"s"(lds_dst):"memory");}
__device__ __forceinline__ float max3f(float a,float b,float c){float r;asm("v_max3_f32 %0, %1, %2, %3":"=v"(r):"v"(a),"v"(b),"v"(c));return r;}
__device__ __forceinline__ float max2f(float a,float b){float r;asm("v_max_f32_e32 %0, %1, %2":"=v"(r):"v"(a),"v"(b));return r;}
__device__ __forceinline__ float fadd_s(float a,float b){float r;asm("v_add_f32_e32 %0, %1, %2":"=v"(r):"v"(a),"v"(b));return r;}
__device__ __forceinline__ float fsub_s(float a,float b){float r;asm("v_sub_f32_e32 %0, %1, %2":"=v"(r):"v"(a),"v"(b));return r;}
typedef float f32x2_t __attribute__((ext_vector_type(2))); typedef __bf16 bf16x2_t __attribute__((ext_vector_type(2)));
__device__ __forceinline__ unsigned cvtpk_s(float lo,float hi){f32x2_t v={lo,hi};bf16x2_t b=__builtin_convertvector(v,bf16x2_t);return __builtin_bit_cast(unsigned,b);}
#define WAIT_BAR(N) asm volatile("s_waitcnt vmcnt(" #N ") lgkmcnt(0)\n\ts_barrier":::"memory")

__device__ __forceinline__ void qkt(f32x16&p0,f32x16&p1,const char*Kslot,const bf16x8*qr,const f32x16&negm,int r32,int hi){
  const char*kb=Kslot+hi*1024+r32*16;
  #pragma unroll
  for(int d0=0;d0<4;++d0){
    const bf16x8 b0=*reinterpret_cast<const bf16x8*>(kb+d0*2048);
    const bf16x8 b1=*reinterpret_cast<const bf16x8*>(kb+d0*2048+512);
    if(d0==0){p0=__builtin_amdgcn_mfma_f32_32x32x16_bf16(b0,qr[0],negm,0,0,0);p1=__builtin_amdgcn_mfma_f32_32x32x16_bf16(b1,qr[0],negm,0,0,0);}
    else{p0=__builtin_amdgcn_mfma_f32_32x32x16_bf16(b0,qr[d0],p0,0,0,0);p1=__builtin_amdgcn_mfma_f32_32x32x16_bf16(b1,qr[d0],p1,0,0,0);}}
}
typedef __attribute__((address_space(3))) const char* lds_cptr;
typedef short v4i16_t __attribute__((ext_vector_type(4)));
__device__ __forceinline__ void kload8(bf16x8*kf,lds_cptr kp){
  kf[0]=*(const __attribute__((address_space(3))) bf16x8*)(kp);      kf[1]=*(const __attribute__((address_space(3))) bf16x8*)(kp+512);
  kf[2]=*(const __attribute__((address_space(3))) bf16x8*)(kp+2048); kf[3]=*(const __attribute__((address_space(3))) bf16x8*)(kp+2560);
  kf[4]=*(const __attribute__((address_space(3))) bf16x8*)(kp+4096); kf[5]=*(const __attribute__((address_space(3))) bf16x8*)(kp+4608);
  kf[6]=*(const __attribute__((address_space(3))) bf16x8*)(kp+6144); kf[7]=*(const __attribute__((address_space(3))) bf16x8*)(kp+6656);
}
__device__ __forceinline__ void kload2(bf16x8*kf,lds_cptr kp,int j){ kf[2*j]=*(const __attribute__((address_space(3))) bf16x8*)(kp+j*2048); kf[2*j+1]=*(const __attribute__((address_space(3))) bf16x8*)(kp+j*2048+512); }
__device__ __forceinline__ s16x4 vtr(lds_cptr p){ return __builtin_bit_cast(s16x4,__builtin_amdgcn_ds_read_tr16_b64_v4i16((__attribute__((address_space(3))) v4i16_t*)p)); }
__device__ __forceinline__ float rowmax(const f32x16&p0,const f32x16&p1){
  float a=max3f(p0[0],p0[1],p1[0]),b=max3f(p0[2],p0[3],p1[1]);a=max3f(a,p1[2],p1[3]);
  #pragma unroll
  for(int r=4;r<16;r+=4){a=max3f(a,p0[r],p0[r+1]);b=max3f(b,p0[r+2],p0[r+3]);a=max3f(a,p1[r],p1[r+1]);b=max3f(b,p1[r+2],p1[r+3]);}
  const float m=max2f(a,b);
  auto rr=__builtin_amdgcn_permlane32_swap(__float_as_uint(m),__float_as_uint(m),false,false);
  return max2f(__uint_as_float(rr[0]),__uint_as_float(rr[1]));
}
__device__ __forceinline__ void pv(f32x16*o,int vb,bf16x8 pa0,bf16x8 pa1,bf16x8 pa2,bf16x8 pa3){
  #pragma unroll
  for(int d0=0;d0<2;++d0){s16x4 lo[4],hi[4];
    #pragma unroll
    for(int ks=0;ks<4;++ks){
      asm volatile("ds_read_b64_tr_b16 %0,%1 offset:%c2":"=&v"(lo[ks]):"v"(vb),"i"(d0*4096+ks*1024):"memory");
      asm volatile("ds_read_b64_tr_b16 %0,%1 offset:%c2":"=&v"(hi[ks]):"v"(vb),"i"(d0*4096+ks*1024+512):"memory");}
    asm volatile("s_waitcnt lgkmcnt(0)":::"memory");SBAR();
    #define PK(k) (bf16x8){lo[k][0],lo[k][1],lo[k][2],lo[k][3],hi[k][0],hi[k][1],hi[k][2],hi[k][3]}
    o[d0]=__builtin_amdgcn_mfma_f32_32x32x16_bf16(pa0,PK(0),o[d0],0,0,0);
    o[d0]=__builtin_amdgcn_mfma_f32_32x32x16_bf16(pa1,PK(1),o[d0],0,0,0);
    o[d0]=__builtin_amdgcn_mfma_f32_32x32x16_bf16(pa2,PK(2),o[d0],0,0,0);
    o[d0]=__builtin_amdgcn_mfma_f32_32x32x16_bf16(pa3,PK(3),o[d0],0,0,0);
    #undef PK
  }
}

#ifndef ATTN_STORE16
#define ATTN_STORE16(p,v) (*(u32x4*)(p)=(v))
#endif
template<int THRL> __device__ __forceinline__ void attn_unit(int b,int qkcol,int vcol,int qb,const bf16*Q,const bf16*__restrict__ K,const bf16*__restrict__ V,bf16*O,char*shm){
  int tid_=threadIdx.x; asm volatile("":"+v"(tid_)); const int tid=tid_,lane=tid&63,r32=lane&31,hi=lane>>5; const int wid=__builtin_amdgcn_readfirstlane(tid>>6);
  const long rowbase=(long)b*SEQ; const int q0=qb*QB;
  const bf16*Qw=Q+(rowbase+q0+wid*QBLK)*DM+qkcol;
  const bf16*Kh=K+rowbase*DM+qkcol,*Vh=V+rowbase*DM+vcol;
  const unsigned lds0=(unsigned)(uintptr_t)shm;
  float*wsf=(float*)(shm+LDS_WS)+wid*64;
  const bf16*ksrc=Kh+(long)lane*DM+wid*8;
  const bf16*vsrc=Vh+(long)(16*(wid&3)+(lane>>2))*DM+(wid>>2)*32+(lane&3)*8;
  const unsigned kdst=lds0+LDS_K+wid*1024, vdst=lds0+LDS_V+wid*1024;
  #define DMA_K(t,slot) glds16(ksrc+(long)(t)*KVBLK*DM,(unsigned)__builtin_amdgcn_readfirstlane(kdst+(slot)))
  #define DMA_V(t,slot) glds16(vsrc+(long)(t)*KVBLK*DM,(unsigned)__builtin_amdgcn_readfirstlane(vdst+(slot)))
  const int vb0=(int)(lds0+LDS_V)+((lane>>4)&1)*32+(lane&3)*8+(4*hi+((lane&15)>>2))*64;
  const char*Kbase=shm+LDS_K; bf16x8 kf[8];
  const lds_cptr shm3=(lds_cptr)shm; const lds_cptr kp0=shm3+LDS_K+hi*1024+r32*16; const lds_cptr vp0=shm3+LDS_V+((lane>>4)&1)*32+(lane&3)*8+(4*hi+((lane&15)>>2))*64;
  const int NT=(q0+QB)/KVBLK;
  DMA_K(0,0);DMA_V(0,0);DMA_K(1,SLOTB);
  bf16x8 qr[4];
  #pragma unroll
  for(int d0=0;d0<4;++d0)qr[d0]=*reinterpret_cast<const bf16x8*>(&Qw[(long)r32*DM+d0*16+hi*8]);
  float mhat=0.f,l_reg=0.f;f32x16 o[2];o[0]=f32x16{};o[1]=f32x16{};f32x16 negm=f32x16{};asm volatile("":"+v"(negm));
  const int qrel=wid*QBLK+r32;
  #define CMASK(P0,P1,t) do{int jb_=(t)-(NT-4); if(jb_>=0)cmask(P0,P1,jb_,qrel,hi);}while(0)
  bool resc=false;
  #define START(P0,P1) do{ const float rm=rowmax(P0,P1); resc=false; \
    { const float dl=rm; mhat=fadd_s(mhat,dl); \
      _Pragma("unroll") for(int r=0;r<16;++r){P0[r]=fsub_s(P0[r],dl);P1[r]=fsub_s(P1[r],dl);} \
      _Pragma("unroll") for(int r=0;r<16;++r)negm[r]=-mhat; asm volatile("":"+v"(negm)); } \
    _Pragma("unroll") for(int r=0;r<16;++r)P0[r]=__builtin_amdgcn_exp2f(P0[r]); }while(0)
  #define RESC() do{ if(resc){ asm volatile("s_waitcnt lgkmcnt(0)":::"memory"); \
      _Pragma("unroll") for(int d_=0;d_<2;++d_) _Pragma("unroll") for(int r=0;r<16;++r)o[d_][r]*=wsf[crow(r,hi)]; } }while(0)
  f32x16 pA0,pA1,pB0,pB1;
  int sl_prev=0,sl_cur=0,sl_next=SLOTB;
  #define ROT() do{sl_prev=sl_cur;sl_cur=sl_next;sl_next=(sl_next==(NSLOT-1)*SLOTB)?0:sl_next+SLOTB;}while(0)
  DMA_K(2,2*SLOTB);
  WAIT_BAR(3);
  qkt(pA0,pA1,Kbase,qr,negm,r32,hi);asm volatile("s_nop 15\n\ts_nop 7":"+v"(pA0),"+v"(pA1));CMASK(pA0,pA1,0);
  START(pA0,pA1);
  _Pragma("unroll") for(int r=0;r<16;++r)pA1[r]=__builtin_amdgcn_exp2f(pA1[r]);
  WAIT_BAR(0);
  DMA_K(3,0);DMA_V(1,SLOTB);
  ROT();
  kload8(kf,kp0+sl_cur);
  WAIT_BAR(2);
  s16x4 vlo[8],vhi[8]; u32x4 pw0,pw1,pw2,pw3;
  #define PKW(P,B) cvtpk_s(P[B],P[B+1])
  #define PAF(k) __builtin_bit_cast(bf16x8,pw##k)
  #define VFR(i) (bf16x8){vlo[i][0],vlo[i][1],vlo[i][2],vlo[i][3],vhi[i][0],vhi[i][1],vhi[i][2],vhi[i][3]}
  #define PIN(x) asm volatile("":"+v"(x))
  #define MX3(a,b,c) __builtin_fmaxf(__builtin_fmaxf((a),(b)),(c))
  #define GAPA(MF,A0,A1,A2,A3,W0,W1,PW) do{ MF; sacc+=A0; sacc+=A1; sacc+=A2; sacc+=A3; PIN(sacc); W0; W1; PIN(PW); SBAR(); }while(0)
  #define EX(v) __builtin_amdgcn_exp2f(v)
  #define GAPB(MF,X,B) do{ MF; X[B]=EX(X[B]); X[B+1]=EX(X[B+1]); X[B+2]=EX(X[B+2]); X[B+3]=EX(X[B+3]); PIN(X); SBAR(); }while(0)
  #define VRD(i) do{ vlo[i]=vtr(vp_+(((i)>>2)*4096+((i)&3)*1024)); vhi[i]=vtr(vp_+(((i)>>2)*4096+((i)&3)*1024+512)); }while(0)
  #define KRD(G,j) do{ if(G){ kload2(kf,kp0+sl_next,j); SBAR(); } }while(0)
  #define STEP(C0,C1,P0,P1,t,GK,GV,GL) do{ SBAR(); \
    const lds_cptr vp_=vp0+sl_prev; \
    VRD(0); SBAR(); float sacc=(P0[0]+P0[1]); \
    GAPA(C0=__builtin_amdgcn_mfma_f32_32x32x16_bf16(kf[0],qr[0],negm,0,0,0), P0[2],P0[3],P0[4],P0[5],     pw0[0]=PKW(P0,0), pw0[1]=PKW(P0,2), pw0); \
    VRD(4); SBAR(); GAPA(C1=__builtin_amdgcn_mfma_f32_32x32x16_bf16(kf[1],qr[0],negm,0,0,0), P0[6],P0[7],P0[8],P0[9],     pw0[2]=PKW(P0,4), pw0[3]=PKW(P0,6), pw0); \
    VRD(1); SBAR(); GAPA(C0=__builtin_amdgcn_mfma_f32_32x32x16_bf16(kf[2],qr[1],C0,0,0,0),   P0[10],P0[11],P0[12],P0[13], pw1[0]=PKW(P0,8), pw1[1]=PKW(P0,10), pw1); \
    VRD(5); SBAR(); GAPA(C1=__builtin_amdgcn_mfma_f32_32x32x16_bf16(kf[3],qr[1],C1,0,0,0),   P0[14],P0[15],P1[0],P1[1],   pw1[2]=PKW(P0,12),pw1[3]=PKW(P0,14), pw1); \
    VRD(2); SBAR(); GAPA(C0=__builtin_amdgcn_mfma_f32_32x32x16_bf16(kf[4],qr[2],C0,0,0,0),   P1[2],P1[3],P1[4],P1[5],     pw2[0]=PKW(P1,0), pw2[1]=PKW(P1,2), pw2); \
    VRD(6); SBAR(); GAPA(C1=__builtin_amdgcn_mfma_f32_32x32x16_bf16(kf[5],qr[2],C1,0,0,0),   P1[6],P1[7],P1[8],P1[9],     pw2[2]=PKW(P1,4), pw2[3]=PKW(P1,6), pw2); \
    VRD(3); SBAR(); GAPA(C0=__builtin_amdgcn_mfma_f32_32x32x16_bf16(kf[6],qr[3],C0,0,0,0),   P1[10],P1[11],P1[12],P1[13], pw3[0]=PKW(P1,8), pw3[1]=PKW(P1,10), pw3); \
    VRD(7); SBAR(); GAPA(C1=__builtin_amdgcn_mfma_f32_32x32x16_bf16(kf[7],qr[3],C1,0,0,0),   P1[14],P1[15],0.f,0.f,       pw3[2]=PKW(P1,12),pw3[3]=PKW(P1,14), pw3); \
    l_reg+=sacc; \
    if(GK){DMA_K((t)+3,sl_cur);} if(GV){DMA_V((t)+1,sl_next);} \
    CMASK(C0,C1,t); \
    { float a=MX3(C0[0],C0[1],C1[0]),b=MX3(C0[2],C0[3],C1[1]); a=MX3(a,C1[2],C1[3]); \
      _Pragma("unroll") for(int r=4;r<16;r+=4){a=MX3(a,C0[r],C0[r+1]);b=MX3(b,C0[r+2],C0[r+3]);a=MX3(a,C1[r],C1[r+1]);b=MX3(b,C1[r+2],C1[r+3]);} \
      float rm=__builtin_fmaxf(a,b); { auto rr=__builtin_amdgcn_permlane32_swap(__float_as_uint(rm),__float_as_uint(rm),false,false); rm=__builtin_fmaxf(__uint_as_float(rr[0]),__uint_as_float(rr[1])); } \
      resc=false; \
      if(__builtin_expect(__any(rm>(float)THRL),0)){ const float dl=__builtin_fmaxf(rm,0.f); mhat+=dl; \
        _Pragma("unroll") for(int r=0;r<16;++r){C0[r]-=dl;C1[r]-=dl;} \
        _Pragma("unroll") for(int r=0;r<16;++r)negm[r]=-mhat; asm volatile("":"+v"(negm)); \
        const float f=__builtin_amdgcn_exp2f(-dl); l_reg*=f; if(hi==0)wsf[r32]=f; resc=true; } } \
    SBAR(); \
    GAPB(o[0]=__builtin_amdgcn_mfma_f32_32x32x16_bf16(PAF(0),VFR(0),o[0],0,0,0), C0,0); \
    GAPB(o[1]=__builtin_amdgcn_mfma_f32_32x32x16_bf16(PAF(0),VFR(4),o[1],0,0,0), C0,4); \
    KRD(GL,0); GAPB(o[0]=__builtin_amdgcn_mfma_f32_32x32x16_bf16(PAF(1),VFR(1),o[0],0,0,0), C0,8); \
    KRD(GL,1); GAPB(o[1]=__builtin_amdgcn_mfma_f32_32x32x16_bf16(PAF(1),VFR(5),o[1],0,0,0), C0,12); \
    KRD(GL,2); GAPB(o[0]=__builtin_amdgcn_mfma_f32_32x32x16_bf16(PAF(2),VFR(2),o[0],0,0,0), C1,0); \
    KRD(GL,3); GAPB(o[1]=__builtin_amdgcn_mfma_f32_32x32x16_bf16(PAF(2),VFR(6),o[1],0,0,0), C1,4); \
    GAPB(o[0]=__builtin_amdgcn_mfma_f32_32x32x16_bf16(PAF(3),VFR(3),o[0],0,0,0), C1,8); \
    GAPB(o[1]=__builtin_amdgcn_mfma_f32_32x32x16_bf16(PAF(3),VFR(7),o[1],0,0,0), C1,12); \
    }while(0)
  int t=1;
  #undef CMASK
  #define CMASK(P0,P1,t) do{}while(0)
  for(;t+5<NT;t+=2){
    STEP(pB0,pB1,pA0,pA1,t,true,true,true);     WAIT_BAR(2); RESC(); ROT();
    STEP(pA0,pA1,pB0,pB1,t+1,true,true,true);   WAIT_BAR(2); RESC(); ROT();
  }
  #undef CMASK
  #define CMASK(P0,P1,t) do{int jb_=(t)-(NT-4); if(jb_>=0)cmask(P0,P1,jb_,qrel,hi);}while(0)
  #define ENDW(tt) do{ if((tt)+3<NT){WAIT_BAR(2);} else if((tt)+2<NT){WAIT_BAR(1);} else {WAIT_BAR(0);} }while(0)
  for(;t+1<NT;t+=2){
    STEP(pB0,pB1,pA0,pA1,t,(t+3<NT),(t+1<NT),(t+1<NT));       ENDW(t);   RESC(); ROT();
    STEP(pA0,pA1,pB0,pB1,t+1,(t+4<NT),(t+2<NT),(t+2<NT));     ENDW(t+1); RESC(); ROT();
  }
  STEP(pB0,pB1,pA0,pA1,NT-1,false,false,false); RESC();
  { float sacc=pB0[0]+pB0[1]; _Pragma("unroll") for(int r=2;r<16;++r)sacc+=pB0[r]; _Pragma("unroll") for(int r=0;r<16;++r)sacc+=pB1[r]; l_reg+=sacc;
    pw0=(u32x4){PKW(pB0,0),PKW(pB0,2),PKW(pB0,4),PKW(pB0,6)};pw1=(u32x4){PKW(pB0,8),PKW(pB0,10),PKW(pB0,12),PKW(pB0,14)};pw2=(u32x4){PKW(pB1,0),PKW(pB1,2),PKW(pB1,4),PKW(pB1,6)};pw3=(u32x4){PKW(pB1,8),PKW(pB1,10),PKW(pB1,12),PKW(pB1,14)};
    SBAR(); pv(o,vb0+sl_cur,PAF(0),PAF(1),PAF(2),PAF(3)); }
  #undef PKW
  #undef PAF
  #undef VFR
  #undef PIN
  #undef MX3
  #undef GAPA
  #undef GAPB
  #undef EX
  #undef VRD
  #undef KRD
  #undef STEP
  #undef ENDW
  {auto rr=__builtin_amdgcn_permlane32_swap(__float_as_uint(l_reg),__float_as_uint(l_reg),false,false);l_reg=__uint_as_float(rr[0])+__uint_as_float(rr[1]);}
  if(hi==0)wsf[32+r32]=l_reg;asm volatile("s_waitcnt lgkmcnt(0)":::"memory");
  float rli[16];
  #pragma unroll
  for(int r=0;r<16;++r)rli[r]=__builtin_amdgcn_rcpf(wsf[32+crow(r,hi)]);
  bf16*Ow=O+(rowbase+q0+wid*QBLK)*DM+vcol;
  { bf16*stg=(bf16*)(shm+LDS_OST)+wid*2048;
    #pragma unroll
    for(int r=0;r<16;++r){const int orow=crow(r,hi);
      #pragma unroll
      for(int d0=0;d0<2;++d0)stg[orow*64+d0*32+r32]=__float2bfloat16(o[d0][r]*rli[r]);}
    asm volatile("s_waitcnt lgkmcnt(0)":::"memory");
    #pragma unroll
    for(int i=0;i<4;++i){const int row=i*8+(lane>>3),ch=lane&7; const u32x4 v=*(const u32x4*)(stg+row*64+ch*8); ATTN_STORE16(Ow+(long)row*DM+ch*8,v);} }
  asm volatile("s_waitcnt lgkmcnt(0)\n\ts_barrier":::"memory");
  #undef DMA_K
  #undef DMA_V
  #undef CMASK
  #undef START
  #undef RESC
  #undef ROT
}
constexpr int ATTN_LDS_BYTES=LDS_BYTES;
struct DiffTensors { const bf16* Q; const bf16* K; const bf16* V; bf16* O1; bf16* O2; };
template<int THRL=8> __device__ __forceinline__ void diff_attn_phase(char*lds,const DiffTensors&T,int vcu){
  const int s=vcu&7;
  for(int i=0;i<8;++i){ const int st=(vcu>>3)+32*(i>>2), k=i&3; const int qb=(k==0)?s:(k==1)?15-s:(k==2)?16+s:31-s;
    const int b=st>>5,h=(st>>2)&7,c=(st>>1)&1,vh=st&1;
    attn_unit<THRL>(b,(2*h+c)*64,h*128+vh*64,qb,T.Q,T.K,T.V,c?T.O2:T.O1,lds); }
}
#undef SBAR
#undef WAIT_BAR
}
#define GAS __attribute__((address_space(1)))
#define LAS __attribute__((address_space(3)))
typedef unsigned short bf16;
typedef unsigned v4u __attribute__((ext_vector_type(4)));
typedef float f32x4 __attribute__((ext_vector_type(4)));
typedef short bf16x8 __attribute__((ext_vector_type(8)));
typedef GAS unsigned gu32;
typedef GAS unsigned long long gu64;
#define RLX_AGENT __ATOMIC_RELAXED, __HIP_MEMORY_SCOPE_AGENT
#define LDS_WAIT() asm volatile("s_waitcnt lgkmcnt(0)" ::: "memory")
#define VM_WAIT() asm volatile("s_waitcnt vmcnt(0)" ::: "memory")
__device__ __forceinline__ unsigned long long rt() { return __builtin_amdgcn_s_memrealtime(); }
__device__ __forceinline__ unsigned f2bf(float f) { unsigned u = __builtin_bit_cast(unsigned, f); return (u + 0x7fffu + ((u >> 16) & 1u)) >> 16; }
__device__ __forceinline__ unsigned pk2(float lo, float hi) { return f2bf(lo) | (f2bf(hi) << 16); }

#define XB_TMO      128
#define XB_XCNT(j)  (256  + 64 * (j))
#define XB_XSUB(j)  (1280 + 64 * (j))
#define XB_XGEN(j)  (2304 + 64 * (j))
#define XB_TOP      3328
#define XB_TOPGEN   3392
#define XCD_BAR_WORDS 3456
#define XB_SPIN_CAP (1u << 18)

__device__ __forceinline__ unsigned xb_ld(unsigned* p)              { return __hip_atomic_load(p, __ATOMIC_RELAXED, __HIP_MEMORY_SCOPE_AGENT); }
__device__ __forceinline__ unsigned xb_add(unsigned* p, unsigned v) { return __hip_atomic_fetch_add(p, v, __ATOMIC_RELAXED, __HIP_MEMORY_SCOPE_AGENT); }
__device__ __forceinline__ unsigned xb_xcc_id() { return (unsigned)__builtin_amdgcn_s_getreg((3 << 11) | 20) & 0xFu; }
#define XB_SPIN(cond, bar) do { unsigned _sp = 0; while (cond) { __builtin_amdgcn_s_sleep(1); \
    if ((++_sp & 255u) == 0u) { if (xb_ld(&(bar)[XB_TMO])) break; if (_sp > XB_SPIN_CAP) { atomicAdd(&(bar)[XB_TMO], 1u); break; } } } } while (0)

struct XcdBarrier {
    unsigned* bar; unsigned x;
    volatile LAS unsigned* st;
};

__device__ __forceinline__ XcdBarrier xcd_barrier_post(unsigned* bar, volatile LAS unsigned* st) {
    XcdBarrier b; b.bar = bar; b.x = xb_xcc_id(); b.st = st;
    if (threadIdx.x == 0) (void)xb_add(&bar[XB_XCNT(b.x)], 1u);
    return b;
}
__device__ __forceinline__ void xcd_barrier_complete(unsigned* bar, unsigned x, unsigned& nloc, unsigned& nx) {
    const unsigned G = gridDim.x * gridDim.y * gridDim.z;
    unsigned sum, cnt, mine, sp = 0u;
    for (;;) {
        sum = 0u; cnt = 0u; mine = 0u;
#pragma unroll
        for (unsigned j = 0; j < 16; ++j) { const unsigned c = xb_ld(&bar[XB_XCNT(j)]); sum += c; cnt += (c > 0u) ? 1u : 0u; mine = (j == x) ? c : mine; }
        if (sum == G) break;
        __builtin_amdgcn_s_sleep(1);
        if ((++sp & 255u) == 0u) { if (xb_ld(&bar[XB_TMO])) break; if (sp > XB_SPIN_CAP) { atomicAdd(&bar[XB_TMO], 1u); break; } }
    }
    nloc = mine > 0u ? mine : 1u; nx = cnt > 0u ? cnt : 1u;
}

__device__ __forceinline__ void xcd_barrier(const XcdBarrier& b) {
    asm volatile("s_waitcnt vmcnt(0)" ::: "memory");
    __syncthreads();
    if (threadIdx.x == 0) {
        GAS unsigned* gbar_ = (GAS unsigned*)b.bar; unsigned bx_ = b.x; asm volatile("" : "+s"(bx_), "+s"(gbar_)); unsigned* bar = (unsigned*)gbar_;
        __builtin_amdgcn_s_waitcnt(0);
        unsigned nloc = b.st[0], nx = b.st[1];
        if (nloc == 0u) { xcd_barrier_complete(bar, bx_, nloc, nx); b.st[0] = nloc; b.st[1] = nx; }
        const unsigned old = xb_add(&bar[XB_XSUB(bx_)], 1u);
        const unsigned gen = old / nloc;
        if (old + 1u == (gen + 1u) * nloc) {
            __builtin_amdgcn_fence(__ATOMIC_RELEASE, "agent");
            asm volatile("s_waitcnt vmcnt(0)" ::: "memory");
            const unsigned og = xb_add(&bar[XB_TOP], 1u);
            const unsigned tg = og / nx;
            if (og + 1u == (tg + 1u) * nx) xb_add(&bar[XB_TOPGEN], 1u);
            else XB_SPIN(xb_ld(&bar[XB_TOPGEN]) == tg, bar);
            __builtin_amdgcn_fence(__ATOMIC_ACQUIRE, "agent");
            xb_add(&bar[XB_XGEN(bx_)], 1u);
            asm volatile("s_waitcnt vmcnt(0)" ::: "memory");
        } else {
            XB_SPIN(xb_ld(&bar[XB_XGEN(bx_)]) == gen, bar);
            __builtin_amdgcn_fence(__ATOMIC_ACQUIRE, "agent");
            asm volatile("s_waitcnt vmcnt(0)" ::: "memory");
        }
    }
    __syncthreads();
}
constexpr int NWAVES = 8;
constexpr int NB = 4, SEQ = 8192, T = NB * SEQ, D = 1024, DEPTH = 2;
constexpr int NCHUNK = 2, TC = T / NCHUNK, BPC = NB / NCHUNK;
constexpr int INC = 8192;
constexpr int MEML = 256, MH = 4, MHD = 128;
constexpr int NE = 16, FF = 512;
constexpr int XG_ROWS = 2 * T + NE * 256;
constexpr int MAXTILES = XG_ROWS / 256;
constexpr float LN_EPS = 1e-5f, RMS_EPS = 1e-5f;
constexpr float ALPHA = 1.4142135623730951f;
constexpr int GRID = 256;

constexpr size_t MiB = 1u << 20;
constexpr size_t WS_CTL = 0, CTL_ZERO_BYTES = 1 * MiB;
constexpr size_t WS_WRH = 1 * MiB, WS_WRL = WS_WRH + 32768;
constexpr size_t WS_WKV = 2 * MiB;
constexpr size_t WS_MEMB = 6 * MiB;
constexpr size_t WS_MEMKV = 8 * MiB;
constexpr size_t WS_COS = 12 * MiB, WS_SIN = 16 * MiB;
constexpr size_t WS_TOKPOS = 20 * MiB;
constexpr size_t WS_TOKW = WS_TOKPOS + 256 * 1024;
constexpr size_t WS_ROWINFO = WS_TOKW + 256 * 1024;
constexpr size_t WS_ROWW = WS_ROWINFO + 512 * 1024;
constexpr size_t WS_W = 22 * MiB;
constexpr size_t WS_WIN = WS_W, WS_WA = WS_WIN + 16 * MiB, WS_WC = WS_WA + 2 * MiB, WS_WM = WS_WC + 1 * MiB, WS_WO = WS_WM + 1 * MiB, WS_WGU = WS_WO + 2 * MiB, WS_WD = WS_WGU + 32 * MiB;
constexpr size_t WS_XB = 92 * MiB;
static_assert(WS_WD + 16 * MiB == WS_XB, "weights end at xb");
constexpr size_t WS_AREA = 156 * MiB;
constexpr size_t WS_Q = WS_AREA, WS_K = WS_Q + 32 * MiB, WS_V = WS_K + 32 * MiB, WS_CB = WS_V + 32 * MiB, WS_Z = WS_CB + 16 * MiB, WS_QM = WS_Z + 16 * MiB, WS_G = WS_QM + 16 * MiB,
                 WS_O1 = WS_G + 96 * MiB, WS_O2 = WS_O1 + 32 * MiB, WS_CH_END = WS_O2 + 32 * MiB;
constexpr size_t WS_YATT = WS_Q, WS_MERGED = WS_K, WS_MIX = WS_V;
constexpr size_t WS_XG = WS_AREA, WS_H = WS_XG + (size_t)XG_ROWS * 1024 * 2, WS_YC = WS_H + (size_t)XG_ROWS * 512 * 2, WS_MOE_END = WS_YC + (size_t)2 * T * 1024 * 2;
constexpr size_t WS_END = 512 * MiB;
static_assert(WS_CH_END <= WS_END && WS_MOE_END <= WS_END, "d_ws map");
constexpr int CW_TMO = 0, CW_CODE = 1, CW_FAIL = 2;
constexpr int CW_BAR = 4096;
constexpr int CW_CNT = 16384;

constexpr int RING_OFF = 0, RING_BYTES = 143360;
constexpr int LDSCTL_OFF = RING_BYTES, MISC_OFF = LDSCTL_OFF + 320, TILEE_OFF = LDSCTL_OFF + 1024;
constexpr int LDS_BYTES = 147456;
static_assert(TILEE_OFF + MAXTILES * 4 + 256 <= LDS_BYTES, "LDS map");

struct Frame {
    LAS unsigned char* lds;
    volatile LAS unsigned* MISC;
    gu32* ctl;
    unsigned char* ws;
    int tid, lane, wave, vcu, G, bx;
};
__device__ __forceinline__ float wave_sum(float v) {
#pragma unroll
    for (int o = 1; o < 64; o <<= 1) v += __shfl_xor(v, o);
    return v;
}
__device__ __forceinline__ float bfl(unsigned w) { return __uint_as_float(w << 16); }
__device__ __forceinline__ float bfh(unsigned w) { return __uint_as_float(w & 0xffff0000u); }

__device__ __forceinline__ void transpose_item(const float* W, int ldw, int k0, int nsrc, bf16* WT, int ldk, int ndst, LAS float* scr, int lane) {
#pragma unroll 8
    for (int i = 0; i < 32; ++i) { const int kk = 2 * i + (lane >> 5); scr[kk * 33 + (lane & 31)] = W[(size_t)(k0 + kk) * ldw + nsrc + (lane & 31)]; }
    LDS_WAIT(); asm volatile("" ::: "memory");
    const int c = lane & 7;
#pragma unroll
    for (int j = 0; j < 4; ++j) { const int n = (lane >> 3) + 8 * j; const LAS float* s = scr + (8 * c) * 33 + n;
        v4u o; o.x = pk2(s[0 * 33], s[1 * 33]); o.y = pk2(s[2 * 33], s[3 * 33]); o.z = pk2(s[4 * 33], s[5 * 33]); o.w = pk2(s[6 * 33], s[7 * 33]);
        *(GAS v4u*)(WT + (size_t)(ndst + n) * ldk + k0 + 8 * c) = o; }
    LDS_WAIT(); asm volatile("" ::: "memory");
}
struct Args { const void* in[24]; float* out; unsigned char* ws; int ph_lo, ph_hi; };
static_assert(sizeof(Args) == 24 * 8 + 8 + 8 + 8, "no padding in Args");
__device__ __forceinline__ const void* lptr(const void* p) { const GAS unsigned char* g = (const GAS unsigned char*)p; asm volatile("" : "+s"(g)); return (const void*)g; }
__device__ __forceinline__ unsigned char* lws(unsigned char* p) { GAS unsigned char* g = (GAS unsigned char*)p; asm volatile("" : "+s"(g)); return (unsigned char*)g; }
#define INF(k) ((const float*)lptr(A.in[k]))
#define INI(k) ((const int*)lptr(A.in[k]))

__device__ __forceinline__ void convert_layer_weights(Frame& F, const Args& A, int l) {
    LAS float* scr = (LAS float*)(F.lds + RING_OFF + F.wave * 16384);
    const int gw = F.vcu * NWAVES + F.wave, NGW = F.G * NWAVES;
    unsigned char* const ws = lws(F.ws);
    bf16* Win_t = (bf16*)(ws + WS_WIN); bf16* Wa_t = (bf16*)(ws + WS_WA); bf16* Wc_t = (bf16*)(ws + WS_WC); bf16* Wm_t = (bf16*)(ws + WS_WM);
    bf16* Wo_t = (bf16*)(ws + WS_WO); bf16* Wgu_t = (bf16*)(ws + WS_WGU); bf16* Wd_t = (bf16*)(ws + WS_WD);
    const float* w_in = INF(3) + (size_t)l * D * INC;
    constexpr int I_IN = 16 * 256, I_A = 16 * 32, I_C = 8 * 32, I_O = 16 * 32, I_GU = NE * 16 * 32, I_D = NE * 8 * 32;
    constexpr int NITEMS = I_IN + I_A + 2 * I_C + I_O + I_GU + I_D;
    for (int it = gw; it < NITEMS; it += NGW) {
        int r = it;
        if (r < I_IN) { const int kb = r >> 8, n0 = (r & 255) * 32, pn = n0 >> 8, p = n0 & 255; int src;
            if (pn < 8) src = 256 * pn + 64 * ((p >> 5) & 3) + 32 * (p >> 7);
            else if (pn >= 14 && pn < 18) src = (p < 128 ? 3584 : 4096) + 128 * (pn - 14) + (p & 127);
            else src = n0;
            transpose_item(w_in, INC, kb * 64, src, Win_t, 1024, n0, scr, F.lane); continue; }
        r -= I_IN;
        if (r < I_A) { transpose_item(INF(11) + (size_t)l * 1024 * 1024, 1024, (r >> 5) * 64, (r & 31) * 32, Wa_t, 1024, (r & 31) * 32, scr, F.lane); continue; }
        r -= I_A;
        if (r < I_C) { transpose_item(INF(12) + (size_t)l * 512 * 1024, 1024, (r >> 5) * 64, (r & 31) * 32, Wc_t, 512, (r & 31) * 32, scr, F.lane); continue; }
        r -= I_C;
        if (r < I_C) { transpose_item(INF(13) + (size_t)l * 512 * 1024, 1024, (r >> 5) * 64, (r & 31) * 32, Wm_t, 512, (r & 31) * 32, scr, F.lane); continue; }
        r -= I_C;
        if (r < I_O) { transpose_item(INF(14) + (size_t)l * 1024 * 1024, 1024, (r >> 5) * 64, (r & 31) * 32, Wo_t, 1024, (r & 31) * 32, scr, F.lane); continue; }
        r -= I_O;
        if (r < I_GU) { const int e = r >> 9, q = r & 511, kb = q >> 5, n0 = (q & 31) * 32, pnl = n0 >> 8, p = n0 & 255;
            const float* src = (p < 128 ? INF(21) : INF(22)) + (size_t)(l * NE + e) * 1024 * 512;
            transpose_item(src, 512, kb * 64, 128 * pnl + (p & 127), Wgu_t + (size_t)e * 1024 * 1024, 1024, n0, scr, F.lane); continue; }
        r -= I_GU;
        { const int e = r >> 8, q = r & 255; transpose_item(INF(23) + (size_t)(l * NE + e) * 512 * 1024, 1024, (q >> 5) * 64, (q & 31) * 32, Wd_t + (size_t)e * 1024 * 512, 512, (q & 31) * 32, scr, F.lane); }
    }
}

__device__ __forceinline__ void row_to_bf16(const float* xrow, bf16* orow, int lane) {
    const GAS f32x4* xr = (const GAS f32x4*)xrow + lane; GAS unsigned long long* o8 = (GAS unsigned long long*)orow + lane;
#pragma unroll
    for (int j = 0; j < 4; ++j) { const f32x4 v = xr[64 * j]; o8[64 * j] = (unsigned long long)pk2(v.x, v.y) | ((unsigned long long)pk2(v.z, v.w) << 32); }
}

__device__ __forceinline__ void p0_prologue(Frame& F, const Args& A) {
    const int gw = F.vcu * NWAVES + F.wave, NGW = F.G * NWAVES;
    unsigned char* const ws = lws(F.ws);
    convert_layer_weights(F, A, 0);
    {
        LAS float* scr = (LAS float*)(F.lds + RING_OFF + F.wave * 16384); bf16* Wkv_t = (bf16*)(ws + WS_WKV);
        for (int it = gw; it < 2 * 512; it += NGW) { const int l = it >> 9, r = it & 511;
            transpose_item(INF(10) + (size_t)l * 1024 * 1024, 1024, (r >> 5) * 64, (r & 31) * 32, Wkv_t + (size_t)l * 1024 * 1024, 1024, (r & 31) * 32, scr, F.lane); }
    }
    bf16* XBp = (bf16*)(ws + WS_XB); bf16* MEMB = (bf16*)(ws + WS_MEMB);
    for (int m = gw; m < T; m += NGW) row_to_bf16(INF(0) + (size_t)m * D, XBp + (size_t)m * D, F.lane);
    for (int m = gw; m < NB * MEML; m += NGW) row_to_bf16(INF(1) + (size_t)m * D, MEMB + (size_t)m * D, F.lane);
    {
        float* cosT = (float*)(ws + WS_COS); float* sinT = (float*)(ws + WS_SIN);
        const int gt = F.vcu * (NWAVES * 64) + F.tid, NGT = F.G * NWAVES * 64;
        for (int i = gt; i < T * 32; i += NGT) { const int t = i >> 5, d = i & 31;
            const float inv = (float)exp2(-(double)d * (13.287712379549449 / 32.0));
            const float ang = (float)INI(2)[t] * inv;
            const double a = (double)ang; const double n = rint(a * 0.15915494309189535); const float r = (float)(a - n * 6.283185307179586);
            cosT[i] = cosf(r); sinT[i] = sinf(r); }
        bf16* WRH = (bf16*)(ws + WS_WRH); bf16* WRL = (bf16*)(ws + WS_WRL);
        for (int i = gt; i < 32 * 64 * 8; i += NGT) { const int j = i & 7, L = (i >> 3) & 63, ks = i >> 9;
            const float w = INF(19)[(size_t)(32 * ks + 8 * (L >> 4) + j) * NE + (L & 15)]; const unsigned h = f2bf(w); const float rem = w - __uint_as_float(h << 16);
            WRH[i] = (bf16)h; WRL[i] = (bf16)f2bf(rem); }
    }
}

namespace memattn {
typedef short bf16x8 __attribute__((ext_vector_type(8)));
typedef short s16x4 __attribute__((ext_vector_type(4)));
typedef float f32x16 __attribute__((ext_vector_type(16)));
constexpr int KS_STRIDE = 272, VT_STRIDE = 528, LDS_VT = 256 * KS_STRIDE, LDS_TOTAL = LDS_VT + 128 * VT_STRIDE;
__device__ __forceinline__ void unit(int bglob, int blocal, int hm, int qblk, bf16* QM, const bf16* KV, int ldkv, LAS unsigned char* lds) {
    int tid_ = threadIdx.x; asm volatile("" : "+v"(tid_)); const int tid = tid_, lane = tid & 63, r32 = lane & 31, hi = lane >> 5, wid = tid >> 6;
#pragma unroll
    for (int j = 0; j < 8; ++j) { const int id = tid + 512 * j, key = id >> 4, ch = id & 15;
        const v4u v = *(const v4u*)(KV + (size_t)(bglob * MEML + key) * ldkv + hm * MHD + ch * 8);
        *(LAS v4u*)(lds + key * KS_STRIDE + ch * 16) = v; }
#pragma unroll
    for (int j = 0; j < 8; ++j) { const int id = tid + 512 * j, key = id >> 4, ch = id & 15;
        const v4u v = *(const v4u*)(KV + (size_t)(bglob * MEML + key) * ldkv + 512 + hm * MHD + ch * 8);
        const unsigned w[4] = {v.x, v.y, v.z, v.w};
#pragma unroll
        for (int e = 0; e < 8; ++e) *(LAS unsigned short*)(lds + LDS_VT + (ch * 8 + e) * VT_STRIDE + key * 2) = (unsigned short)((w[e >> 1] >> (16 * (e & 1))) & 0xffffu); }
    bf16* qrow = QM + (size_t)(blocal * SEQ + qblk * 256 + wid * 32 + r32) * 512 + hm * MHD;
    bf16x8 qf[8];
#pragma unroll
    for (int ks = 0; ks < 8; ++ks) qf[ks] = *(const bf16x8*)(qrow + 16 * ks + 8 * hi);
    __syncthreads();
    f32x16 p[8];
#pragma unroll
    for (int kb = 0; kb < 8; ++kb) { p[kb] = (f32x16){};
#pragma unroll
        for (int ks = 0; ks < 8; ++ks) { const bf16x8 kf = *(const LAS bf16x8*)(lds + (32 * kb + r32) * KS_STRIDE + (16 * ks + 8 * hi) * 2);
            p[kb] = __builtin_amdgcn_mfma_f32_32x32x16_bf16(kf, qf[ks], p[kb], 0, 0, 0); } }
    float m = -INFINITY;
#pragma unroll
    for (int kb = 0; kb < 8; ++kb)
#pragma unroll
        for (int r = 0; r < 16; ++r) m = fmaxf(m, p[kb][r]);
    m = fmaxf(m, __shfl_xor(m, 32));
    float l = 0.f;
#pragma unroll
    for (int kb = 0; kb < 8; ++kb)
#pragma unroll
        for (int r = 0; r < 16; ++r) { const float e = __builtin_amdgcn_exp2f(p[kb][r] - m); p[kb][r] = e; l += e; }
    l += __shfl_xor(l, 32);
    bf16x8 pf[8][2];
#pragma unroll
    for (int kb = 0; kb < 8; ++kb)
#pragma unroll
        for (int s = 0; s < 2; ++s) { v4u w; w.x = pg8::cvt_pk_bf16(p[kb][8 * s + 0], p[kb][8 * s + 1]); w.y = pg8::cvt_pk_bf16(p[kb][8 * s + 2], p[kb][8 * s + 3]);
            w.z = pg8::cvt_pk_bf16(p[kb][8 * s + 4], p[kb][8 * s + 5]); w.w = pg8::cvt_pk_bf16(p[kb][8 * s + 6], p[kb][8 * s + 7]); pf[kb][s] = __builtin_bit_cast(bf16x8, w); }
    f32x16 o[4];
#pragma unroll
    for (int db = 0; db < 4; ++db) { o[db] = (f32x16){};
#pragma unroll
        for (int kb = 0; kb < 8; ++kb)
#pragma unroll
            for (int s = 0; s < 2; ++s) { const LAS unsigned char* vp = lds + LDS_VT + (32 * db + r32) * VT_STRIDE + (32 * kb + 16 * s + 4 * hi) * 2;
                const s16x4 a = *(const LAS s16x4*)vp, b = *(const LAS s16x4*)(vp + 16);
                const bf16x8 vf = (bf16x8){a[0], a[1], a[2], a[3], b[0], b[1], b[2], b[3]};
                o[db] = __builtin_amdgcn_mfma_f32_32x32x16_bf16(vf, pf[kb][s], o[db], 0, 0, 0); } }
    const float rl = 1.0f / l;
#pragma unroll
    for (int db = 0; db < 4; ++db)
#pragma unroll
        for (int g = 0; g < 4; ++g) { const unsigned lo = pk2(o[db][4 * g] * rl, o[db][4 * g + 1] * rl), hi2 = pk2(o[db][4 * g + 2] * rl, o[db][4 * g + 3] * rl);
            *(unsigned long long*)(qrow + 32 * db + 8 * g + 4 * hi) = (unsigned long long)lo | ((unsigned long long)hi2 << 32); }
    __syncthreads();
}
}

#define XB ((bf16*)(ws + WS_XB))
#define Qb ((bf16*)(ws + WS_Q))
#define Kb ((bf16*)(ws + WS_K))
#define Vb ((bf16*)(ws + WS_V))
#define CBb ((bf16*)(ws + WS_CB))
#define Zb ((bf16*)(ws + WS_Z))
#define QMb ((bf16*)(ws + WS_QM))
#define Gb ((bf16*)(ws + WS_G))
#define O1b ((bf16*)(ws + WS_O1))
#define O2b ((bf16*)(ws + WS_O2))
#define YATT ((bf16*)(ws + WS_YATT))
#define MERGED ((bf16*)(ws + WS_MERGED))
#define MIX ((bf16*)(ws + WS_MIX))
#define XG ((bf16*)(ws + WS_XG))
#define Hb ((bf16*)(ws + WS_H))
#define YC ((bf16*)(ws + WS_YC))
#define TOKPOS ((unsigned*)(ws + WS_TOKPOS))
#define TOKW ((float*)(ws + WS_TOKW))
#define ROWINFO ((int*)(ws + WS_ROWINFO))
#define ROWW ((float*)(ws + WS_ROWW))
#define MEMKV ((const bf16*)(ws + WS_MEMKV))
__global__ void __launch_bounds__(NWAVES * 64, 2) mega_fwd(Args A) {
    extern __shared__ __attribute__((aligned(16))) unsigned char lds[];
    Frame F;
    F.lds = (LAS unsigned char*)lds;
    F.MISC = (volatile LAS unsigned*)(F.lds + MISC_OFF);
    F.tid = threadIdx.x; F.lane = F.tid & 63; F.wave = __builtin_amdgcn_readfirstlane(F.tid >> 6);
    F.G = gridDim.x; { const int bx = blockIdx.x; F.bx = bx; F.vcu = (F.G % 8 == 0) ? (bx % 8) * (F.G / 8) + bx / 8 : bx; }
    F.ws = A.ws; F.ctl = (gu32*)(A.ws + WS_CTL);
    if (F.G != GRID) return;
    for (int u = F.tid; u < (LDS_BYTES - LDSCTL_OFF) / 4; u += NWAVES * 64) ((LAS unsigned*)(F.lds + LDSCTL_OFF))[u] = 0u;
    __syncthreads();
    const int lo = A.ph_lo, hi = A.ph_hi;
    const bool single = (hi - lo) > 1;
    XcdBarrier bar; bar.bar = (unsigned*)(F.ctl + CW_BAR); bar.x = 0; bar.st = nullptr;
    if (single) bar = xcd_barrier_post((unsigned*)(F.ctl + CW_BAR), F.MISC + 8);
    int ph = 0;
#define PH_BEGIN if (ph >= lo && ph < hi) { asm volatile("" : "+v"(F.tid), "+v"(F.lane), "+s"(F.wave), "+s"(F.vcu), "+s"(F.bx), "+s"(F.ctl), "+s"(F.lds)); unsigned char* const ws = lws(F.ws); float* const OUT = (float*)lptr(A.out); const int gw = F.vcu * NWAVES + F.wave, NGW = F.G * NWAVES; (void)ws; (void)OUT; (void)gw; (void)NGW;
#define PH_END   if (ph + 1 < hi) xcd_barrier(bar); } ++ph;

    PH_BEGIN p0_prologue(F, A); PH_END

    for (int lc = 0; lc < DEPTH * NCHUNK; ++lc) {
        const int l = lc >> 1, c = lc & 1;
        const size_t tok0 = (size_t)c * TC;
        const float lam_init = (l == 0) ? 0.2f : 0.35550906758f;

        PH_BEGIN
            {
                pg8::Gemm g{XB + tok0 * D, (const bf16*)(ws + WS_WIN), TC, INC, D}; pg8::StaticOrder S; S.init(TC, INC, F.G, F.bx);
                pg8::EpiP1 E{Qb, Kb, Vb, CBb, Zb, QMb, Gb, (const float*)(ws + WS_COS) + tok0 * 32, (const float*)(ws + WS_SIN) + tok0 * 32};
                pg8::gemm_phase<pg8::EpiP1, pg8::StaticOrder, true, true>(F.lds + RING_OFF, g, S, E);
            }
            if (lc == 0) {
                __syncthreads();
                pg8::Gemm g{(const bf16*)(ws + WS_MEMB), (const bf16*)(ws + WS_WKV), NB * MEML, 2048, D}; pg8::StaticOrder S; S.init(NB * MEML, 2048, F.G, F.bx);
                pg8::EpiBf16<0> E{(bf16*)(ws + WS_MEMKV), 2048, nullptr, 0, 0, 1.f};
                pg8::gemm_phase<pg8::EpiBf16<0>, pg8::StaticOrder, true, true>(F.lds + RING_OFF, g, S, E);
            }
        PH_END

        PH_BEGIN
            {
                const attn_body::DiffTensors AT{(const attn_body::bf16*)Qb, (const attn_body::bf16*)Kb, (const attn_body::bf16*)Vb, (attn_body::bf16*)O1b, (attn_body::bf16*)O2b};
                attn_body::diff_attn_phase<8>((char*)lds + RING_OFF, AT, F.vcu);
            }
            __syncthreads();
            { const int v = F.vcu; memattn::unit(c * BPC + (v >> 7), v >> 7, (v >> 5) & 3, v & 31, QMb, MEMKV + l * 1024, 2048, F.lds + RING_OFF); }
        PH_END

        PH_BEGIN
            {
                const float a1 = wave_sum(INF(4)[l * 64 + F.lane] * INF(5)[l * 64 + F.lane]), a2 = wave_sum(INF(6)[l * 64 + F.lane] * INF(7)[l * 64 + F.lane]);
                const float lam = expf(a1) - expf(a2) + lam_init, osc = 1.0f - lam_init;
                const int L = F.lane;
                float gs[16];
#pragma unroll
                for (int j = 0; j < 16; ++j) gs[j] = INF(8)[l * 128 + ((16 * L + j) & 127)] * osc;
                float cw0[8], cw1[8], cw2[8];
#pragma unroll
                for (int j = 0; j < 8; ++j) { cw0[j] = INF(9)[(l * 3 + 0) * 512 + 8 * L + j]; cw1[j] = INF(9)[(l * 3 + 1) * 512 + 8 * L + j]; cw2[j] = INF(9)[(l * 3 + 2) * 512 + 8 * L + j]; }
                for (int r = gw; r < TC; r += NGW) {
                    {
                        const v4u a0 = *(const v4u*)(O1b + (size_t)r * 1024 + 16 * L), a1v = *(const v4u*)(O1b + (size_t)r * 1024 + 16 * L + 8);
                        const v4u b0 = *(const v4u*)(O2b + (size_t)r * 1024 + 16 * L), b1v = *(const v4u*)(O2b + (size_t)r * 1024 + 16 * L + 8);
                        const unsigned aw[8] = {a0.x, a0.y, a0.z, a0.w, a1v.x, a1v.y, a1v.z, a1v.w}, bw[8] = {b0.x, b0.y, b0.z, b0.w, b1v.x, b1v.y, b1v.z, b1v.w};
                        float o[16]; float ss = 0.f;
#pragma unroll
                        for (int j = 0; j < 8; ++j) { o[2 * j] = bfl(aw[j]) - lam * bfl(bw[j]); o[2 * j + 1] = bfh(aw[j]) - lam * bfh(bw[j]); ss += o[2 * j] * o[2 * j] + o[2 * j + 1] * o[2 * j + 1]; }
                        ss += __shfl_xor(ss, 1); ss += __shfl_xor(ss, 2); ss += __shfl_xor(ss, 4);
                        const float rs = 1.0f / sqrtf(ss * (1.0f / 128.0f) + RMS_EPS);
                        v4u w0, w1;
                        w0.x = pk2(o[0] * rs * gs[0], o[1] * rs * gs[1]); w0.y = pk2(o[2] * rs * gs[2], o[3] * rs * gs[3]); w0.z = pk2(o[4] * rs * gs[4], o[5] * rs * gs[5]); w0.w = pk2(o[6] * rs * gs[6], o[7] * rs * gs[7]);
                        w1.x = pk2(o[8] * rs * gs[8], o[9] * rs * gs[9]); w1.y = pk2(o[10] * rs * gs[10], o[11] * rs * gs[11]); w1.z = pk2(o[12] * rs * gs[12], o[13] * rs * gs[13]); w1.w = pk2(o[14] * rs * gs[14], o[15] * rs * gs[15]);
                        *(v4u*)(YATT + (size_t)r * 1024 + 16 * L) = w0; *(v4u*)(YATT + (size_t)r * 1024 + 16 * L + 8) = w1;
                    }
                    {
                        const int s = r & (SEQ - 1);
                        const v4u z0 = *(const v4u*)(Zb + (size_t)r * 512 + 8 * L);
                        v4u z1 = (v4u){0u, 0u, 0u, 0u}, z2 = (v4u){0u, 0u, 0u, 0u};
                        if (s >= 1) z1 = *(const v4u*)(Zb + (size_t)(r - 1) * 512 + 8 * L);
                        if (s >= 2) z2 = *(const v4u*)(Zb + (size_t)(r - 2) * 512 + 8 * L);
                        const v4u cb = *(const v4u*)(CBb + (size_t)r * 512 + 8 * L);
                        const unsigned z0w[4] = {z0.x, z0.y, z0.z, z0.w}, z1w[4] = {z1.x, z1.y, z1.z, z1.w}, z2w[4] = {z2.x, z2.y, z2.z, z2.w}, cbw[4] = {cb.x, cb.y, cb.z, cb.w};
                        unsigned ow[4];
#pragma unroll
                        for (int j = 0; j < 4; ++j) {
                            const float ylo = bfl(cbw[j]) * (cw0[2 * j] * bfl(z2w[j]) + cw1[2 * j] * bfl(z1w[j]) + cw2[2 * j] * bfl(z0w[j]));
                            const float yhi = bfh(cbw[j]) * (cw0[2 * j + 1] * bfh(z2w[j]) + cw1[2 * j + 1] * bfh(z1w[j]) + cw2[2 * j + 1] * bfh(z0w[j]));
                            ow[j] = pk2(ylo, yhi); }
                        *(v4u*)(CBb + (size_t)r * 512 + 8 * L) = (v4u){ow[0], ow[1], ow[2], ow[3]};
                    }
                }
                if (c == 0) { const int gt = F.vcu * (NWAVES * 64) + F.tid; for (int i = gt; i < XG_ROWS; i += F.G * NWAVES * 64) ROWINFO[i] = -1; }
            }
        PH_END

        PH_BEGIN
            {
                pg8::StaticOrder S; S.init(TC, D, F.G, F.bx);
                { pg8::Gemm g{YATT, (const bf16*)(ws + WS_WA), TC, D, 1024}; pg8::EpiGate<true> E{MERGED, Gb, 0};
                  pg8::gemm_phase<pg8::EpiGate<true>, pg8::StaticOrder, true, true>(F.lds + RING_OFF, g, S, E); }
                asm volatile("s_waitcnt vmcnt(0)" ::: "memory"); __syncthreads();
                { pg8::Gemm g{CBb, (const bf16*)(ws + WS_WC), TC, D, 512}; pg8::EpiGate<false> E{MERGED, Gb, 1};
                  pg8::gemm_phase<pg8::EpiGate<false>, pg8::StaticOrder, true, true>(F.lds + RING_OFF, g, S, E); }
                asm volatile("s_waitcnt vmcnt(0)" ::: "memory"); __syncthreads();
                { pg8::Gemm g{QMb, (const bf16*)(ws + WS_WM), TC, D, 512}; pg8::EpiGate<false> E{MERGED, Gb, 2};
                  pg8::gemm_phase<pg8::EpiGate<false>, pg8::StaticOrder, true, true>(F.lds + RING_OFF, g, S, E); }
            }
        PH_END

        PH_BEGIN
            {
                pg8::Gemm g{MERGED, (const bf16*)(ws + WS_WO), TC, D, D}; pg8::StaticOrder S; S.init(TC, D, F.G, F.bx);
                pg8::EpiBf16<0> E{MIX, D, nullptr, 0, 0, 1.f};
                pg8::gemm_phase<pg8::EpiBf16<0>, pg8::StaticOrder, true, true>(F.lds + RING_OFF, g, S, E);
            }
        PH_END

        PH_BEGIN
            {
                LAS unsigned* lcnt = (LAS unsigned*)(F.lds + RING_OFF);
                LAS unsigned* rec = (LAS unsigned*)(F.lds + RING_OFF + 256);
                if (F.tid < 32) lcnt[F.tid] = 0u;
                __syncthreads();
                const float* xin = (l == 0) ? INF(0) : (const float*)OUT;
                const float* g1 = INF(15) + l * D; const float* b1 = INF(16) + l * D;
                const int rbase = gw * 8;
                for (int i = 0; i < 8; ++i) {
                    const size_t t = tok0 + rbase + i; const int r = rbase + i;
                    const GAS f32x4* xr = (const GAS f32x4*)(xin + t * D) + F.lane; const GAS unsigned long long* mr = (const GAS unsigned long long*)(MIX + (size_t)r * D) + F.lane;
                    f32x4 v[4]; float s = 0.f;
#pragma unroll
                    for (int j = 0; j < 4; ++j) { const f32x4 xv = xr[64 * j]; const unsigned long long mw = mr[64 * j]; const unsigned m0 = (unsigned)mw, m1 = (unsigned)(mw >> 32);
                        v[j] = (f32x4){ALPHA * xv.x + bfl(m0), ALPHA * xv.y + bfh(m0), ALPHA * xv.z + bfl(m1), ALPHA * xv.w + bfh(m1)}; s += (v[j].x + v[j].y) + (v[j].z + v[j].w); }
                    const float mean = wave_sum(s) * (1.f / D); float s2 = 0.f;
#pragma unroll
                    for (int j = 0; j < 4; ++j) { v[j] = v[j] - mean; s2 += (v[j].x * v[j].x + v[j].y * v[j].y) + (v[j].z * v[j].z + v[j].w * v[j].w); }
                    const float rstd = 1.f / sqrtf(wave_sum(s2) * (1.f / D) + LN_EPS);
                    GAS f32x4* orow = (GAS f32x4*)(OUT + t * D) + F.lane; GAS unsigned long long* o8 = (GAS unsigned long long*)(XB + t * D) + F.lane;
#pragma unroll
                    for (int j = 0; j < 4; ++j) { const f32x4 gg = *((const GAS f32x4*)g1 + F.lane + 64 * j), bb = *((const GAS f32x4*)b1 + F.lane + 64 * j);
                        const f32x4 y = v[j] * rstd * gg + bb; orow[64 * j] = y; o8[64 * j] = (unsigned long long)pk2(y.x, y.y) | ((unsigned long long)pk2(y.z, y.w) << 32); }
                }
                asm volatile("s_waitcnt vmcnt(0)" ::: "memory");
                {
                    const int tt = F.lane & 15, kg = F.lane >> 4; const size_t t = tok0 + rbase + (tt & 7);
                    const float* yrow = OUT + t * D + 8 * kg; const bf16* WRH = (const bf16*)(ws + WS_WRH) + F.lane * 8; const bf16* WRL = (const bf16*)(ws + WS_WRL) + F.lane * 8;
                    f32x4 acc = (f32x4){0.f, 0.f, 0.f, 0.f};
#pragma unroll 4
                    for (int ks = 0; ks < 32; ++ks) {
                        const f32x4 y0 = __builtin_nontemporal_load((const f32x4*)(yrow + 32 * ks)), y1 = __builtin_nontemporal_load((const f32x4*)(yrow + 32 * ks + 4));
                        const float yv[8] = {y0.x, y0.y, y0.z, y0.w, y1.x, y1.y, y1.z, y1.w}; unsigned hw[4], lw[4];
#pragma unroll
                        for (int j = 0; j < 4; ++j) { const unsigned h0 = f2bf(yv[2 * j]), h1 = f2bf(yv[2 * j + 1]);
                            hw[j] = h0 | (h1 << 16); lw[j] = f2bf(yv[2 * j] - __uint_as_float(h0 << 16)) | (f2bf(yv[2 * j + 1] - __uint_as_float(h1 << 16)) << 16); }
                        const bf16x8 yh = __builtin_bit_cast(bf16x8, (v4u){hw[0], hw[1], hw[2], hw[3]}), yl = __builtin_bit_cast(bf16x8, (v4u){lw[0], lw[1], lw[2], lw[3]});
                        const bf16x8 wh = *(const bf16x8*)(WRH + ks * 512), wl = *(const bf16x8*)(WRL + ks * 512);
                        acc = __builtin_amdgcn_mfma_f32_16x16x32_bf16(wh, yh, acc, 0, 0, 0);
                        acc = __builtin_amdgcn_mfma_f32_16x16x32_bf16(wl, yh, acc, 0, 0, 0);
                        acc = __builtin_amdgcn_mfma_f32_16x16x32_bf16(wh, yl, acc, 0, 0, 0);
                    }
                    float lg[4];
#pragma unroll
                    for (int j = 0; j < 4; ++j) lg[j] = acc[j] + INF(20)[4 * kg + j];
                    int a1i = 0; float l1 = lg[0];
#pragma unroll
                    for (int j = 1; j < 4; ++j) if (lg[j] > l1) { l1 = lg[j]; a1i = j; }
                    int a2i = -1; float l2 = -INFINITY;
#pragma unroll
                    for (int j = 0; j < 4; ++j) if (j != a1i && lg[j] > l2) { l2 = lg[j]; a2i = j; }
                    bool win = true;
#pragma unroll
                    for (int x = 1; x < 4; ++x) { const float om = __shfl_xor(l1, 16 * x); const int og = kg ^ x; if (om > l1 || (om == l1 && og < kg)) win = false; }
                    if (win && tt < 8) {
                        const int e1 = 4 * kg + a1i, e2 = 4 * kg + a2i; const float ex = expf(l2 - l1), w1 = 1.0f / (1.0f + ex), w2 = ex / (1.0f + ex);
                        const unsigned p1 = atomicAdd((unsigned*)&lcnt[e1], 1u), p2 = atomicAdd((unsigned*)&lcnt[e2], 1u);
                        LAS unsigned* rc = rec + (F.wave * 8 + tt) * 6; rc[0] = (unsigned)e1; rc[1] = p1; rc[2] = (unsigned)e2; rc[3] = p2; rc[4] = __float_as_uint(w1); rc[5] = __float_as_uint(w2);
                    }
                }
                __syncthreads();
                if (F.tid < 16) lcnt[16 + F.tid] = __hip_atomic_fetch_add(F.ctl + CW_CNT + (l * 16 + F.tid) * 64, lcnt[F.tid], __ATOMIC_RELAXED, __HIP_MEMORY_SCOPE_AGENT);
                __syncthreads();
                if (F.tid < 64) { const LAS unsigned* rc = rec + F.tid * 6; const size_t t = tok0 + (size_t)(F.vcu * NWAVES + (F.tid >> 3)) * 8 + (F.tid & 7);
                    TOKPOS[2 * t] = (rc[0] << 24) | (lcnt[16 + rc[0]] + rc[1]); TOKPOS[2 * t + 1] = (rc[2] << 24) | (lcnt[16 + rc[2]] + rc[3]);
                    TOKW[2 * t] = __uint_as_float(rc[4]); TOKW[2 * t + 1] = __uint_as_float(rc[5]); }
                __syncthreads();
            }
        PH_END

        if (c == NCHUNK - 1) {
            PH_BEGIN
                {
                    LAS unsigned* pst = (LAS unsigned*)(F.lds + RING_OFF);
                    if (F.tid == 0) { unsigned a = 0; for (int e = 0; e < NE; ++e) { pst[e] = a; const unsigned n = __hip_atomic_load(F.ctl + CW_CNT + (l * 16 + e) * 64, __ATOMIC_RELAXED, __HIP_MEMORY_SCOPE_AGENT); a += (n + 255u) & ~255u; } }
                    __syncthreads();
                    for (int p = gw; p < 2 * T; p += NGW) {
                        const unsigned tp = TOKPOS[p]; const unsigned row = pst[tp >> 24] + (tp & 0xffffffu); const int t = p >> 1;
                        const GAS v4u* src = (const GAS v4u*)(XB + (size_t)t * D) + F.lane; GAS v4u* dst = (GAS v4u*)(XG + (size_t)row * D) + F.lane;
                        dst[0] = src[0]; dst[64] = src[64];
                        if (F.lane == 0) { ROWINFO[row] = p; ROWW[row] = TOKW[p]; }
                    }
                    __syncthreads();
                }
            PH_END

            PH_BEGIN
                {
                    LAS int* tile_e = (LAS int*)(F.lds + TILEE_OFF);
                    if (F.tid == 0) { unsigned a = 0; for (int e = 0; e < NE; ++e) { const unsigned n = __hip_atomic_load(F.ctl + CW_CNT + (l * 16 + e) * 64, __ATOMIC_RELAXED, __HIP_MEMORY_SCOPE_AGENT); const unsigned nt = (n + 255u) >> 8;
                            for (unsigned i = 0; i < nt; ++i) tile_e[a + i] = e; a += nt; } tile_e[MAXTILES] = (int)a; }
                    __syncthreads();
                    pg8::MoeOrder S{tile_e[MAXTILES], F.vcu, F.G, tile_e};
                    pg8::Gemm g{XG, (const bf16*)(ws + WS_WGU), XG_ROWS, 1024, D}; pg8::EpiSwiglu E{Hb};
                    pg8::gemm_phase<pg8::EpiSwiglu, pg8::MoeOrder, true, true>(F.lds + RING_OFF, g, S, E);
                }
            PH_END

            PH_BEGIN
                {
                    LAS int* tile_e = (LAS int*)(F.lds + TILEE_OFF);
                    __syncthreads();
                    if (F.tid == 0) { unsigned a = 0; for (int e = 0; e < NE; ++e) { const unsigned n = __hip_atomic_load(F.ctl + CW_CNT + (l * 16 + e) * 64, __ATOMIC_RELAXED, __HIP_MEMORY_SCOPE_AGENT); const unsigned nt = (n + 255u) >> 8;
                            for (unsigned i = 0; i < nt; ++i) tile_e[a + i] = e; a += nt; } tile_e[MAXTILES] = (int)a; }
                    __syncthreads();
                    pg8::MoeOrder S{tile_e[MAXTILES], F.vcu, F.G, tile_e};
                    pg8::Gemm g{Hb, (const bf16*)(ws + WS_WD), XG_ROWS, 1024, FF}; pg8::EpiScatter E{YC, ROWINFO, ROWW};
                    pg8::gemm_phase<pg8::EpiScatter, pg8::MoeOrder, true, true>(F.lds + RING_OFF, g, S, E);
                }
            PH_END

            PH_BEGIN
                {
                    const float* g2 = INF(17) + l * D; const float* b2 = INF(18) + l * D;
                    for (int t = gw; t < T; t += NGW) {
                        GAS f32x4* xr = (GAS f32x4*)(OUT + (size_t)t * D) + F.lane;
                        const GAS unsigned long long* y0 = (const GAS unsigned long long*)(YC + (size_t)(2 * t) * D) + F.lane; const GAS unsigned long long* y1 = (const GAS unsigned long long*)(YC + (size_t)(2 * t + 1) * D) + F.lane;
                        f32x4 v[4]; float s = 0.f;
#pragma unroll
                        for (int j = 0; j < 4; ++j) { const f32x4 xv = xr[64 * j]; const unsigned long long a = y0[64 * j], b = y1[64 * j]; const unsigned a0 = (unsigned)a, a1 = (unsigned)(a >> 32), b0 = (unsigned)b, b1 = (unsigned)(b >> 32);
                            v[j] = (f32x4){ALPHA * xv.x + (bfl(a0) + bfl(b0)), ALPHA * xv.y + (bfh(a0) + bfh(b0)), ALPHA * xv.z + (bfl(a1) + bfl(b1)), ALPHA * xv.w + (bfh(a1) + bfh(b1))}; s += (v[j].x + v[j].y) + (v[j].z + v[j].w); }
                        const float mean = wave_sum(s) * (1.f / D); float s2 = 0.f;
#pragma unroll
                        for (int j = 0; j < 4; ++j) { v[j] = v[j] - mean; s2 += (v[j].x * v[j].x + v[j].y * v[j].y) + (v[j].z * v[j].z + v[j].w * v[j].w); }
                        const float rstd = 1.f / sqrtf(wave_sum(s2) * (1.f / D) + LN_EPS);
                        GAS unsigned long long* o8 = (GAS unsigned long long*)(XB + (size_t)t * D) + F.lane;
#pragma unroll
                        for (int j = 0; j < 4; ++j) { const f32x4 gg = *((const GAS f32x4*)g2 + F.lane + 64 * j), bb = *((const GAS f32x4*)b2 + F.lane + 64 * j);
                            const f32x4 y = v[j] * rstd * gg + bb; xr[64 * j] = y; if (l + 1 < DEPTH) o8[64 * j] = (unsigned long long)pk2(y.x, y.y) | ((unsigned long long)pk2(y.z, y.w) << 32); }
                    }
                    if (l + 1 < DEPTH) convert_layer_weights(F, A, l + 1);
                }
            PH_END
        }
    }
#undef PH_BEGIN
#undef PH_END
}

__global__ void dump_bf16_kernel(const unsigned char* ws, size_t off, float* out) {
    const bf16* src = (const bf16*)(ws + off); const size_t n = (size_t)T * D;
#ifndef MK_DUMP_N
#define MK_DUMP_N n
#endif
    for (size_t i = (size_t)blockIdx.x * blockDim.x + threadIdx.x; i < n; i += (size_t)gridDim.x * blockDim.x) out[i] = i < (size_t)(MK_DUMP_N) ? __uint_as_float((unsigned)src[i] << 16) : 0.f;
}
constexpr int N_PHASES = 1 + DEPTH * (NCHUNK * 6 + 4);
#ifndef MK_PER_PHASE
#define MK_PER_PHASE 0
#endif
extern "C" void kernel_launch(void* const* d_in, const int* in_sizes, int n_in, void* d_out, int out_size, void* d_ws, size_t ws_size, hipStream_t stream) {
    static int grid = 0;
    if (grid == 0) {
        if (n_in != 24 || in_sizes[0] != T * D || out_size != T * D || ws_size < WS_END) { fprintf(stderr, "kernel_launch: unexpected shapes / workspace (n_in %d, in0 %d, out %d, ws %zu); nothing launched\n", n_in, n_in > 0 ? in_sizes[0] : -1, out_size, ws_size); grid = -1; return; }
        int dev = 0, cus = 0, per_cu = 0;
        if (hipGetDevice(&dev) != hipSuccess || hipDeviceGetAttribute(&cus, hipDeviceAttributeMultiprocessorCount, dev) != hipSuccess) { grid = -1; return; }
        if (hipFuncSetAttribute((const void*)mega_fwd, hipFuncAttributeMaxDynamicSharedMemorySize, LDS_BYTES) != hipSuccess) { fprintf(stderr, "kernel_launch: hipFuncSetAttribute failed\n"); grid = -1; return; }
        if (hipOccupancyMaxActiveBlocksPerMultiprocessor(&per_cu, (const void*)mega_fwd, NWAVES * 64, LDS_BYTES) != hipSuccess || per_cu < 1) { fprintf(stderr, "kernel_launch: occupancy query says %d blocks per CU\n", per_cu); }
        (void)hipGetLastError();
        if (cus != GRID) { fprintf(stderr, "kernel_launch: built for %d CUs, device has %d; nothing launched\n", GRID, cus); grid = -1; return; }
        grid = cus;
    }
    if (grid < 0) return;
    if (hipMemsetAsync((char*)d_ws + WS_CTL, 0, CTL_ZERO_BYTES, stream) != hipSuccess) return;
    Args a{};
    for (int i = 0; i < 24; ++i) a.in[i] = d_in[i];
    a.out = (float*)d_out; a.ws = (unsigned char*)d_ws;
#ifndef MK_STOP
#define MK_STOP N_PHASES
#endif
#if MK_PER_PHASE
    for (int p = 0; p < MK_STOP; ++p) { a.ph_lo = p; a.ph_hi = p + 1; hipLaunchKernelGGL(mega_fwd, dim3(grid), dim3(NWAVES * 64), LDS_BYTES, stream, a); }
#ifdef MK_DUMP_OFF
    hipLaunchKernelGGL(dump_bf16_kernel, dim3(2048), dim3(256), 0, stream, (const unsigned char*)d_ws, (size_t)(MK_DUMP_OFF), (float*)d_out);
#endif
#else
    a.ph_lo = 0; a.ph_hi = N_PHASES;
    hipLaunchKernelGGL(mega_fwd, dim3(grid), dim3(NWAVES * 64), LDS_BYTES, stream, a);
#endif
}
```

```cpp
#include <hip/hip_runtime.h>
#include <cstdio>
#include <cstdint>
#ifndef MK_FUSEC
#define MK_FUSEC 0
#endif
namespace pg8 {
#define PG8_LAS __attribute__((address_space(3)))
typedef unsigned short bf16_t;
typedef short bf16x8 __attribute__((ext_vector_type(8)));
typedef float f32x4 __attribute__((ext_vector_type(4)));
typedef unsigned u32x4 __attribute__((ext_vector_type(4)));
__device__ __forceinline__ int lane_id_v() { int l; asm volatile("v_mbcnt_lo_u32_b32 %0, -1, 0\n\tv_mbcnt_hi_u32_b32 %0, -1, %0" : "=v"(l)); return l; }
template <int M> __device__ __forceinline__ float shx(float v) {
    static_assert(M >= 1 && M < 64, "xor mask");
    if constexpr (M < 32) return __builtin_bit_cast(float, __builtin_amdgcn_ds_swizzle(__builtin_bit_cast(int, v), (M << 10) | 0x1f));
    else if constexpr (M == 32) { const unsigned u = __builtin_bit_cast(unsigned, v); auto rr = __builtin_amdgcn_permlane32_swap(u, u, false, false);
        return __builtin_bit_cast(float, rr[0] == u ? rr[1] : rr[0]); }
    else return shx<32>(shx<M - 32>(v));
}
constexpr int BM = 256, BK = 64, HALF = 128, HTB = HALF * BK * 2  , STAGE_BYTES = 8 * HTB, NXCD = 8, WGM = 8;

__host__ __device__ __forceinline__ int lds_byte(int r, int c) { const int st = (r >> 4) * 2 + (c >> 5), rr = r & 15, cc = c & 31, ob = rr * 64 + cc * 2; return st * 1024 + (ob ^ (((ob >> 9) & 1) << 5)); }
__host__ __device__ __forceinline__ void stage_rc(int b, int& R, int& C) { const int st = b / 1024, sb = b % 1024, swz = sb ^ (((sb >> 9) & 1) << 5); R = (st >> 1) * 16 + swz / 64; C = (st & 1) * 32 + (swz % 64) / 2; }
__host__ __device__ __forceinline__ int perm32(int rho) { const int n = rho >> 4, i = rho & 15; return 8 * (i >> 2) + 4 * n + (i & 3); }

struct Unit { int pm, pn; };
struct Gemm { const bf16_t* A; const bf16_t* Bt; int M, N, K; };

struct StaticOrder {
    int nM, nN, nwg, G, c;
    __host__ __device__ void init(int M, int N, int G_, int c_) { nM = M / BM; nN = N / BM; nwg = nM * nN; G = G_; c = c_; }
    __host__ __device__ bool next(int i, Unit& u) const {
        const long L = (long)i * G + c; if (L >= nwg) return false;
        int wgid = (int)L; { const int q = nwg / NXCD, r = nwg % NXCD, xcd = wgid % NXCD, off = wgid / NXCD; wgid = (xcd < r ? xcd * (q + 1) : r * (q + 1) + (xcd - r) * q) + off; }
        const int nig = WGM * nN, gid = wgid / nig, fm = gid * WGM, gsz = (nM - fm) < WGM ? (nM - fm) : WGM;
        u.pm = fm + ((wgid % nig) % gsz); u.pn = (wgid % nig) / gsz; return true;
    }
    __device__ __forceinline__ void a_ready(const Unit&) const {}
    __device__ __forceinline__ void done(const Unit&) const {}
};

typedef float f32x2c_t __attribute__((ext_vector_type(2))); typedef __bf16 bf16x2c_t __attribute__((ext_vector_type(2)));
__device__ __forceinline__ unsigned cvt_pk_bf16(float lo, float hi) { f32x2c_t v = {lo, hi}; bf16x2c_t b = __builtin_convertvector(v, bf16x2c_t); return __builtin_bit_cast(unsigned, b); }
typedef float f32x2 __attribute__((ext_vector_type(2)));
__device__ __forceinline__ f32x2 gelu_pk(f32x2 v) {
    const f32x2 av = __builtin_elementwise_abs(v), d = av * 0.2316418882f + 1.0f;
    f32x2 t; t.x = __builtin_amdgcn_rcpf(d.x); t.y = __builtin_amdgcn_rcpf(d.y);
    f32x2 q = t * 0.5307027145f + (-0.7265760135f); q = q * t + 0.7107068705f; q = q * t + (-0.142248368f); q = q * t + 0.127414796f; q = q * t;
    const f32x2 s = (v * v) * (-0.72134752044f);
    f32x2 e; e.x = __builtin_amdgcn_exp2f(s.x); e.y = __builtin_amdgcn_exp2f(s.y);
    const f32x2 m = v * (q * e), r = v - m;
    f32x2 o; o.x = v.x < 0.f ? m.x : r.x; o.y = v.y < 0.f ? m.y : r.y; return o;
}

template <int ACT  > struct EpiBf16 {
    static constexpr bool PERM = true, AFTER_DRAIN = false; static_assert(ACT == 0 || ACT == 1, "EpiBf16: ACT is 0 (none) or 1 (gelu_pk)");
    bf16_t* O; int ldc; const float* bias; int split_cols; size_t split_stride; float scale0;
    __device__ __forceinline__ void operator()(const f32x4 (&acc)[2][2][4][2], const Unit& u, int wr, int wc, int fr, int fq) const {
        const int row0 = u.pm * BM + wr * 64 + fr; int colt = u.pn * BM; bf16_t* base = O;
        float sc = 1.f; if (split_cols) { const int t = colt / split_cols; base += (size_t)t * split_stride; colt -= t * split_cols; if (t == 0) sc = scale0; }
        const int col0 = colt + wc * 32 + 8 * fq, bcol0 = u.pn * BM + wc * 32 + 8 * fq;
        f32x4 bv[2][2];
#pragma unroll
        for (int bj = 0; bj < 2; ++bj)
#pragma unroll
            for (int n = 0; n < 2; ++n) bv[bj][n] = bias ? *(const f32x4*)(bias + bcol0 + bj * HALF + 4 * n) : (f32x4){0.f, 0.f, 0.f, 0.f};
#pragma unroll
        for (int ai = 0; ai < 2; ++ai)
#pragma unroll
            for (int m = 0; m < 4; ++m) { bf16_t* rowp = base + (size_t)(row0 + ai * HALF + m * 16) * ldc + col0;
#pragma unroll
                for (int bj = 0; bj < 2; ++bj) { f32x4 v0 = acc[ai][bj][m][0] + bv[bj][0], v1 = acc[ai][bj][m][1] + bv[bj][1];
                    if (ACT == 1) { f32x2 a = gelu_pk((f32x2){v0[0], v0[1]}), b = gelu_pk((f32x2){v0[2], v0[3]}), c = gelu_pk((f32x2){v1[0], v1[1]}), d = gelu_pk((f32x2){v1[2], v1[3]});
                        v0 = (f32x4){a.x, a.y, b.x, b.y}; v1 = (f32x4){c.x, c.y, d.x, d.y}; }
                    v0 = v0 * sc; v1 = v1 * sc; u32x4 w; w.x = cvt_pk_bf16(v0[0], v0[1]); w.y = cvt_pk_bf16(v0[2], v0[3]); w.z = cvt_pk_bf16(v1[0], v1[1]); w.w = cvt_pk_bf16(v1[2], v1[3]);
                    *(u32x4*)(rowp + bj * HALF) = w; } }
    }
};

struct PanelStats {
    unsigned* xbuf;
    unsigned* cnt;
    unsigned* tmo;
    int ntn; float eps;
    unsigned code;
    __device__ __forceinline__ bool run(const f32x4 (&v)[2][2][4][2], const Unit& u, int wr, int wc, int fr, int fq, PG8_LAS unsigned char* lds, int wid, int lane) const {
        typedef float f32x2v __attribute__((ext_vector_type(2)));
        PG8_LAS f32x2v* P = (PG8_LAS f32x2v*)lds;
        PG8_LAS f32x2v* S = (PG8_LAS f32x2v*)(lds + 8192);
        PG8_LAS unsigned* flag = (PG8_LAS unsigned*)(lds + 8192 + 2048);
#pragma unroll
        for (int ai = 0; ai < 2; ++ai)
#pragma unroll
            for (int m = 0; m < 4; ++m) {
                float s = 0.f;
#pragma unroll
                for (int bj = 0; bj < 2; ++bj)
#pragma unroll
                    for (int n = 0; n < 2; ++n) { const f32x4 x = v[ai][bj][m][n]; s += (x[0] + x[1]) + (x[2] + x[3]); }
                s += shx<16>(s); s += shx<32>(s);
                const float mw = s * (1.0f / 64.0f); float q = 0.f;
#pragma unroll
                for (int bj = 0; bj < 2; ++bj)
#pragma unroll
                    for (int n = 0; n < 2; ++n) { const f32x4 d = v[ai][bj][m][n] - mw; q += (d[0] * d[0] + d[1] * d[1]) + (d[2] * d[2] + d[3] * d[3]); }
                q += shx<16>(q); q += shx<32>(q);
                if (fq == 0) P[(ai * HALF + wr * 64 + m * 16 + fr) * 4 + wc] = (f32x2v){mw, q};
            }
        asm volatile("s_waitcnt lgkmcnt(0)" ::: "memory"); __builtin_amdgcn_s_barrier(); asm volatile("" ::: "memory");
#if defined(BROKEN_EXCHANGE_NO_WAIT)
#warning BROKEN CONTROL BUILD: the row-statistics exchange does not wait; results are wrong by design
        if (blockIdx.x >= 64) { const long long t0_ = clock64(); while (clock64() - t0_ < 60000) __builtin_amdgcn_s_sleep(8); }
#endif
        const int row = wid * 32 + (lane & 31);
        if (lane < 32) {
            const f32x2v a = P[row * 4 + 0], b = P[row * 4 + 1], c = P[row * 4 + 2], d = P[row * 4 + 3];
            const float mt = (a.x + b.x + c.x + d.x) * 0.25f;
            const float da = a.x - mt, db = b.x - mt, dc = c.x - mt, dd = d.x - mt;
            const float m2 = (a.y + b.y) + (c.y + d.y) + 64.0f * ((da * da + db * db) + (dc * dc + dd * dd));
            unsigned long long* slot = (unsigned long long*)xbuf + ((size_t)(u.pm * BM + row) * 4 + u.pn);
            __hip_atomic_store(slot, ((unsigned long long)__float_as_uint(m2) << 32) | __float_as_uint(mt), __ATOMIC_RELAXED, __HIP_MEMORY_SCOPE_AGENT);
        }
        asm volatile("s_waitcnt vmcnt(0)" ::: "memory");
        if (lane == 0) __hip_atomic_fetch_add(cnt + 64 * u.pm, 1u, __ATOMIC_RELAXED, __HIP_MEMORY_SCOPE_AGENT);
        if (wid == 0) {
            bool dead = false; const unsigned long long t0 = __builtin_amdgcn_s_memrealtime(); const unsigned want = 8u * (unsigned)ntn;
            for (;;) {
#if defined(BROKEN_EXCHANGE_NO_WAIT)
                break;
#endif
                if ((unsigned)__builtin_amdgcn_readfirstlane(__hip_atomic_load(cnt + 64 * u.pm, __ATOMIC_RELAXED, __HIP_MEMORY_SCOPE_AGENT)) >= want) break;
                if (__builtin_amdgcn_s_memrealtime() - t0 > 2000000ull) {
                    if (lane == 0) { unsigned expect = 0u; __hip_atomic_compare_exchange_strong(tmo + 1, &expect, code | (unsigned)(u.pm & 0xff), __ATOMIC_RELAXED, __ATOMIC_RELAXED, __HIP_MEMORY_SCOPE_AGENT);
                                     __hip_atomic_store(tmo, 1u, __ATOMIC_RELAXED, __HIP_MEMORY_SCOPE_AGENT); }
                    dead = true; break; }
                __builtin_amdgcn_s_sleep(2);
            }
            __builtin_amdgcn_fence(__ATOMIC_ACQUIRE, "agent");
            if (lane == 0) flag[0] = dead ? 1u : 0u;
        }
        asm volatile("s_waitcnt vmcnt(0) lgkmcnt(0)" ::: "memory"); __builtin_amdgcn_s_barrier(); asm volatile("" ::: "memory");
        const bool bad = flag[0] != 0u;
        if (lane < 32) {
            const unsigned long long* slot = (const unsigned long long*)xbuf + (size_t)(u.pm * BM + row) * 4; float mt[4], m2[4]; float ms = 0.f;
#pragma unroll
            for (int t = 0; t < 4; ++t) { if (t < ntn) { const unsigned long long w = __hip_atomic_load(slot + t, __ATOMIC_RELAXED, __HIP_MEMORY_SCOPE_AGENT); mt[t] = __uint_as_float((unsigned)w); m2[t] = __uint_as_float((unsigned)(w >> 32)); } else { mt[t] = 0.f; m2[t] = 0.f; } ms += mt[t]; }
            const float mean = ms / (float)ntn; float q = 0.f;
#pragma unroll
            for (int t = 0; t < 4; ++t) if (t < ntn) { const float dm = mt[t] - mean; q += m2[t] + 256.0f * dm * dm; }
            S[row] = (f32x2v){mean, 1.0f / sqrtf(q / (256.0f * (float)ntn) + eps)};
        }
        asm volatile("s_waitcnt lgkmcnt(0)" ::: "memory"); __builtin_amdgcn_s_barrier(); asm volatile("" ::: "memory");
        return bad;
    }
};
struct EpiLnRes {
    static constexpr bool PERM = false, AFTER_DRAIN = true;
    const float* base; float* out; int ldc; const float* bias; PanelStats st; unsigned poison;
    __device__ __forceinline__ void fused(f32x4 (&acc)[2][2][4][2], const Unit& u, int wr, int wc, int fr, int fq, PG8_LAS unsigned char* lds, int wid, int lane) const {
        typedef float f32x2v __attribute__((ext_vector_type(2)));
        const PG8_LAS f32x2v* S = (const PG8_LAS f32x2v*)(lds + 8192);
        const int col0 = u.pn * BM + wc * 32 + 4 * fq;
#pragma unroll
        for (int bj = 0; bj < 2; ++bj)
#pragma unroll
            for (int n = 0; n < 2; ++n) { const f32x4 bv = bias ? *(const f32x4*)(bias + col0 + bj * HALF + n * 16) : (f32x4){0.f, 0.f, 0.f, 0.f};
#pragma unroll
                for (int ai = 0; ai < 2; ++ai)
#pragma unroll
                    for (int m = 0; m < 4; ++m) acc[ai][bj][m][n] += bv; }
        f32x4 pre[4][2][2];
#pragma unroll
        for (int m = 0; m < 4; ++m) { const size_t off = (size_t)(u.pm * BM + wr * 64 + m * 16 + fr) * ldc + col0;
#pragma unroll
            for (int bj = 0; bj < 2; ++bj)
#pragma unroll
                for (int n = 0; n < 2; ++n) pre[m][bj][n] = *(const f32x4*)(base + off + bj * HALF + n * 16); }
        const bool bad = st.run(acc, u, wr, wc, fr, fq, lds, wid, lane) || poison != 0u;
        const float qnan = __builtin_nanf("");
#pragma unroll
        for (int ai = 0; ai < 2; ++ai)
#pragma unroll
            for (int m = 0; m < 4; ++m) { const int r = ai * HALF + wr * 64 + m * 16 + fr; const f32x2v sr = S[r]; const size_t off = (size_t)(u.pm * BM + r) * ldc + col0;
#pragma unroll
                for (int bj = 0; bj < 2; ++bj)
#pragma unroll
                    for (int n = 0; n < 2; ++n) { const f32x4 bs = ai == 0 ? pre[m][bj][n] : *(const f32x4*)(base + off + bj * HALF + n * 16); f32x4 o = bs + (acc[ai][bj][m][n] - sr.x) * sr.y;
                        if (bad) o = (f32x4){qnan, qnan, qnan, qnan}; *(f32x4*)(out + off + bj * HALF + n * 16) = o; }
                if (m & 1) asm volatile("" ::: "memory"); }
    }
};
struct EpiLnResLn {
    static constexpr bool PERM = false, AFTER_DRAIN = true;
    const float* base; float* out; bf16_t* xn; int ldc; const float* bias; PanelStats st1, st2; unsigned poison;
    __device__ __forceinline__ void fused(f32x4 (&acc)[2][2][4][2], const Unit& u, int wr, int wc, int fr, int fq, PG8_LAS unsigned char* lds, int wid, int lane) const {
        typedef float f32x2v __attribute__((ext_vector_type(2))); typedef unsigned u32x2v __attribute__((ext_vector_type(2)));
        const PG8_LAS f32x2v* S = (const PG8_LAS f32x2v*)(lds + 8192);
        const int col0 = u.pn * BM + wc * 32 + 4 * fq;
#pragma unroll
        for (int bj = 0; bj < 2; ++bj)
#pragma unroll
            for (int n = 0; n < 2; ++n) { const f32x4 bv = bias ? *(const f32x4*)(bias + col0 + bj * HALF + n * 16) : (f32x4){0.f, 0.f, 0.f, 0.f};
#pragma unroll
                for (int ai = 0; ai < 2; ++ai)
#pragma unroll
                    for (int m = 0; m < 4; ++m) acc[ai][bj][m][n] += bv; }
        bool bad = st1.run(acc, u, wr, wc, fr, fq, lds, wid, lane) || poison != 0u;
        const float qnan = __builtin_nanf("");
#pragma unroll
        for (int ai = 0; ai < 2; ++ai)
#pragma unroll
            for (int m = 0; m < 4; ++m) { const int r = ai * HALF + wr * 64 + m * 16 + fr; const f32x2v sr = S[r]; const size_t off = (size_t)(u.pm * BM + r) * ldc + col0;
#pragma unroll
                for (int bj = 0; bj < 2; ++bj)
#pragma unroll
                    for (int n = 0; n < 2; ++n) { const f32x4 bs = *(const f32x4*)(base + off + bj * HALF + n * 16); acc[ai][bj][m][n] = bs + (acc[ai][bj][m][n] - sr.x) * sr.y; }
                asm volatile("" : "+v"(acc[ai][0][m][0]), "+v"(acc[ai][0][m][1]), "+v"(acc[ai][1][m][0]), "+v"(acc[ai][1][m][1]));
                if (m & 1) asm volatile("" ::: "memory"); }
        const bool bad1 = bad;
        bad = st2.run(acc, u, wr, wc, fr, fq, lds, wid, lane) || bad;
#pragma unroll
        for (int ai = 0; ai < 2; ++ai)
#pragma unroll
            for (int m = 0; m < 4; ++m) { const int r = ai * HALF + wr * 64 + m * 16 + fr; const f32x2v sr = S[r]; const size_t off = (size_t)(u.pm * BM + r) * ldc + col0;
#pragma unroll
                for (int bj = 0; bj < 2; ++bj)
#pragma unroll
                    for (int n = 0; n < 2; ++n) { const f32x4 x1 = acc[ai][bj][m][n]; *(f32x4*)(out + off + bj * HALF + n * 16) = bad1 ? (f32x4){qnan, qnan, qnan, qnan} : x1;
                        const f32x4 o = (x1 - sr.x) * sr.y; u32x2v w; w.x = cvt_pk_bf16(o[0], o[1]); w.y = cvt_pk_bf16(o[2], o[3]);
                        if (bad) { w.x = 0x7fc07fc0u; w.y = 0x7fc07fc0u; } *(u32x2v*)(xn + off + bj * HALF + n * 16) = w; }
                asm volatile("" ::: "memory"); }
    }
};

template <class Epi, class Sched, bool ALIGN_EPI = false, bool SP2 = false>
__device__ __forceinline__ void gemm_phase(PG8_LAS unsigned char* lds, const Gemm g, const Sched& S, const Epi& E, int wave_id) {
    int tid_ = wave_id * 64 + lane_id_v(); asm volatile("" : "+v"(tid_));
    const int tid = tid_, wid = __builtin_amdgcn_readfirstlane(tid >> 6), lane = tid & 63, wr = wid >> 2, wc = wid & 3, fr = lane & 15, fq = lane >> 4;
    const int K = g.K, nt = K / BK;
    unsigned voffA[2], voffB[2];
#pragma unroll
    for (int i = 0; i < 2; ++i) { int R, C; stage_rc(tid * 16 + i * 8192, R, C); const int Rb = Epi::PERM ? ((R & ~31) + perm32(R & 31)) : R;
        voffA[i] = (unsigned)(R * K + C) * 2u; voffB[i] = (unsigned)(Rb * K + C) * 2u; }
    const size_t kstep = (size_t)(BK * 2);
    const size_t hstep = (size_t)HALF * K * 2;
    const size_t tstep = 2 * hstep;
    const unsigned ldsw = (unsigned)wid * 1024u;
    const int aoff = lds_byte(wr * 64 + fr, fq * 8), boff = lds_byte(wc * 32 + fr, fq * 8);
#define PG8_SA(b, h) (((b) * 2 + (h)) * HTB)
#define PG8_SB(b, h) ((4 + (b) * 2 + (h)) * HTB)
#define PG8_STAGE(bufoff, gbase, voff) do { _Pragma("unroll") for (int _i = 0; _i < 2; ++_i) \
        __builtin_amdgcn_global_load_lds((const unsigned*)((const char*)(gbase) + (voff)[_i]), (PG8_LAS unsigned*)(lds + (bufoff) + ldsw + _i * 8192), 16, 0, 0); } while (0)
#define PG8_LDA(dst, b, h) do { _Pragma("unroll") for (int m = 0; m < 4; ++m) _Pragma("unroll") for (int k = 0; k < 2; ++k) dst[m][k] = *(const PG8_LAS bf16x8*)(lds + PG8_SA(b, h) + aoff + m * 2048 + k * 1024); } while (0)
#define PG8_LDB(dst, b, h) do { _Pragma("unroll") for (int n = 0; n < 2; ++n) _Pragma("unroll") for (int k = 0; k < 2; ++k) dst[n][k] = *(const PG8_LAS bf16x8*)(lds + PG8_SB(b, h) + boff + n * 2048 + k * 1024); } while (0)
#define PG8_MMA(ai, bj, At, Bt) do { __builtin_amdgcn_s_setprio(1); _Pragma("unroll") for (int m = 0; m < 4; ++m) _Pragma("unroll") for (int n = 0; n < 2; ++n) _Pragma("unroll") for (int k = 0; k < 2; ++k) \
        acc[ai][bj][m][n] = __builtin_amdgcn_mfma_f32_16x16x32_bf16(Bt[n][k], At[m][k], acc[ai][bj][m][n], 0, 0, 0); __builtin_amdgcn_s_setprio(0); } while (0)
#define PG8_WAIT_V(n) asm volatile("s_waitcnt vmcnt(" #n ")" ::: "memory")
#define PG8_WAIT_L(n) asm volatile("s_waitcnt lgkmcnt(" #n ")" ::: "memory")
#define PG8_BAR __builtin_amdgcn_s_barrier()
#define PG8_SCHED __builtin_amdgcn_sched_barrier(0)
    Unit cur, nxt; int ui = 0;
#if defined(MK_GPROBE) && MK_GPROBE == 2
    unsigned gp_last = 0;
#endif
    if (!S.next(0, cur)) return;
    f32x4 acc[2][2][4][2];
#pragma unroll
    for (int a = 0; a < 2; ++a)
#pragma unroll
        for (int b = 0; b < 2; ++b)
#pragma unroll
            for (int m = 0; m < 4; ++m)
#pragma unroll
                for (int n = 0; n < 2; ++n) acc[a][b][m][n] = (f32x4){0.f, 0.f, 0.f, 0.f};
    bf16x8 At[4][2], B0[2][2], B1[2][2];
    const char* cA = (const char*)g.A + (size_t)cur.pm * tstep; const char* cB = (const char*)g.Bt + (size_t)cur.pn * tstep;
    S.a_ready(cur);
    if constexpr (SP2) {
        PG8_STAGE(PG8_SB(0, 0), cB, voffB); PG8_STAGE(PG8_SB(0, 1), cB + hstep, voffB); PG8_STAGE(PG8_SA(0, 0), cA, voffA); PG8_STAGE(PG8_SA(0, 1), cA + hstep, voffA);
        if (wr == 1) PG8_BAR;
        PG8_WAIT_V(2); PG8_BAR;
        PG8_STAGE(PG8_SB(1, 0), cB + kstep, voffB); PG8_STAGE(PG8_SA(1, 0), cA + kstep, voffA); PG8_STAGE(PG8_SB(1, 1), cB + hstep + kstep, voffB);
        PG8_WAIT_V(6); PG8_BAR;
    } else {
        PG8_STAGE(PG8_SB(0, 0), cB, voffB); PG8_STAGE(PG8_SA(0, 0), cA, voffA); PG8_STAGE(PG8_SB(0, 1), cB + hstep, voffB); PG8_STAGE(PG8_SA(0, 1), cA + hstep, voffA);
        if (wr == 1) PG8_BAR;
        PG8_WAIT_V(4); PG8_BAR;
        PG8_STAGE(PG8_SB(1, 0), cB + kstep, voffB); PG8_STAGE(PG8_SA(1, 0), cA + kstep, voffA); PG8_STAGE(PG8_SB(1, 1), cB + hstep + kstep, voffB);
        PG8_WAIT_V(6); PG8_BAR;
    }
    for (;;) {
        const bool has_next = S.next(ui + 1, nxt);
        const char* nA = has_next ? (const char*)g.A + (size_t)nxt.pm * tstep : cA; const char* nB = has_next ? (const char*)g.Bt + (size_t)nxt.pn * tstep : cB;
#if defined(MK_GPROBE) && MK_GPROBE == 3
        unsigned gp_k0 = 0; if (wid == 0) gp_k0 = (unsigned)__builtin_amdgcn_s_memrealtime();
#endif
        for (int t = 0; t < nt; t += 2) {
            const bool last = (t == nt - 2);
            const char* a1 = cA + (size_t)(t + 1) * kstep;
            const char* a2 = last ? nA : cA + (size_t)(t + 2) * kstep; const char* b2 = last ? nB : cB + (size_t)(t + 2) * kstep;
            const char* a3 = a2 + kstep; const char* b3 = b2 + kstep;
            if (last && has_next) S.a_ready(nxt);
            if constexpr (SP2) {
            PG8_LDB(B0, 0, 0); PG8_LDB(B1, 0, 1); PG8_SCHED; PG8_LDA(At, 0, 0); PG8_STAGE(PG8_SA(1, 1), a1 + hstep, voffA);
            PG8_WAIT_V(8); PG8_WAIT_L(0); PG8_BAR;
#if defined(MK_GPROBE) && MK_GPROBE == 2
            if (wid == 0 && t == 2 && ui > 0) { const unsigned gp_t3 = (unsigned)__builtin_amdgcn_s_memrealtime(); if (lane == 0) ((PG8_LAS unsigned*)(lds + 143360 + 3584))[0] += gp_t3 - gp_last; }
#endif
            PG8_MMA(0, 0, At, B0); PG8_MMA(0, 1, At, B1); PG8_BAR; PG8_SCHED;
            PG8_LDA(At, 0, 1); PG8_STAGE(PG8_SB(0, 0), b2, voffB); PG8_STAGE(PG8_SB(0, 1), b2 + hstep, voffB); PG8_STAGE(PG8_SA(0, 0), a2, voffA);
            PG8_WAIT_V(8); PG8_WAIT_L(0); PG8_BAR; PG8_MMA(1, 0, At, B0); PG8_MMA(1, 1, At, B1); PG8_BAR; PG8_SCHED;
            PG8_LDB(B0, 1, 0); PG8_LDB(B1, 1, 1); PG8_SCHED; PG8_LDA(At, 1, 0); PG8_STAGE(PG8_SA(0, 1), a2 + hstep, voffA);
            PG8_WAIT_V(8); PG8_WAIT_L(0); PG8_BAR; PG8_MMA(0, 0, At, B0); PG8_MMA(0, 1, At, B1); PG8_BAR; PG8_SCHED;
            PG8_LDA(At, 1, 1); PG8_STAGE(PG8_SB(1, 0), b3, voffB); PG8_STAGE(PG8_SB(1, 1), b3 + hstep, voffB); PG8_STAGE(PG8_SA(1, 0), a3, voffA);
            PG8_WAIT_V(8); PG8_WAIT_L(0); PG8_BAR; PG8_MMA(1, 0, At, B0); PG8_MMA(1, 1, At, B1); PG8_BAR; PG8_SCHED;
            } else {
            PG8_LDB(B0, 0, 0); PG8_SCHED; PG8_LDA(At, 0, 0); PG8_STAGE(PG8_SA(1, 1), a1 + hstep, voffA);
            PG8_WAIT_L(8); PG8_BAR; PG8_WAIT_L(0); PG8_MMA(0, 0, At, B0); PG8_BAR; PG8_SCHED;
            PG8_LDB(B1, 0, 1); PG8_STAGE(PG8_SB(0, 0), b2, voffB);
            PG8_BAR; PG8_WAIT_L(0); PG8_MMA(0, 1, At, B1); PG8_BAR;
            PG8_LDA(At, 0, 1); PG8_STAGE(PG8_SA(0, 0), a2, voffA);
            PG8_BAR; PG8_WAIT_L(0); PG8_MMA(1, 0, At, B0); PG8_BAR; PG8_SCHED;
            PG8_STAGE(PG8_SB(0, 1), b2 + hstep, voffB);
            PG8_WAIT_V(6); PG8_BAR; PG8_MMA(1, 1, At, B1); PG8_BAR;
            PG8_LDB(B0, 1, 0); PG8_SCHED; PG8_LDA(At, 1, 0); PG8_STAGE(PG8_SA(0, 1), a2 + hstep, voffA);
            PG8_WAIT_L(8); PG8_BAR; PG8_WAIT_L(0); PG8_MMA(0, 0, At, B0); PG8_BAR; PG8_SCHED;
            PG8_LDB(B1, 1, 1); PG8_STAGE(PG8_SB(1, 0), b3, voffB);
            PG8_BAR; PG8_WAIT_L(0); PG8_MMA(0, 1, At, B1); PG8_BAR;
            PG8_LDA(At, 1, 1); PG8_STAGE(PG8_SA(1, 0), a3, voffA);
            PG8_BAR; PG8_WAIT_L(0); PG8_MMA(1, 0, At, B0); PG8_BAR; PG8_SCHED;
            PG8_STAGE(PG8_SB(1, 1), b3 + hstep, voffB);
            PG8_WAIT_V(6); PG8_BAR; PG8_MMA(1, 1, At, B1); PG8_BAR;
            }
        }
#if defined(MK_GPROBE) && MK_GPROBE == 1
        unsigned gp_t0 = 0; if (wid == 0) gp_t0 = (unsigned)__builtin_amdgcn_s_memrealtime();
#endif
#if defined(MK_GPROBE) && MK_GPROBE == 3
        if (wid == 0) { const unsigned gp_k1 = (unsigned)__builtin_amdgcn_s_memrealtime(); if (lane == 0) ((PG8_LAS unsigned*)(lds + 143360 + 3584))[0] += gp_k1 - gp_k0; }
#endif
        if constexpr (ALIGN_EPI) { if (wr == 0) PG8_BAR; }
        if constexpr (!Epi::AFTER_DRAIN) { E(acc, cur, wr, wc, fr, fq); S.done(cur); }
#if defined(MK_GPROBE) && MK_GPROBE == 1
        if (wid == 0) { const unsigned gp_t1 = (unsigned)__builtin_amdgcn_s_memrealtime(); if (lane == 0) ((PG8_LAS unsigned*)(lds + 143360 + 3584))[0] += gp_t1 - gp_t0; }
#endif
#if defined(MK_GPROBE) && MK_GPROBE == 2
        if (wid == 0) gp_last = (unsigned)__builtin_amdgcn_s_memrealtime();
#endif
        if (!has_next) break;
#pragma unroll
        for (int a = 0; a < 2; ++a)
#pragma unroll
            for (int b = 0; b < 2; ++b)
#pragma unroll
                for (int m = 0; m < 4; ++m)
#pragma unroll
                    for (int n = 0; n < 2; ++n) acc[a][b][m][n] = (f32x4){0.f, 0.f, 0.f, 0.f};
        cur = nxt; cA = nA; cB = nB; ++ui;
        if constexpr (ALIGN_EPI) { if (wr == 1) PG8_BAR; }
    }
    PG8_WAIT_V(0);
    if constexpr (!ALIGN_EPI) { if (wr == 0) PG8_BAR; }
    PG8_BAR;
    if constexpr (Epi::AFTER_DRAIN) { E.fused(acc, cur, wr, wc, fr, fq, lds, wid, lane); S.done(cur); }
#undef PG8_SA
#undef PG8_SB
#undef PG8_STAGE
#undef PG8_LDA
#undef PG8_LDB
#undef PG8_MMA
#undef PG8_WAIT_V
#undef PG8_WAIT_L
#undef PG8_BAR
#undef PG8_SCHED
}
}
namespace pg8 {
__device__ __forceinline__ u32x4 pack8(const f32x4& a, const f32x4& b) { u32x4 w; w.x = cvt_pk_bf16(a[0], a[1]); w.y = cvt_pk_bf16(a[2], a[3]); w.z = cvt_pk_bf16(b[0], b[1]); w.w = cvt_pk_bf16(b[2], b[3]); return w; }
__device__ __forceinline__ f32x4 bf_lo4(const u32x4& w) { return (f32x4){__uint_as_float(w.x << 16), __uint_as_float(w.x & 0xffff0000u), __uint_as_float(w.y << 16), __uint_as_float(w.y & 0xffff0000u)}; }
__device__ __forceinline__ f32x4 bf_hi4(const u32x4& w) { return (f32x4){__uint_as_float(w.z << 16), __uint_as_float(w.z & 0xffff0000u), __uint_as_float(w.w << 16), __uint_as_float(w.w & 0xffff0000u)}; }
__device__ __forceinline__ float sigmoid_f(float x) { return __builtin_amdgcn_rcpf(1.0f + __builtin_amdgcn_exp2f(-1.4426950408889634f * x)); }
__device__ __forceinline__ f32x4 sigmoid4(const f32x4& v) { return (f32x4){sigmoid_f(v[0]), sigmoid_f(v[1]), sigmoid_f(v[2]), sigmoid_f(v[3])}; }

constexpr float QSCALE = 0.125f * 1.4426950408889634f;
constexpr float QMSCALE = 0.08838834764831845f * 1.4426950408889634f;

constexpr size_t P1_MiB = 1u << 20;
constexpr size_t P1_COS = 12 * P1_MiB, P1_SIN = 16 * P1_MiB, P1_Q = 156 * P1_MiB, P1_K = P1_Q + 32 * P1_MiB, P1_V = P1_K + 32 * P1_MiB, P1_CB = P1_V + 32 * P1_MiB, P1_Z = P1_CB + 16 * P1_MiB, P1_QM = P1_Z + 16 * P1_MiB, P1_G = P1_QM + 16 * P1_MiB;
struct EpiP1 {
    static constexpr bool PERM = true, AFTER_DRAIN = false;
    unsigned char* ws; int tok0;
    __device__ __forceinline__ void operator()(const f32x4 (&acc)[2][2][4][2], const Unit& u, int wr, int wc, int fr, int fq) const {
        const int pn = u.pn; const int row0 = u.pm * BM + wr * 64 + fr;
        bf16_t* const Q = (bf16_t*)(ws + P1_Q); bf16_t* const K = (bf16_t*)(ws + P1_K); bf16_t* const V = (bf16_t*)(ws + P1_V); bf16_t* const CB = (bf16_t*)(ws + P1_CB);
        bf16_t* const Z = (bf16_t*)(ws + P1_Z); bf16_t* const QM = (bf16_t*)(ws + P1_QM); bf16_t* const G = (bf16_t*)(ws + P1_G);
        const float* const cosT = (const float*)(ws + P1_COS) + (size_t)tok0 * 32; const float* const sinT = (const float*)(ws + P1_SIN) + (size_t)tok0 * 32;
        if (pn < 8) {
            bf16_t* base = (pn < 4 ? Q : K) + (pn & 3) * 256 + wc * 64 + 8 * fq; const float sc = pn < 4 ? QSCALE : 1.0f;
            f32x4 cs[3][4];
#define P1_LD(it) do { const int row_ = row0 + ((it) >> 2) * HALF + ((it) & 3) * 16; const float* cp_ = cosT + (size_t)row_ * 32 + 8 * fq; const float* sp_ = sinT + (size_t)row_ * 32 + 8 * fq; \
                cs[(it) % 3][0] = *(const f32x4*)cp_; cs[(it) % 3][1] = *(const f32x4*)(cp_ + 4); cs[(it) % 3][2] = *(const f32x4*)sp_; cs[(it) % 3][3] = *(const f32x4*)(sp_ + 4); } while (0)
            P1_LD(0); P1_LD(1); __builtin_amdgcn_sched_barrier(0);
#pragma unroll
            for (int it = 0; it < 8; ++it) { const int ai = it >> 2, m = it & 3; const int row = row0 + ai * HALF + m * 16;
                if (it + 2 < 8) P1_LD(it + 2);
                __builtin_amdgcn_sched_barrier(0);
                const f32x4 c0 = cs[it % 3][0], c1 = cs[it % 3][1], s0 = cs[it % 3][2], s1 = cs[it % 3][3];
                const f32x4 lo0 = acc[ai][0][m][0], lo1 = acc[ai][0][m][1], hi0 = acc[ai][1][m][0], hi1 = acc[ai][1][m][1];
                const f32x4 a0 = (lo0 * c0 - hi0 * s0) * sc, a1 = (lo1 * c1 - hi1 * s1) * sc, b0 = (hi0 * c0 + lo0 * s0) * sc, b1 = (hi1 * c1 + lo1 * s1) * sc;
                bf16_t* rp = base + (size_t)row * 1024; *(u32x4*)rp = pack8(a0, a1); *(u32x4*)(rp + 32) = pack8(b0, b1);
                __builtin_amdgcn_sched_barrier(0); }
#undef P1_LD
        } else if (pn < 14) {
            bf16_t* base; int ldc;
            if (pn < 12) { base = V + (pn - 8) * 256; ldc = 1024; } else { base = CB + (pn - 12) * 256; ldc = 512; }
            base += wc * 32 + 8 * fq;
#pragma unroll
            for (int ai = 0; ai < 2; ++ai)
#pragma unroll
                for (int m = 0; m < 4; ++m) { bf16_t* rp = base + (size_t)(row0 + ai * HALF + m * 16) * ldc;
#pragma unroll
                    for (int bj = 0; bj < 2; ++bj) *(u32x4*)(rp + bj * HALF) = pack8(acc[ai][bj][m][0], acc[ai][bj][m][1]); }
        } else if (pn < 18) {
            bf16_t* base = Z + (pn - 14) * 128 + wc * 32 + 8 * fq;
#pragma unroll
            for (int ai = 0; ai < 2; ++ai)
#pragma unroll
                for (int m = 0; m < 4; ++m) { bf16_t* rp = base + (size_t)(row0 + ai * HALF + m * 16) * 512;
                    *(u32x4*)rp = pack8(acc[ai][0][m][0] * acc[ai][1][m][0], acc[ai][0][m][1] * acc[ai][1][m][1]); }
        } else if (pn < 20) {
            bf16_t* base = QM + (pn - 18) * 256 + wc * 32 + 8 * fq;
#pragma unroll
            for (int ai = 0; ai < 2; ++ai)
#pragma unroll
                for (int m = 0; m < 4; ++m) { bf16_t* rp = base + (size_t)(row0 + ai * HALF + m * 16) * 512;
#pragma unroll
                    for (int bj = 0; bj < 2; ++bj) *(u32x4*)(rp + bj * HALF) = pack8(acc[ai][bj][m][0] * QMSCALE, acc[ai][bj][m][1] * QMSCALE); }
        } else {
            unsigned char* base = (unsigned char*)G + (pn - 20) * 256 + wc * 32 + 8 * fq;
#pragma unroll
            for (int ai = 0; ai < 2; ++ai)
#pragma unroll
                for (int m = 0; m < 4; ++m) { unsigned char* rp = base + (size_t)(row0 + ai * HALF + m * 16) * 3072;
#pragma unroll
                    for (int bj = 0; bj < 2; ++bj) { const f32x4 g0 = sigmoid4(acc[ai][bj][m][0]) * 255.0f + 0.5f, g1 = sigmoid4(acc[ai][bj][m][1]) * 255.0f + 0.5f;
                        unsigned q[8];
#pragma unroll
                        for (int i = 0; i < 4; ++i) { const unsigned a = (unsigned)g0[i], b = (unsigned)g1[i]; q[i] = a < 1u ? 1u : a; q[4 + i] = b < 1u ? 1u : b; }
                        typedef unsigned u32x2e __attribute__((ext_vector_type(2))); u32x2e w;
                        w.x = q[0] | (q[1] << 8) | (q[2] << 16) | (q[3] << 24); w.y = q[4] | (q[5] << 8) | (q[6] << 16) | (q[7] << 24);
                        *(u32x2e*)(rp + bj * HALF) = w; } }
        }
    }
};

template <bool FIRST> struct EpiGate {
    static constexpr bool PERM = true, AFTER_DRAIN = false;
    bf16_t* Mg; const bf16_t* G; int gi;
    __device__ __forceinline__ void operator()(const f32x4 (&acc)[2][2][4][2], const Unit& u, int wr, int wc, int fr, int fq) const {
        const int row0 = u.pm * BM + wr * 64 + fr, col0 = u.pn * BM + wc * 32 + 8 * fq;
#pragma unroll
        for (int ai = 0; ai < 2; ++ai)
#pragma unroll
            for (int m = 0; m < 4; ++m) { const size_t row = (size_t)(row0 + ai * HALF + m * 16);
#pragma unroll
                for (int bj = 0; bj < 2; ++bj) { const int col = col0 + bj * HALF;
                    const u32x4 gv = *(const u32x4*)(G + row * 3072 + gi * 1024 + col);
                    f32x4 v0 = acc[ai][bj][m][0] * bf_lo4(gv), v1 = acc[ai][bj][m][1] * bf_hi4(gv);
                    bf16_t* mp = Mg + row * 1024 + col;
                    if (!FIRST) { const u32x4 pv = __builtin_nontemporal_load((const u32x4*)mp); v0 += bf_lo4(pv); v1 += bf_hi4(pv); }
                    *(u32x4*)mp = pack8(v0, v1); } }
    }
};

struct EpiSwiglu {
    static constexpr bool PERM = true, AFTER_DRAIN = false, KEEP_ACC = false;
    __device__ __forceinline__ bool keep(const Unit&) const { return false; }
    bf16_t* H;
    __device__ __forceinline__ void operator()(const f32x4 (&acc)[2][2][4][2], const Unit& u, int wr, int wc, int fr, int fq) const {
        const int row0 = u.pm * BM + wr * 64 + fr; bf16_t* base = H + (u.pn & 3) * 128 + wc * 32 + 8 * fq;
#pragma unroll
        for (int ai = 0; ai < 2; ++ai)
#pragma unroll
            for (int m = 0; m < 4; ++m) { bf16_t* rp = base + (size_t)(row0 + ai * HALF + m * 16) * 512;
                const f32x4 g0 = acc[ai][0][m][0], g1 = acc[ai][0][m][1];
                *(u32x4*)rp = pack8(g0 * sigmoid4(g0) * acc[ai][1][m][0], g1 * sigmoid4(g1) * acc[ai][1][m][1]); }
    }
};
struct EpiScatter {
    static constexpr bool PERM = true, AFTER_DRAIN = false;
    bf16_t* Yc; const int* rowinfo; const float* roww;
    __device__ __forceinline__ void operator()(const f32x4 (&acc)[2][2][4][2], const Unit& u, int wr, int wc, int fr, int fq) const {
        const int row0 = u.pm * BM + wr * 64 + fr, col0 = (u.pn & 3) * BM + wc * 32 + 8 * fq;
        int info[8]; float w[8];
#pragma unroll
        for (int it = 0; it < 8; ++it) { const int row = row0 + (it >> 2) * HALF + (it & 3) * 16; info[it] = rowinfo[row]; w[it] = roww[row]; }
        __builtin_amdgcn_sched_barrier(0);
#pragma unroll
        for (int it = 0; it < 8; ++it) { const int ai = it >> 2, m = it & 3;
            if (info[it] >= 0) { bf16_t* rp = Yc + (size_t)info[it] * 1024 + col0;
#pragma unroll
                for (int bj = 0; bj < 2; ++bj) *(u32x4*)(rp + bj * HALF) = pack8(acc[ai][bj][m][0] * w[it], acc[ai][bj][m][1] * w[it]); } }
    }
};
struct MoeOrder {
    int ntiles, vcu, G; const PG8_LAS int* tile_e;
    __device__ __forceinline__ bool next(int i, Unit& u) const {
        const int L = i * G + vcu; if (L >= ntiles * 4) return false;
        u.pm = L >> 2; u.pn = __builtin_amdgcn_readfirstlane(tile_e[L >> 2]) * 4 + (L & 3); return true;
    }
    __device__ __forceinline__ void a_ready(const Unit&) const {}
    __device__ __forceinline__ void done(const Unit&) const {}
};

struct EpiLn1 {
    static constexpr bool PERM = false, AFTER_DRAIN = true;
    const float* base; float* out; bf16_t* xb; const float* gamma; const float* beta; PanelStats st;
    static constexpr float alpha = 1.4142135623730951f;
    __device__ __forceinline__ void fused(f32x4 (&acc)[2][2][4][2], const Unit& u, int wr, int wc, int fr, int fq, PG8_LAS unsigned char* lds, int wid, int lane) const {
        typedef float f32x2v __attribute__((ext_vector_type(2))); typedef unsigned u32x2v __attribute__((ext_vector_type(2)));
        const PG8_LAS f32x2v* S = (const PG8_LAS f32x2v*)(lds + 8192);
        const int col0 = u.pn * BM + wc * 32 + 4 * fq;
#pragma unroll
        for (int ai = 0; ai < 2; ++ai)
#pragma unroll
            for (int m = 0; m < 4; ++m) { const unsigned off = (unsigned)(u.pm * BM + ai * HALF + wr * 64 + m * 16 + fr) * 1024u + (unsigned)col0;
#pragma unroll
                for (int bj = 0; bj < 2; ++bj)
#pragma unroll
                    for (int n = 0; n < 2; ++n) acc[ai][bj][m][n] += *(const f32x4*)(base + (off + bj * HALF + n * 16)) * alpha;
                asm volatile("" : "+v"(acc[ai][0][m][0]), "+v"(acc[ai][0][m][1]), "+v"(acc[ai][1][m][0]), "+v"(acc[ai][1][m][1]));
                asm volatile("" ::: "memory"); }
        const bool bad = st.run(acc, u, wr, wc, fr, fq, lds, wid, lane);
        const float qnan = __builtin_nanf("");
#pragma unroll
        for (int bj = 0; bj < 2; ++bj)
#pragma unroll
            for (int n = 0; n < 2; ++n) { const f32x4 gv = *(const f32x4*)(gamma + col0 + bj * HALF + n * 16), bv = *(const f32x4*)(beta + col0 + bj * HALF + n * 16);
#pragma unroll
                for (int ai = 0; ai < 2; ++ai)
#pragma unroll
                    for (int m = 0; m < 4; ++m) { const int r = ai * HALF + wr * 64 + m * 16 + fr; const f32x2v sr = S[r]; const unsigned off = (unsigned)(u.pm * BM + r) * 1024u + (unsigned)(col0 + bj * HALF + n * 16);
                        f32x4 o = (acc[ai][bj][m][n] - sr.x) * sr.y * gv + bv;
                        if (bad) o = (f32x4){qnan, qnan, qnan, qnan};
                        *(f32x4*)(out + off) = o;
                        u32x2v w; w.x = cvt_pk_bf16(o[0], o[1]); w.y = cvt_pk_bf16(o[2], o[3]); *(u32x2v*)(xb + off) = w; }
                asm volatile("" ::: "memory"); }
    }
};
}
#include <hip/hip_bf16.h>
#include <cmath>
namespace dattn {
using bf16=__hip_bfloat16;
using bf16x8=__attribute__((ext_vector_type(8)))short;
using s16x4=__attribute__((ext_vector_type(4)))short;
using f32x16=__attribute__((ext_vector_type(16)))float;
using u32x4=__attribute__((ext_vector_type(4)))unsigned;
using f32x4v=__attribute__((ext_vector_type(4)))float;
constexpr int BATCH=2,NHEAD=16,SEQ=8192,D=64,DM=NHEAD*D;
constexpr int NW=8,QBLK=32,QB=QBLK*NW,KVBLK=64,NQB=SEQ/QB;
constexpr int ATTN_PITCH=DM, ATTN_UNIT_ROWS=QB;
__device__ __forceinline__ int crow(int r,int hi){return (r&3)+8*(r>>2)+4*hi;}
#define SBAR() __builtin_amdgcn_sched_barrier(0)
__device__ __forceinline__ void cmask(f32x16&p0,f32x16&p1,int jb,int qrel,int hi){
  const float NEG=-INFINITY; int kb=64*jb+4*hi;
  #pragma unroll
  for(int r=0;r<16;++r){int kv=kb+(r&3)+8*(r>>2); if(kv>qrel)p0[r]=NEG; if(kv+32>qrel)p1[r]=NEG;}
}

constexpr int NSLOT=3, SLOTB=8192;
constexpr int LDS_K=0, LDS_V=NSLOT*SLOTB, LDS_WS=3*NSLOT*SLOTB, LDS_OST=LDS_WS+NW*64*4, LDS_QS=LDS_OST+NW*4096, LDS_BYTES=LDS_QS+NW*4096;
constexpr float C2=0.125f*1.4426950408889634f;
__device__ __forceinline__ void glds16(const void*gsrc,unsigned lds_dst){unsigned keep;
  asm volatile("s_mov_b32 %0, m0\n\ts_mov_b32 m0, %2\n\ts_nop 0\n\tglobal_load_lds_dwordx4 %1, off\n\ts_mov_b32 m0, %0":"=&s"(keep):"v"(gsrc),"s"(lds_dst):"memory");}
__device__ __forceinline__ void glds16o(unsigned voff,const void*sbase,unsigned lds_dst){unsigned keep;
  asm volatile("s_mov_b32 %0, m0\n\ts_mov_b32 m0, %2\n\ts_nop 0\n\tglobal_load_lds_dwordx4 %1, %3\n\ts_mov_b32 m0, %0":"=&s"(keep):"v"(voff),"s"(lds_dst),"s"(sbase):"memory");}
__device__ __forceinline__ float max3f(float a,float b,float c){float r;asm("v_max3_f32 %0, %1, %2, %3":"=v"(r):"v"(a),"v"(b),"v"(c));return r;}
__device__ __forceinline__ float max2f(float a,float b){float r;asm("v_max_f32_e32 %0, %1, %2":"=v"(r):"v"(a),"v"(b));return r;}
__device__ __forceinline__ float fadd_s(float a,float b){float r;asm("v_add_f32_e32 %0, %1, %2":"=v"(r):"v"(a),"v"(b));return r;}
__device__ __forceinline__ float fsub_s(float a,float b){float r;asm("v_sub_f32_e32 %0, %1, %2":"=v"(r):"v"(a),"v"(b));return r;}
typedef float f32x2_t __attribute__((ext_vector_type(2))); typedef __bf16 bf16x2_t __attribute__((ext_vector_type(2)));
__device__ __forceinline__ unsigned cvtpk_s(float lo,float hi){f32x2_t v={lo,hi};bf16x2_t b=__builtin_convertvector(v,bf16x2_t);return __builtin_bit_cast(unsigned,b);}
#define WAIT_BAR(N) asm volatile("s_waitcnt vmcnt(" #N ") lgkmcnt(0)\n\ts_barrier":::"memory")

__device__ __forceinline__ void qkt(f32x16&p0,f32x16&p1,const char*Kslot,const bf16x8*qr,const f32x16&negm,int r32,int hi){
  const char*kb=Kslot+hi*1024+r32*16;
  #pragma unroll
  for(int d0=0;d0<4;++d0){
    const bf16x8 b0=*reinterpret_cast<const bf16x8*>(kb+d0*2048);
    const bf16x8 b1=*reinterpret_cast<const bf16x8*>(kb+d0*2048+512);
    if(d0==0){p0=__builtin_amdgcn_mfma_f32_32x32x16_bf16(b0,qr[0],negm,0,0,0);p1=__builtin_amdgcn_mfma_f32_32x32x16_bf16(b1,qr[0],negm,0,0,0);}
    else{p0=__builtin_amdgcn_mfma_f32_32x32x16_bf16(b0,qr[d0],p0,0,0,0);p1=__builtin_amdgcn_mfma_f32_32x32x16_bf16(b1,qr[d0],p1,0,0,0);}}
}
typedef __attribute__((address_space(3))) const char* lds_cptr;
typedef short v4i16_t __attribute__((ext_vector_type(4)));
__device__ __forceinline__ void kload8(bf16x8*kf,lds_cptr kp){
  kf[0]=*(const __attribute__((address_space(3))) bf16x8*)(kp);      kf[1]=*(const __attribute__((address_space(3))) bf16x8*)(kp+512);
  kf[2]=*(const __attribute__((address_space(3))) bf16x8*)(kp+2048); kf[3]=*(const __attribute__((address_space(3))) bf16x8*)(kp+2560);
  kf[4]=*(const __attribute__((address_space(3))) bf16x8*)(kp+4096); kf[5]=*(const __attribute__((address_space(3))) bf16x8*)(kp+4608);
  kf[6]=*(const __attribute__((address_space(3))) bf16x8*)(kp+6144); kf[7]=*(const __attribute__((address_space(3))) bf16x8*)(kp+6656);
}
__device__ __forceinline__ void kload2(bf16x8*kf,lds_cptr kp,int j){ kf[2*j]=*(const __attribute__((address_space(3))) bf16x8*)(kp+j*2048); kf[2*j+1]=*(const __attribute__((address_space(3))) bf16x8*)(kp+j*2048+512); }
__device__ __forceinline__ s16x4 vtr(lds_cptr p){ return __builtin_bit_cast(s16x4,__builtin_amdgcn_ds_read_tr16_b64_v4i16((__attribute__((address_space(3))) v4i16_t*)p)); }
__device__ __forceinline__ float rowmax(const f32x16&p0,const f32x16&p1){
  float a=max3f(p0[0],p0[1],p1[0]),b=max3f(p0[2],p0[3],p1[1]);a=max3f(a,p1[2],p1[3]);
  #pragma unroll
  for(int r=4;r<16;r+=4){a=max3f(a,p0[r],p0[r+1]);b=max3f(b,p0[r+2],p0[r+3]);a=max3f(a,p1[r],p1[r+1]);b=max3f(b,p1[r+2],p1[r+3]);}
  const float m=max2f(a,b);
  auto rr=__builtin_amdgcn_permlane32_swap(__float_as_uint(m),__float_as_uint(m),false,false);
  return max2f(__uint_as_float(rr[0]),__uint_as_float(rr[1]));
}
__device__ __forceinline__ void pv(f32x16*o,int vb,bf16x8 pa0,bf16x8 pa1,bf16x8 pa2,bf16x8 pa3){
  #pragma unroll
  for(int d0=0;d0<4;++d0){s16x4 lo[4],hi[4];
    #pragma unroll
    for(int ks=0;ks<4;++ks){
      asm volatile("ds_read_b64_tr_b16 %0,%1 offset:%c2":"=&v"(lo[ks]):"v"(vb),"i"(d0*4096+ks*1024):"memory");
      asm volatile("ds_read_b64_tr_b16 %0,%1 offset:%c2":"=&v"(hi[ks]):"v"(vb),"i"(d0*4096+ks*1024+512):"memory");}
    asm volatile("s_waitcnt lgkmcnt(0)":::"memory");SBAR();
    #define PK(k) (bf16x8){lo[k][0],lo[k][1],lo[k][2],lo[k][3],hi[k][0],hi[k][1],hi[k][2],hi[k][3]}
    o[d0]=__builtin_amdgcn_mfma_f32_32x32x16_bf16(pa0,PK(0),o[d0],0,0,0);
    o[d0]=__builtin_amdgcn_mfma_f32_32x32x16_bf16(pa1,PK(1),o[d0],0,0,0);
    o[d0]=__builtin_amdgcn_mfma_f32_32x32x16_bf16(pa2,PK(2),o[d0],0,0,0);
    o[d0]=__builtin_amdgcn_mfma_f32_32x32x16_bf16(pa3,PK(3),o[d0],0,0,0);
    #undef PK
  }
}

#ifndef ATTN_STORE16
#define ATTN_STORE16(p,v) (*(u32x4*)(p)=(v))
#endif
template<int THRL> __device__ __forceinline__ void attn_unit(int b,int qkcol,int vcol,int qb,const bf16*Q,const bf16*__restrict__ K,const bf16*__restrict__ V,bf16*O,char*shm,int wave_id){
  int tid_=wave_id*64+pg8::lane_id_v(); asm volatile("":"+v"(tid_)); const int tid=tid_,lane=tid&63,r32=lane&31,hi=lane>>5; const int wid=__builtin_amdgcn_readfirstlane(tid>>6);
  const long rowbase=(long)b*SEQ; const int q0=qb*QB;
  const bf16*Qw=Q+(rowbase+q0+wid*QBLK)*DM+qkcol;
  const bf16*Kh=K+rowbase*DM+qkcol,*Vh=V+rowbase*DM+vcol;
  const unsigned lds0=(unsigned)(uintptr_t)shm;
  float*wsf=(float*)(shm+LDS_WS)+wid*64;
  const unsigned koff=(unsigned)(lane*DM+wid*8)*2u;
  const unsigned voff=(unsigned)((16*(wid&3)+(lane>>2))*DM+(wid>>2)*32+(lane&3)*8)*2u;
  const unsigned kdst=lds0+LDS_K+wid*1024, vdst=lds0+LDS_V+wid*1024;
  #define DMA_K(t,slot) glds16o(koff,Kh+(long)(t)*KVBLK*DM,(unsigned)__builtin_amdgcn_readfirstlane(kdst+(slot)))
  #define DMA_V(t,slot) do{ glds16o(voff,Vh+(long)(t)*KVBLK*DM,(unsigned)__builtin_amdgcn_readfirstlane(vdst+2*(slot))); glds16o(voff,Vh+(long)(t)*KVBLK*DM+64,(unsigned)__builtin_amdgcn_readfirstlane(vdst+2*(slot)+8192)); }while(0)
  const int vb0=(int)(lds0+LDS_V)+((lane>>4)&1)*32+(lane&3)*8+(4*hi+((lane&15)>>2))*64;
  const char*Kbase=shm+LDS_K; bf16x8 kf[8];
  const lds_cptr shm3=(lds_cptr)shm; const lds_cptr kp0=shm3+LDS_K+hi*1024+r32*16; const lds_cptr vp0=shm3+LDS_V+((lane>>4)&1)*32+(lane&3)*8+(4*hi+((lane&15)>>2))*64;
  const int NT=(q0+QB)/KVBLK;
  DMA_K(0,0);DMA_V(0,0);DMA_K(1,SLOTB);
  bf16x8 qr[4];
  #pragma unroll
  for(int d0=0;d0<4;++d0)qr[d0]=*reinterpret_cast<const bf16x8*>(&Qw[(long)r32*DM+d0*16+hi*8]);
  float mhat=0.f,l_reg=0.f;f32x16 o[4];o[0]=f32x16{};o[1]=f32x16{};o[2]=f32x16{};o[3]=f32x16{};
  const lds_cptr qp0=shm3+LDS_QS+wid*4096+lane*16;
  #pragma unroll
  for(int d0=0;d0<4;++d0)*(__attribute__((address_space(3))) bf16x8*)(qp0+d0*1024)=qr[d0];
  #define QF(d) (qr[d])
  f32x16 negm;
  #pragma unroll
  for(int r=0;r<16;++r){ float z_; asm volatile("v_mov_b32 %0, 0":"=v"(z_)); negm[r]=z_; }
  asm volatile("":"+v"(negm));
  #define ZERO16 negm
  const int qrel=wid*QBLK+r32;
  #define CMASK(P0,P1,t) do{int jb_=(t)-(NT-4); if(jb_>=0)cmask(P0,P1,jb_,qrel,hi);}while(0)
  bool resc=false;
  #define START(P0,P1) do{ const float rm=rowmax(P0,P1); resc=false; \
    { const float dl=rm; mhat=fadd_s(mhat,dl); \
      _Pragma("unroll") for(int r=0;r<16;++r){P0[r]=fsub_s(P0[r],dl);P1[r]=fsub_s(P1[r],dl);} \
      _Pragma("unroll") for(int r=0;r<16;++r)negm[r]=-mhat; asm volatile("":"+v"(negm)); } \
    _Pragma("unroll") for(int r=0;r<16;++r)P0[r]=__builtin_amdgcn_exp2f(P0[r]); }while(0)
  #define RESC() do{ if(resc){ asm volatile("s_waitcnt lgkmcnt(0)":::"memory"); \
      _Pragma("unroll") for(int d_=0;d_<4;++d_) _Pragma("unroll") for(int r=0;r<16;++r)o[d_][r]*=wsf[crow(r,hi)]; } }while(0)
  f32x16 pA0,pA1,pB0,pB1;
  int sl_prev=0,sl_cur=0,sl_next=SLOTB;
  #define ROT() do{sl_prev=sl_cur;sl_cur=sl_next;sl_next=(sl_next==(NSLOT-1)*SLOTB)?0:sl_next+SLOTB;}while(0)
  DMA_K(2,2*SLOTB);
  WAIT_BAR(3);
  { const f32x16 z0_=f32x16{}; qkt(pA0,pA1,Kbase,qr,z0_,r32,hi); }asm volatile("s_nop 15\n\ts_nop 7":"+v"(pA0),"+v"(pA1));CMASK(pA0,pA1,0);
  START(pA0,pA1);
  _Pragma("unroll") for(int r=0;r<16;++r)pA1[r]=__builtin_amdgcn_exp2f(pA1[r]);
  WAIT_BAR(0);
  DMA_K(3,0);DMA_V(1,SLOTB);
  ROT();
  kload8(kf,kp0+sl_cur);
  WAIT_BAR(3);
  s16x4 vlo[4],vhi[4]; u32x4 pw0,pw1,pw2,pw3;
  #define PKW(P,B) cvtpk_s(P[B],P[B+1])
  #define PAF(k) __builtin_bit_cast(bf16x8,pw##k)
  #define VFR(i) (bf16x8){vlo[i][0],vlo[i][1],vlo[i][2],vlo[i][3],vhi[i][0],vhi[i][1],vhi[i][2],vhi[i][3]}
  #define PIN(x) asm volatile("":"+v"(x))
  #define MX3(a,b,c) __builtin_fmaxf(__builtin_fmaxf((a),(b)),(c))
  #define GAPA(MF,A0,A1,A2,A3,W0,W1,PW) do{ MF; sacc+=A0; sacc+=A1; sacc+=A2; sacc+=A3; PIN(sacc); W0; W1; PIN(PW); SBAR(); }while(0)
  #define EX(v) __builtin_amdgcn_exp2f(v)
  #define GAPB(MF,X,B) do{ MF; X[B]=EX(X[B]); X[B+1]=EX(X[B+1]); X[B+2]=EX(X[B+2]); X[B+3]=EX(X[B+3]); PIN(X); SBAR(); }while(0)
  #define GAPC(MF,RD,X,B) do{ MF; RD; X[B]=EX(X[B]); X[B+1]=EX(X[B+1]); PIN(X); SBAR(); }while(0)
  #define VRD2(i) do{ vlo[i]=vtr(vp_+((((i)>>2)+2)*4096+((i)&3)*1024)); vhi[i]=vtr(vp_+((((i)>>2)+2)*4096+((i)&3)*1024+512)); }while(0)
  #define VRDS(s_,f_) do{ vlo[s_]=vtr(vp_+(((f_)>>2)*4096+((f_)&3)*1024)); vhi[s_]=vtr(vp_+(((f_)>>2)*4096+((f_)&3)*1024+512)); }while(0)
  #define VRD(i) do{ vlo[i]=vtr(vp_+(((i)>>2)*4096+((i)&3)*1024)); vhi[i]=vtr(vp_+(((i)>>2)*4096+((i)&3)*1024+512)); }while(0)
  #define KRD(G,j) do{ if(G){ kload2(kf,kp0+sl_next,j); SBAR(); } }while(0)
  #define STEP(C0,C1,P0,P1,t,GK,GV,GL) do{ SBAR(); \
    const lds_cptr vp_=vp0+2*sl_prev; \
    VRDS(0,0); SBAR(); float sacc=(P0[0]+P0[1]); \
    GAPA(C0=__builtin_amdgcn_mfma_f32_32x32x16_bf16(kf[0],QF(0),ZERO16,0,0,0), P0[2],P0[3],P0[4],P0[5],     pw0[0]=PKW(P0,0), pw0[1]=PKW(P0,2), pw0); \
    GAPA(C1=__builtin_amdgcn_mfma_f32_32x32x16_bf16(kf[1],QF(0),ZERO16,0,0,0), P0[6],P0[7],P0[8],P0[9],     pw0[2]=PKW(P0,4), pw0[3]=PKW(P0,6), pw0); \
    VRDS(1,4); SBAR(); GAPA(C0=__builtin_amdgcn_mfma_f32_32x32x16_bf16(kf[2],QF(1),C0,0,0,0),   P0[10],P0[11],P0[12],P0[13], pw1[0]=PKW(P0,8), pw1[1]=PKW(P0,10), pw1); \
    GAPA(C1=__builtin_amdgcn_mfma_f32_32x32x16_bf16(kf[3],QF(1),C1,0,0,0),   P0[14],P0[15],P1[0],P1[1],   pw1[2]=PKW(P0,12),pw1[3]=PKW(P0,14), pw1); \
    VRDS(2,1); SBAR(); GAPA(C0=__builtin_amdgcn_mfma_f32_32x32x16_bf16(kf[4],QF(2),C0,0,0,0),   P1[2],P1[3],P1[4],P1[5],     pw2[0]=PKW(P1,0), pw2[1]=PKW(P1,2), pw2); \
    GAPA(C1=__builtin_amdgcn_mfma_f32_32x32x16_bf16(kf[5],QF(2),C1,0,0,0),   P1[6],P1[7],P1[8],P1[9],     pw2[2]=PKW(P1,4), pw2[3]=PKW(P1,6), pw2); \
    VRDS(3,5); SBAR(); GAPA(C0=__builtin_amdgcn_mfma_f32_32x32x16_bf16(kf[6],QF(3),C0,0,0,0),   P1[10],P1[11],P1[12],P1[13], pw3[0]=PKW(P1,8), pw3[1]=PKW(P1,10), pw3); \
    GAPA(C1=__builtin_amdgcn_mfma_f32_32x32x16_bf16(kf[7],QF(3),C1,0,0,0),   P1[14],P1[15],0.f,0.f,       pw3[2]=PKW(P1,12),pw3[3]=PKW(P1,14), pw3); \
    l_reg+=sacc; \
    if(GK){DMA_K((t)+3,sl_cur);} if(GV){DMA_V((t)+1,sl_next);} \
    CMASK(C0,C1,t); \
    { float a=MX3(C0[0],C0[1],C1[0]),b=MX3(C0[2],C0[3],C1[1]); a=MX3(a,C1[2],C1[3]); \
      _Pragma("unroll") for(int r=4;r<16;r+=4){a=MX3(a,C0[r],C0[r+1]);b=MX3(b,C0[r+2],C0[r+3]);a=MX3(a,C1[r],C1[r+1]);b=MX3(b,C1[r+2],C1[r+3]);} \
      float rm=__builtin_fmaxf(a,b); { auto rr=__builtin_amdgcn_permlane32_swap(__float_as_uint(rm),__float_as_uint(rm),false,false); rm=__builtin_fmaxf(__uint_as_float(rr[0]),__uint_as_float(rr[1])); } \
      resc=false; \
      if(__builtin_expect(__any(rm>(float)THRL),0)){ const float dl=__builtin_fmaxf(rm,0.f); mhat+=dl; \
        _Pragma("unroll") for(int r=0;r<16;++r){C0[r]-=dl;C1[r]-=dl;} \
        _Pragma("unroll") for(int r=0;r<16;++r)negm[r]=-mhat; asm volatile("":"+v"(negm)); \
        const float f=__builtin_amdgcn_exp2f(-dl); l_reg*=f; if(hi==0)wsf[r32]=f; resc=true; } } \
    SBAR(); \
    GAPC(o[0]=__builtin_amdgcn_mfma_f32_32x32x16_bf16(PAF(0),VFR(0),o[0],0,0,0), VRDS(0,2), C0,0); \
    GAPC(o[1]=__builtin_amdgcn_mfma_f32_32x32x16_bf16(PAF(0),VFR(1),o[1],0,0,0), VRDS(1,6), C0,2); \
    GAPC(o[0]=__builtin_amdgcn_mfma_f32_32x32x16_bf16(PAF(1),VFR(2),o[0],0,0,0), VRDS(2,3), C0,4); \
    GAPC(o[1]=__builtin_amdgcn_mfma_f32_32x32x16_bf16(PAF(1),VFR(3),o[1],0,0,0), VRDS(3,7), C0,6); \
    GAPC(o[0]=__builtin_amdgcn_mfma_f32_32x32x16_bf16(PAF(2),VFR(0),o[0],0,0,0), VRDS(0,8), C0,8); \
    GAPC(o[1]=__builtin_amdgcn_mfma_f32_32x32x16_bf16(PAF(2),VFR(1),o[1],0,0,0), VRDS(1,12), C0,10); \
    GAPC(o[0]=__builtin_amdgcn_mfma_f32_32x32x16_bf16(PAF(3),VFR(2),o[0],0,0,0), VRDS(2,9), C0,12); \
    GAPC(o[1]=__builtin_amdgcn_mfma_f32_32x32x16_bf16(PAF(3),VFR(3),o[1],0,0,0), VRDS(3,13), C0,14); \
    GAPC(o[2]=__builtin_amdgcn_mfma_f32_32x32x16_bf16(PAF(0),VFR(0),o[2],0,0,0), VRDS(0,10), C1,0); \
    GAPC(o[3]=__builtin_amdgcn_mfma_f32_32x32x16_bf16(PAF(0),VFR(1),o[3],0,0,0), VRDS(1,14), C1,2); \
    KRD(GL,0); GAPC(o[2]=__builtin_amdgcn_mfma_f32_32x32x16_bf16(PAF(1),VFR(2),o[2],0,0,0), VRDS(2,11), C1,4); \
    KRD(GL,1); GAPC(o[3]=__builtin_amdgcn_mfma_f32_32x32x16_bf16(PAF(1),VFR(3),o[3],0,0,0), VRDS(3,15), C1,6); \
    KRD(GL,2); GAPC(o[2]=__builtin_amdgcn_mfma_f32_32x32x16_bf16(PAF(2),VFR(0),o[2],0,0,0), (void)0, C1,8); \
    KRD(GL,3); GAPC(o[3]=__builtin_amdgcn_mfma_f32_32x32x16_bf16(PAF(2),VFR(1),o[3],0,0,0), (void)0, C1,10); \
    GAPC(o[2]=__builtin_amdgcn_mfma_f32_32x32x16_bf16(PAF(3),VFR(2),o[2],0,0,0), (void)0, C1,12); \
    GAPC(o[3]=__builtin_amdgcn_mfma_f32_32x32x16_bf16(PAF(3),VFR(3),o[3],0,0,0), (void)0, C1,14); \
    }while(0)
  int t=1;
  #undef CMASK
  #define CMASK(P0,P1,t) do{}while(0)
  for(;t+5<NT;t+=2){
    STEP(pB0,pB1,pA0,pA1,t,true,true,true);     WAIT_BAR(3); RESC(); ROT();
    STEP(pA0,pA1,pB0,pB1,t+1,true,true,true);   WAIT_BAR(3); RESC(); ROT();
  }
  #undef CMASK
  #define CMASK(P0,P1,t) do{int jb_=(t)-(NT-4); if(jb_>=0)cmask(P0,P1,jb_,qrel,hi);}while(0)
  #define ENDW(tt) do{ if((tt)+3<NT){WAIT_BAR(3);} else if((tt)+2<NT){WAIT_BAR(2);} else {WAIT_BAR(0);} }while(0)
  for(;t+1<NT;t+=2){
    STEP(pB0,pB1,pA0,pA1,t,(t+3<NT),(t+1<NT),(t+1<NT));       ENDW(t);   RESC(); ROT();
    STEP(pA0,pA1,pB0,pB1,t+1,(t+4<NT),(t+2<NT),(t+2<NT));     ENDW(t+1); RESC(); ROT();
  }
  STEP(pB0,pB1,pA0,pA1,NT-1,false,false,false); RESC();
  { float sacc=pB0[0]+pB0[1]; _Pragma("unroll") for(int r=2;r<16;++r)sacc+=pB0[r]; _Pragma("unroll") for(int r=0;r<16;++r)sacc+=pB1[r]; l_reg+=sacc;
    pw0=(u32x4){PKW(pB0,0),PKW(pB0,2),PKW(pB0,4),PKW(pB0,6)};pw1=(u32x4){PKW(pB0,8),PKW(pB0,10),PKW(pB0,12),PKW(pB0,14)};pw2=(u32x4){PKW(pB1,0),PKW(pB1,2),PKW(pB1,4),PKW(pB1,6)};pw3=(u32x4){PKW(pB1,8),PKW(pB1,10),PKW(pB1,12),PKW(pB1,14)};
    SBAR(); pv(o,vb0+2*sl_cur,PAF(0),PAF(1),PAF(2),PAF(3)); }
  #undef PKW
  #undef PAF
  #undef VFR
  #undef PIN
  #undef MX3
  #undef GAPA
  #undef GAPB
  #undef EX
  #undef VRD
  #undef VRDS
  #undef VRD2
  #undef GAPC
  #undef KRD
  #undef STEP
  #undef ENDW
  {auto rr=__builtin_amdgcn_permlane32_swap(__float_as_uint(l_reg),__float_as_uint(l_reg),false,false);l_reg=__uint_as_float(rr[0])+__uint_as_float(rr[1]);}
  if(hi==0)wsf[32+r32]=l_reg;asm volatile("s_waitcnt lgkmcnt(0)":::"memory");
  float rli[16];
  #pragma unroll
  for(int r=0;r<16;++r)rli[r]=__builtin_amdgcn_rcpf(wsf[32+crow(r,hi)]);
  bf16*Ow=O+(rowbase+q0+wid*QBLK)*DM+vcol;
  { bf16*stg=(bf16*)(shm+LDS_OST)+wid*2048;
    #pragma unroll
    for(int hf=0;hf<2;++hf){
      #pragma unroll
      for(int r=0;r<16;++r){const int orow=crow(r,hi);
        #pragma unroll
        for(int d0=0;d0<2;++d0)stg[orow*64+d0*32+r32]=__float2bfloat16(o[2*hf+d0][r]*rli[r]);}
      asm volatile("s_waitcnt lgkmcnt(0)":::"memory");
      #pragma unroll
      for(int i=0;i<4;++i){const int row=i*8+(lane>>3),ch=lane&7; const u32x4 v=*(const u32x4*)(stg+row*64+ch*8); ATTN_STORE16(Ow+(long)row*DM+hf*64+ch*8,v);}
      asm volatile("s_waitcnt lgkmcnt(0)":::"memory"); } }
  asm volatile("s_waitcnt lgkmcnt(0)\n\ts_barrier":::"memory");
  #undef DMA_K
  #undef DMA_V
  #undef CMASK
  #undef START
  #undef RESC
  #undef ROT
  #undef QF
  #undef ZERO16
}
constexpr int ATTN_LDS_BYTES=LDS_BYTES;
struct DiffTensors { const bf16* Q; const bf16* K; const bf16* V; bf16* O1; bf16* O2; bf16* Y; const float* subg; float lam, osc; };
#if !MK_FUSEC
template<int THRL=8> __device__ __forceinline__ void diff_attn_phase_sep(char*lds,const DiffTensors&T,int vcu,int wave_id){
  const int s=vcu&7, st=vcu>>3, b=st>>4, h=(st>>1)&7, c=st&1;
  for(int i=0;i<4;++i){ const int qb=(i==0)?s:(i==1)?15-s:(i==2)?16+s:31-s;
    attn_unit<THRL>(b,(2*h+c)*64,h*128,qb,T.Q,T.K,T.V,c?T.O2:T.O1,lds,wave_id); }
}
#else
template<int THRL=8> __device__ __forceinline__ void diff_attn_phase(char*lds,const DiffTensors&T,int vcu,int wave_id){
  const int j=vcu&15, bh=vcu>>4, b=bh>>3, h=bh&7;
  for(int i=0;i<4;++i){ const int qb=(i>>1)?31-j:j, c=i&1;
    attn_unit<THRL>(b,(2*h+c)*64,h*128,qb,T.Q,T.K,T.V,c?T.O2:T.O1,lds,wave_id);
    if(c){
      asm volatile("s_waitcnt vmcnt(0)":::"memory");
      const int lane=pg8::lane_id_v(), row=lane>>1, hf=lane&1;
      const size_t roff=((size_t)b*SEQ+(size_t)qb*QB+(size_t)wave_id*QBLK+row)*DM+h*128+hf*64;
      u32x4 a[8],d[8];
      #pragma unroll
      for(int k=0;k<8;++k){ a[k]=__builtin_nontemporal_load(reinterpret_cast<const u32x4*>(T.O1+roff+8*k)); d[k]=__builtin_nontemporal_load(reinterpret_cast<const u32x4*>(T.O2+roff+8*k)); }
      float o[64]; float ss=0.f;
      #pragma unroll
      for(int k=0;k<8;++k){
        #pragma unroll
        for(int e=0;e<4;++e){ const unsigned aw=a[k][e],dw=d[k][e];
          const float lo=__uint_as_float(aw<<16)-T.lam*__uint_as_float(dw<<16), hi_=__uint_as_float(aw&0xffff0000u)-T.lam*__uint_as_float(dw&0xffff0000u);
          o[8*k+2*e]=lo; o[8*k+2*e+1]=hi_; ss+=lo*lo+hi_*hi_; } }
      ss+=pg8::shx<1>(ss);
      const float rs=T.osc/sqrtf(ss*(1.0f/128.0f)+1e-5f);
      #pragma unroll
      for(int k=0;k<8;++k){ const f32x4v g0=*reinterpret_cast<const f32x4v*>(T.subg+hf*64+8*k), g1=*reinterpret_cast<const f32x4v*>(T.subg+hf*64+8*k+4);
        u32x4 w; w[0]=cvtpk_s(o[8*k]*rs*g0[0],o[8*k+1]*rs*g0[1]); w[1]=cvtpk_s(o[8*k+2]*rs*g0[2],o[8*k+3]*rs*g0[3]); w[2]=cvtpk_s(o[8*k+4]*rs*g1[0],o[8*k+5]*rs*g1[1]); w[3]=cvtpk_s(o[8*k+6]*rs*g1[2],o[8*k+7]*rs*g1[3]);
        *reinterpret_cast<u32x4*>(T.Y+roff+8*k)=w; }
    }
  }
}
#endif
#undef SBAR
#undef WAIT_BAR
}
namespace pg8 {
typedef int v8i32 __attribute__((ext_vector_type(8)));
__device__ __forceinline__ v8i32 cat8(const bf16x8& lo, const bf16x8& hi) { typedef int v4i32 __attribute__((ext_vector_type(4)));
    const v4i32 a = __builtin_bit_cast(v4i32, lo), b = __builtin_bit_cast(v4i32, hi); return (v8i32){a[0], a[1], a[2], a[3], b[0], b[1], b[2], b[3]}; }
template <class Epi, class Sched, bool FP8 = false>
__device__ __forceinline__ void gemm_phase2(PG8_LAS unsigned char* lds, const Sched& S, const Epi& E, int wave_id) {
    int tid_ = wave_id * 64 + lane_id_v(); asm volatile("" : "+v"(tid_));
    const int tid = tid_, wid = __builtin_amdgcn_readfirstlane(tid >> 6), lane = tid & 63, wr = wid >> 2, wc = wid & 3, fr = lane & 15, fq = lane >> 4;
    const size_t kstep = (size_t)(BK * 2);
    const unsigned ldsw = (unsigned)wid * 1024u;
    const int aoff = lds_byte(wr * 64 + fr, fq * 8), boff = lds_byte(wc * 32 + fr, fq * 8);
#define PG8_SA(b, h) (((b) * 2 + (h)) * HTB)
#define PG8_SB(b, h) ((4 + (b) * 2 + (h)) * HTB)
#define PG8_STAGE(bufoff, gbase, voff) do { _Pragma("unroll") for (int _i = 0; _i < 2; ++_i) \
        __builtin_amdgcn_global_load_lds((const unsigned*)((const char*)(gbase) + (voff)[_i]), (PG8_LAS unsigned*)(lds + (bufoff) + ldsw + _i * 8192), 16, 0, 0); } while (0)
#define PG8_LDA(dst, b, h) do { _Pragma("unroll") for (int m = 0; m < 4; ++m) _Pragma("unroll") for (int k = 0; k < 2; ++k) dst[m][k] = *(const PG8_LAS bf16x8*)(lds + PG8_SA(b, h) + aoff + m * 2048 + k * 1024); } while (0)
#define PG8_LDB(dst, b, h) do { _Pragma("unroll") for (int n = 0; n < 2; ++n) _Pragma("unroll") for (int k = 0; k < 2; ++k) dst[n][k] = *(const PG8_LAS bf16x8*)(lds + PG8_SB(b, h) + boff + n * 2048 + k * 1024); } while (0)
#define PG8_MMA(ai, bj, At, Bt) do { __builtin_amdgcn_s_setprio(1); _Pragma("unroll") for (int m = 0; m < 4; ++m) _Pragma("unroll") for (int n = 0; n < 2; ++n) { \
        if constexpr (FP8) acc[ai][bj][m][n] = __builtin_amdgcn_mfma_scale_f32_16x16x128_f8f6f4(cat8(Bt[n][0], Bt[n][1]), cat8(At[m][0], At[m][1]), acc[ai][bj][m][n], 0, 0, 0, 0x7f7f7f7f, 0, 0x7f7f7f7f); \
        else { _Pragma("unroll") for (int k = 0; k < 2; ++k) acc[ai][bj][m][n] = __builtin_amdgcn_mfma_f32_16x16x32_bf16(Bt[n][k], At[m][k], acc[ai][bj][m][n], 0, 0, 0); } } \
        __builtin_amdgcn_s_setprio(0); } while (0)
#define PG8_WAIT_V(n) asm volatile("s_waitcnt vmcnt(" #n ")" ::: "memory")
#define PG8_WAIT_L(n) asm volatile("s_waitcnt lgkmcnt(" #n ")" ::: "memory")
#define PG8_BAR __builtin_amdgcn_s_barrier()
#define PG8_SCHED __builtin_amdgcn_sched_barrier(0)
    constexpr int NH = Sched::GATHER ? 2 : 1;
#define PG8_ROWS(u, ar) do { if (Sched::GATHER) { _Pragma("unroll") for (int h_ = 0; h_ < 2; ++h_) _Pragma("unroll") for (int i_ = 0; i_ < 2; ++i_) { int R_, C_; stage_rc(tid * 16 + i_ * 8192, R_, C_); \
        ar[h_][i_] = S.arow(u, h_ * HALF + R_); } } } while (0)
#define PG8_OFFS(ar, K_, ao, bo) do { _Pragma("unroll") for (int i_ = 0; i_ < 2; ++i_) { int R_, C_; stage_rc(tid * 16 + i_ * 8192, R_, C_); \
        const int Rb_ = Epi::PERM ? ((R_ & ~31) + perm32(R_ & 31)) : R_; bo[i_] = (unsigned)(Rb_ * (K_) + C_) * 2u; \
        _Pragma("unroll") for (int h_ = 0; h_ < NH; ++h_) ao[h_][i_] = (unsigned)((Sched::GATHER ? ar[h_][i_] : R_) * (K_) + C_) * 2u; } } while (0)
#define PG8_AH(h) (Sched::GATHER ? 0 : (size_t)(h) * hsA)
    Unit cur, nxt; int ui = 0;
    if (!S.next(0, cur)) return;
    f32x4 acc[2][2][4][2];
#pragma unroll
    for (int a = 0; a < 2; ++a)
#pragma unroll
        for (int b = 0; b < 2; ++b)
#pragma unroll
            for (int m = 0; m < 4; ++m)
#pragma unroll
                for (int n = 0; n < 2; ++n) acc[a][b][m][n] = (f32x4){0.f, 0.f, 0.f, 0.f};
    bf16x8 At[4][2], B0[2][2], B1[2][2];
    const char* cA; const char* cB; int cK; S.desc(cur, cA, cB, cK);
    unsigned ao2[NH][2], bo2[2]; int arN[2][2];
    PG8_ROWS(cur, arN); PG8_OFFS(arN, cK, ao2, bo2);
    size_t hsA = (size_t)HALF * cK * 2, hsB = hsA;
    int nt = cK / BK;
    PG8_STAGE(PG8_SB(0, 0), cB, bo2); PG8_STAGE(PG8_SB(0, 1), cB + hsB, bo2); PG8_STAGE(PG8_SA(0, 0), cA, ao2[0]); PG8_STAGE(PG8_SA(0, 1), cA + PG8_AH(1), ao2[NH - 1]);
    if (wr == 1) PG8_BAR;
    PG8_WAIT_V(2); PG8_BAR;
    PG8_STAGE(PG8_SB(1, 0), cB + kstep, bo2); PG8_STAGE(PG8_SA(1, 0), cA + kstep, ao2[0]); PG8_STAGE(PG8_SB(1, 1), cB + hsB + kstep, bo2);
    PG8_WAIT_V(6); PG8_BAR;
    for (;;) {
        const bool has_next = S.next(ui + 1, nxt);
        const char* nA = cA; const char* nB = cB; int nK = cK;
        if (has_next) { S.desc(nxt, nA, nB, nK); PG8_ROWS(nxt, arN); }
#pragma unroll 1
        for (int t = 0; t < nt; t += 2) {
            const bool last = (t == nt - 2);
            _Pragma("unroll") for (int h_ = 0; h_ < NH; ++h_) asm volatile("" : "+v"(ao2[h_][0]), "+v"(ao2[h_][1]));
            asm volatile("" : "+v"(bo2[0]), "+v"(bo2[1]));
            const char* a1 = cA + (size_t)(t + 1) * kstep;
            const char* a2 = last ? nA : cA + (size_t)(t + 2) * kstep; const char* b2 = last ? nB : cB + (size_t)(t + 2) * kstep;
            const char* a3 = a2 + kstep; const char* b3 = b2 + kstep;
            PG8_LDB(B0, 0, 0); PG8_LDB(B1, 0, 1); PG8_SCHED; PG8_LDA(At, 0, 0); PG8_STAGE(PG8_SA(1, 1), a1 + PG8_AH(1), ao2[NH - 1]);
            PG8_WAIT_V(8); PG8_WAIT_L(0); PG8_BAR; PG8_MMA(0, 0, At, B0); PG8_MMA(0, 1, At, B1); PG8_BAR; PG8_SCHED;
            if (last && has_next) { PG8_OFFS(arN, nK, ao2, bo2); hsA = (size_t)HALF * nK * 2; hsB = hsA; }
            PG8_LDA(At, 0, 1); PG8_STAGE(PG8_SB(0, 0), b2, bo2); PG8_STAGE(PG8_SB(0, 1), b2 + hsB, bo2); PG8_STAGE(PG8_SA(0, 0), a2, ao2[0]);
            PG8_WAIT_V(8); PG8_WAIT_L(0); PG8_BAR; PG8_MMA(1, 0, At, B0); PG8_MMA(1, 1, At, B1); PG8_BAR; PG8_SCHED;
            PG8_LDB(B0, 1, 0); PG8_LDB(B1, 1, 1); PG8_SCHED; PG8_LDA(At, 1, 0); PG8_STAGE(PG8_SA(0, 1), a2 + PG8_AH(1), ao2[NH - 1]);
            PG8_WAIT_V(8); PG8_WAIT_L(0); PG8_BAR; PG8_MMA(0, 0, At, B0); PG8_MMA(0, 1, At, B1); PG8_BAR; PG8_SCHED;
            PG8_LDA(At, 1, 1); PG8_STAGE(PG8_SB(1, 0), b3, bo2); PG8_STAGE(PG8_SB(1, 1), b3 + hsB, bo2); PG8_STAGE(PG8_SA(1, 0), a3, ao2[0]);
            PG8_WAIT_V(8); PG8_WAIT_L(0); PG8_BAR; PG8_MMA(1, 0, At, B0); PG8_MMA(1, 1, At, B1); PG8_BAR; PG8_SCHED;
        }
        if (wr == 0) PG8_BAR;
        E(acc, cur, wr, wc, fr, fq);
        if (!has_next) break;
        if (!(Epi::KEEP_ACC && E.keep(cur))) {
#pragma unroll
        for (int a = 0; a < 2; ++a)
#pragma unroll
            for (int b = 0; b < 2; ++b)
#pragma unroll
                for (int m = 0; m < 4; ++m)
#pragma unroll
                    for (int n = 0; n < 2; ++n) acc[a][b][m][n] = (f32x4){0.f, 0.f, 0.f, 0.f}; }
        cur = nxt; cA = nA; cB = nB; cK = nK; nt = cK / BK; ++ui;
        if (wr == 1) PG8_BAR;
    }
    PG8_WAIT_V(0);
    PG8_BAR;
#undef PG8_SA
#undef PG8_SB
#undef PG8_STAGE
#undef PG8_LDA
#undef PG8_LDB
#undef PG8_MMA
#undef PG8_WAIT_V
#undef PG8_WAIT_L
#undef PG8_BAR
#undef PG8_SCHED
#undef PG8_OFFS
#undef PG8_ROWS
#undef PG8_AH
}
}
namespace pg8 {
struct EpiGate3 {
    static constexpr bool PERM = true, AFTER_DRAIN = false, KEEP_ACC = true;
    bf16_t* Mg; const unsigned char* G;
    __device__ __forceinline__ bool keep(const Unit& u) const { return (u.pn >> 8) < 2; }
    typedef unsigned u32x2e __attribute__((ext_vector_type(2)));
    static __device__ __forceinline__ f32x4 ub4(unsigned w) { return (f32x4){(float)(w & 0xffu), (float)((w >> 8) & 0xffu), (float)((w >> 16) & 0xffu), (float)(w >> 24)}; }
    static __device__ __forceinline__ f32x4 rcp4(const f32x4& v) { return (f32x4){__builtin_amdgcn_rcpf(v[0]), __builtin_amdgcn_rcpf(v[1]), __builtin_amdgcn_rcpf(v[2]), __builtin_amdgcn_rcpf(v[3])}; }
    __device__ __forceinline__ void operator()(f32x4 (&acc)[2][2][4][2], const Unit& u, int wr, int wc, int fr, int fq) const {
        const int sub = u.pn >> 8; const int row0 = u.pm * BM + wr * 64 + fr, col0 = (u.pn & 255) * BM + wc * 32 + 8 * fq;
        if (sub < 2) {
            u32x2e ga[2][4][2], gb[2][4][2];
#pragma unroll
            for (int ai = 0; ai < 2; ++ai)
#pragma unroll
                for (int m = 0; m < 4; ++m) { const size_t row = (size_t)(row0 + ai * HALF + m * 16);
#pragma unroll
                    for (int bj = 0; bj < 2; ++bj) { const int col = col0 + bj * HALF;
                        ga[ai][m][bj] = *(const u32x2e*)(G + row * 3072 + sub * 1024 + col); gb[ai][m][bj] = *(const u32x2e*)(G + row * 3072 + (sub + 1) * 1024 + col); } }
            __builtin_amdgcn_sched_barrier(0);
#pragma unroll
            for (int ai = 0; ai < 2; ++ai)
#pragma unroll
                for (int m = 0; m < 4; ++m)
#pragma unroll
                    for (int bj = 0; bj < 2; ++bj) {
                        acc[ai][bj][m][0] = acc[ai][bj][m][0] * (ub4(ga[ai][m][bj].x) * rcp4(ub4(gb[ai][m][bj].x))); acc[ai][bj][m][1] = acc[ai][bj][m][1] * (ub4(ga[ai][m][bj].y) * rcp4(ub4(gb[ai][m][bj].y))); }
        } else {
            u32x2e gv[2][4][2];
#pragma unroll
            for (int ai = 0; ai < 2; ++ai)
#pragma unroll
                for (int m = 0; m < 4; ++m) { const size_t row = (size_t)(row0 + ai * HALF + m * 16);
#pragma unroll
                    for (int bj = 0; bj < 2; ++bj) gv[ai][m][bj] = *(const u32x2e*)(G + row * 3072 + 2048 + col0 + bj * HALF); }
            __builtin_amdgcn_sched_barrier(0);
#pragma unroll
            for (int ai = 0; ai < 2; ++ai)
#pragma unroll
                for (int m = 0; m < 4; ++m) { const size_t row = (size_t)(row0 + ai * HALF + m * 16);
#pragma unroll
                    for (int bj = 0; bj < 2; ++bj) { const int col = col0 + bj * HALF;
                        *(u32x4*)(Mg + row * 1024 + col) = pack8(acc[ai][bj][m][0] * (ub4(gv[ai][m][bj].x) * (1.0f / 255.0f)), acc[ai][bj][m][1] * (ub4(gv[ai][m][bj].y) * (1.0f / 255.0f))); } }
        }
    }
};
struct MoeGatherOrder {
    static constexpr bool GATHER = true;
    int ntiles, vcu, G; const PG8_LAS int* tile_e; const PG8_LAS int* tile_r; const int* rowinfo; const char* Xp; const char* W;
    __device__ __forceinline__ bool next(int i, Unit& u) const {
        const int L = i * G + vcu; if (L >= ntiles * 4) return false;
        u.pm = L >> 2; u.pn = __builtin_amdgcn_readfirstlane(tile_e[L >> 2]) * 4 + (L & 3); return true; }
    __device__ __forceinline__ void desc(const Unit& u, const char*& Ab, const char*& Bb, int& K) const { K = 512; Ab = Xp; Bb = W + (size_t)u.pn * 256 * 1024; }
    __device__ __forceinline__ int arow(const Unit& u, int r) const { const int info = rowinfo[__builtin_amdgcn_readfirstlane(tile_r[u.pm]) + r]; return info < 0 ? 0 : (info >> 1); }
};
struct MoeDownOrder {
    static constexpr bool GATHER = false;
    int ntiles, vcu, G; const PG8_LAS int* tile_e; const char* Hp; const char* W;
    __device__ __forceinline__ bool next(int i, Unit& u) const {
        const int L = i * G + vcu; if (L >= ntiles * 4) return false;
        u.pm = L >> 2; u.pn = __builtin_amdgcn_readfirstlane(tile_e[L >> 2]) * 4 + (L & 3); return true; }
    __device__ __forceinline__ void desc(const Unit& u, const char*& Ab, const char*& Bb, int& K) const { K = 256; Ab = Hp + (size_t)u.pm * 256 * 512; Bb = W + (size_t)u.pn * 256 * 512; }
    __device__ __forceinline__ int arow(const Unit&, int r) const { return r; }
};
__device__ __forceinline__ unsigned pk4_fp8(float a, float b, float c, float d) { int w = 0; w = __builtin_amdgcn_cvt_pk_fp8_f32(a, b, w, false); w = __builtin_amdgcn_cvt_pk_fp8_f32(c, d, w, true); return (unsigned)w; }
constexpr float F8_WSCALE = 64.0f, F8_HSCALE = 8.0f;
struct EpiSwiglu8 {
    static constexpr bool PERM = true, AFTER_DRAIN = false, KEEP_ACC = false;
    unsigned char* H;
    __device__ __forceinline__ bool keep(const Unit&) const { return false; }
    __device__ __forceinline__ void operator()(const f32x4 (&acc)[2][2][4][2], const Unit& u, int wr, int wc, int fr, int fq) const {
        typedef unsigned u32x2e __attribute__((ext_vector_type(2)));
        const int row0 = u.pm * BM + wr * 64 + fr; unsigned char* base = H + (u.pn & 3) * 128 + wc * 32 + 8 * fq;
        constexpr float ds = 1.0f / F8_WSCALE;
#pragma unroll
        for (int ai = 0; ai < 2; ++ai)
#pragma unroll
            for (int m = 0; m < 4; ++m) { unsigned char* rp = base + (size_t)(row0 + ai * HALF + m * 16) * 512;
                const f32x4 g0 = acc[ai][0][m][0] * ds, g1 = acc[ai][0][m][1] * ds;
                const f32x4 h0 = g0 * sigmoid4(g0) * acc[ai][1][m][0] * (ds * F8_HSCALE), h1 = g1 * sigmoid4(g1) * acc[ai][1][m][1] * (ds * F8_HSCALE);
                u32x2e w; w.x = pk4_fp8(h0[0], h0[1], h0[2], h0[3]); w.y = pk4_fp8(h1[0], h1[1], h1[2], h1[3]); *(u32x2e*)rp = w; }
    }
};
struct EpiScatter8 {
    static constexpr bool PERM = true, AFTER_DRAIN = false, KEEP_ACC = false;
    bf16_t* Yc; const int* rowinfo; const float* roww; const PG8_LAS int* tile_r;
    __device__ __forceinline__ bool keep(const Unit&) const { return false; }
    __device__ __forceinline__ void operator()(const f32x4 (&acc)[2][2][4][2], const Unit& u, int wr, int wc, int fr, int fq) const {
        const int row0 = __builtin_amdgcn_readfirstlane(tile_r[u.pm]) + wr * 64 + fr, col0 = (u.pn & 3) * BM + wc * 32 + 8 * fq;
        int info[8]; float w[8];
#pragma unroll
        for (int it = 0; it < 8; ++it) { const int row = row0 + (it >> 2) * HALF + (it & 3) * 16; info[it] = rowinfo[row]; w[it] = roww[row] * (1.0f / (F8_WSCALE * F8_HSCALE)); }
        __builtin_amdgcn_sched_barrier(0);
#pragma unroll
        for (int it = 0; it < 8; ++it) { const int ai = it >> 2, m = it & 3;
            if (info[it] >= 0) { bf16_t* rp = Yc + (size_t)info[it] * 1024 + col0;
#pragma unroll
                for (int bj = 0; bj < 2; ++bj) *(u32x4*)(rp + bj * HALF) = pack8(acc[ai][bj][m][0] * w[it], acc[ai][bj][m][1] * w[it]); } }
    }
};
struct GateOrder {
    static constexpr bool GATHER = false;
    StaticOrder so; const char* X8; const char* W8;
    __device__ __forceinline__ bool next(int i, Unit& u) const { return so.next(i, u); }
    __device__ __forceinline__ void desc(const Unit& u, const char*& Ab, const char*& Bb, int& K) const { K = 512; Ab = X8 + (size_t)u.pm * 256 * 1024; Bb = W8 + (size_t)u.pn * 256 * 1024; }
    __device__ __forceinline__ int arow(const Unit&, int r) const { return r; }
};
struct EpiGates8 {
    static constexpr bool PERM = true, AFTER_DRAIN = false, KEEP_ACC = false;
    unsigned char* G;
    __device__ __forceinline__ bool keep(const Unit&) const { return false; }
    __device__ __forceinline__ void operator()(const f32x4 (&acc)[2][2][4][2], const Unit& u, int wr, int wc, int fr, int fq) const {
        typedef unsigned u32x2e __attribute__((ext_vector_type(2)));
        const int row0 = u.pm * BM + wr * 64 + fr; unsigned char* base = G + u.pn * 256 + wc * 32 + 8 * fq;
#pragma unroll
        for (int ai = 0; ai < 2; ++ai)
#pragma unroll
            for (int m = 0; m < 4; ++m) { unsigned char* rp = base + (size_t)(row0 + ai * HALF + m * 16) * 3072;
#pragma unroll
                for (int bj = 0; bj < 2; ++bj) { const f32x4 g0 = sigmoid4(acc[ai][bj][m][0] * (1.0f / 32.0f)) * 255.0f + 0.5f, g1 = sigmoid4(acc[ai][bj][m][1] * (1.0f / 32.0f)) * 255.0f + 0.5f;
                    unsigned q[8];
#pragma unroll
                    for (int i = 0; i < 4; ++i) { const unsigned a = (unsigned)g0[i], b = (unsigned)g1[i]; q[i] = a < 1u ? 1u : a; q[4 + i] = b < 1u ? 1u : b; }
                    u32x2e w; w.x = q[0] | (q[1] << 8) | (q[2] << 16) | (q[3] << 24); w.y = q[4] | (q[5] << 8) | (q[6] << 16) | (q[7] << 24);
                    *(u32x2e*)(rp + bj * HALF) = w; } }
    }
};
}
#define GAS __attribute__((address_space(1)))
#define LAS __attribute__((address_space(3)))
typedef unsigned short bf16;
typedef unsigned v4u __attribute__((ext_vector_type(4)));
typedef float f32x4 __attribute__((ext_vector_type(4)));
typedef short bf16x8 __attribute__((ext_vector_type(8)));
typedef GAS unsigned gu32;
typedef GAS unsigned long long gu64;
#define RLX_AGENT __ATOMIC_RELAXED, __HIP_MEMORY_SCOPE_AGENT
#define LDS_WAIT() asm volatile("s_waitcnt lgkmcnt(0)" ::: "memory")
#define VM_WAIT() asm volatile("s_waitcnt vmcnt(0)" ::: "memory")
__device__ __forceinline__ unsigned long long rt() { return __builtin_amdgcn_s_memrealtime(); }
__device__ __forceinline__ unsigned f2bf(float f) { unsigned u = __builtin_bit_cast(unsigned, f); return (u + 0x7fffu + ((u >> 16) & 1u)) >> 16; }
__device__ __forceinline__ unsigned pk2(float lo, float hi) { return f2bf(lo) | (f2bf(hi) << 16); }

#define XB_TMO      128
#define XB_XCNT(j)  (256  + 64 * (j))
#define XB_XSUB(j)  (1280 + 64 * (j))
#define XB_XGEN(j)  (2304 + 64 * (j))
#define XB_TOP      3328
#define XB_TOPGEN   3392
#define XCD_BAR_WORDS 3456
#define XB_SPIN_CAP (1u << 18)

__device__ __forceinline__ unsigned xb_ld(unsigned* p)              { return __hip_atomic_load(p, __ATOMIC_RELAXED, __HIP_MEMORY_SCOPE_AGENT); }
__device__ __forceinline__ unsigned xb_add(unsigned* p, unsigned v) { return __hip_atomic_fetch_add(p, v, __ATOMIC_RELAXED, __HIP_MEMORY_SCOPE_AGENT); }
__device__ __forceinline__ unsigned xb_xcc_id() { return (unsigned)__builtin_amdgcn_s_getreg((3 << 11) | 20) & 0xFu; }
#define XB_SPIN(cond, bar) do { unsigned _sp = 0; while (cond) { __builtin_amdgcn_s_sleep(1); \
    if ((++_sp & 255u) == 0u) { if (xb_ld(&(bar)[XB_TMO])) break; if (_sp > XB_SPIN_CAP) { atomicAdd(&(bar)[XB_TMO], 1u); break; } } } } while (0)

struct XcdBarrier {
    int wave;
    unsigned* bar; unsigned x;
    volatile LAS unsigned* st;
};

__device__ __forceinline__ XcdBarrier xcd_barrier_post(unsigned* bar, volatile LAS unsigned* st) {
    XcdBarrier b; b.wave = 0; b.bar = bar; b.x = xb_xcc_id(); b.st = st;
    if (threadIdx.x == 0) (void)xb_add(&bar[XB_XCNT(b.x)], 1u);
    return b;
}
__device__ __forceinline__ void xcd_barrier_complete(unsigned* bar, unsigned x, unsigned& nloc, unsigned& nx) {
    const unsigned G = gridDim.x * gridDim.y * gridDim.z;
    unsigned sum, cnt, mine, sp = 0u;
    for (;;) {
        sum = 0u; cnt = 0u; mine = 0u;
#pragma unroll
        for (unsigned j = 0; j < 16; ++j) { const unsigned c = xb_ld(&bar[XB_XCNT(j)]); sum += c; cnt += (c > 0u) ? 1u : 0u; mine = (j == x) ? c : mine; }
        if (sum == G) break;
        __builtin_amdgcn_s_sleep(1);
        if ((++sp & 255u) == 0u) { if (xb_ld(&bar[XB_TMO])) break; if (sp > XB_SPIN_CAP) { atomicAdd(&bar[XB_TMO], 1u); break; } }
    }
    nloc = mine > 0u ? mine : 1u; nx = cnt > 0u ? cnt : 1u;
}

__device__ __forceinline__ void xcd_barrier(const XcdBarrier& b) {
    asm volatile("s_waitcnt vmcnt(0)" ::: "memory");
    __syncthreads();
    if (b.wave == 0 && pg8::lane_id_v() == 0) {
        GAS unsigned* gbar_ = (GAS unsigned*)b.bar; unsigned bx_ = b.x; asm volatile("" : "+s"(bx_), "+s"(gbar_)); unsigned* bar = (unsigned*)gbar_;
        __builtin_amdgcn_s_waitcnt(0);
        unsigned nloc = b.st[0], nx = b.st[1];
        if (nloc == 0u) { xcd_barrier_complete(bar, bx_, nloc, nx); b.st[0] = nloc; b.st[1] = nx; }
        const unsigned old = xb_add(&bar[XB_XSUB(bx_)], 1u);
        const unsigned gen = old / nloc;
        if (old + 1u == (gen + 1u) * nloc) {
            __builtin_amdgcn_fence(__ATOMIC_RELEASE, "agent");
            asm volatile("s_waitcnt vmcnt(0)" ::: "memory");
            const unsigned og = xb_add(&bar[XB_TOP], 1u);
            const unsigned tg = og / nx;
            if (og + 1u == (tg + 1u) * nx) xb_add(&bar[XB_TOPGEN], 1u);
            else XB_SPIN(xb_ld(&bar[XB_TOPGEN]) == tg, bar);
            __builtin_amdgcn_fence(__ATOMIC_ACQUIRE, "agent");
            xb_add(&bar[XB_XGEN(bx_)], 1u);
            asm volatile("s_waitcnt vmcnt(0)" ::: "memory");
        } else {
            XB_SPIN(xb_ld(&bar[XB_XGEN(bx_)]) == gen, bar);
            __builtin_amdgcn_fence(__ATOMIC_ACQUIRE, "agent");
            asm volatile("s_waitcnt vmcnt(0)" ::: "memory");
        }
    }
    __syncthreads();
}
#ifndef MK_FUSEC
#define MK_FUSEC 0
#endif
constexpr int NWAVES = 8;
constexpr int NB = 4, SEQ = 8192, T = NB * SEQ, D = 1024, DEPTH = 2;
constexpr int NCHUNK = 2, TC = T / NCHUNK, BPC = NB / NCHUNK;
constexpr int INC = 8192;
constexpr int MEML = 256, MH = 4, MHD = 128;
constexpr int NE = 16, FF = 512;
constexpr int XG_ROWS = 2 * T + NE * 256;
constexpr int MAXTILES = XG_ROWS / 256;
constexpr float LN_EPS = 1e-5f, RMS_EPS = 1e-5f;
constexpr float ALPHA = 1.4142135623730951f;
constexpr int GRID = 256;

constexpr size_t MiB = 1u << 20;
constexpr size_t WS_CTL = 0, CTL_ZERO_BYTES = 1 * MiB;
constexpr size_t WS_WRH = 1 * MiB, WS_WRL = WS_WRH + 32768;
constexpr size_t WS_XCH = 1 * MiB + 512 * 1024;
constexpr size_t WS_WKV = 2 * MiB;
constexpr size_t WS_MEMB = 6 * MiB;
constexpr size_t WS_MEMKV = 8 * MiB;
constexpr size_t WS_COS = 12 * MiB, WS_SIN = 16 * MiB;
constexpr size_t WS_TOKPOS = 20 * MiB;
constexpr size_t WS_TOKW = WS_TOKPOS + 256 * 1024;
constexpr int CAP = T;
constexpr size_t WS_ROWINFO = 508 * MiB;
constexpr size_t WS_ROWW = 510 * MiB;
constexpr size_t WS_W = 22 * MiB;
constexpr size_t WS_WIN = WS_W, WS_WA = WS_WIN + 16 * MiB, WS_WC = WS_WA + 2 * MiB, WS_WM = WS_WC + 1 * MiB, WS_WO = WS_WM + 1 * MiB, WS_WGU = WS_WO + 2 * MiB, WS_WD = WS_WGU + 32 * MiB;
constexpr size_t WS_XB = 92 * MiB;
static_assert(WS_WD + 16 * MiB == WS_XB, "weights end at xb");
constexpr size_t WS_AREA = 156 * MiB;
constexpr size_t WS_Q = WS_AREA, WS_K = WS_Q + 32 * MiB, WS_V = WS_K + 32 * MiB, WS_CB = WS_V + 32 * MiB, WS_Z = WS_CB + 16 * MiB, WS_QM = WS_Z + 16 * MiB, WS_G = WS_QM + 16 * MiB,
                 WS_O1 = WS_G + 96 * MiB, WS_O2 = WS_O1 + 32 * MiB, WS_CH_END = WS_O2 + 32 * MiB;
constexpr size_t WS_YATT = WS_Q, WS_MERGED = WS_K, WS_MIX = WS_V;
constexpr size_t WS_MERGED0 = WS_CH_END;
constexpr size_t WS_MIXALL = WS_O1;
static_assert(WS_MERGED0 + (size_t)TC * 1024 * 2 <= 512 * MiB && WS_O2 == WS_O1 + 32 * MiB, "merged0 / mixall");
constexpr size_t WS_XB8 = WS_AREA;
constexpr size_t WS_XG = WS_AREA, WS_H = WS_XG + (size_t)XG_ROWS * 1024 * 2, WS_YC = 380 * MiB, WS_MOE_END = WS_YC + (size_t)2 * T * 1024 * 2;
constexpr size_t WS_XBIN8 = WS_G + 48 * MiB;
constexpr size_t WS_WING8 = WS_WGU + 16 * MiB;
static_assert(WS_XBIN8 + (size_t)T * 1024 <= WS_O1 && WS_XBIN8 + (size_t)T * 1024 <= WS_YC && WS_H + (size_t)XG_ROWS * 512 <= WS_XBIN8 && WS_WING8 + 3 * MiB <= WS_WD, "fp8 buffers");
constexpr size_t WS_END = 512 * MiB;
static_assert(WS_CH_END <= WS_END && WS_MOE_END <= WS_ROWINFO && WS_MERGED0 + (size_t)TC * 1024 * 2 <= WS_ROWINFO && WS_ROWW + (size_t)NE * CAP * 4 <= WS_END, "d_ws map");
static_assert(pg8::P1_COS == WS_COS && pg8::P1_SIN == WS_SIN && pg8::P1_Q == WS_Q && pg8::P1_K == WS_K && pg8::P1_V == WS_V && pg8::P1_CB == WS_CB && pg8::P1_Z == WS_Z && pg8::P1_QM == WS_QM && pg8::P1_G == WS_G, "EpiP1 offsets");
constexpr int CW_TMO = 0, CW_CODE = 1, CW_FAIL = 2;
constexpr int CW_BAR = 4096;
constexpr int CW_SEAM = 32768, SEAM_BANK = 64 * 64;
constexpr int CW_CNT = 16384;

namespace pg8 {
struct BranchOrder {
    static constexpr bool GATHER = false;
    StaticOrder so; const char* ws;
    __device__ __forceinline__ bool next(int i, Unit& u) const { if (i >= 3) return false; Unit v; if (!so.next(0, v)) return false; u.pm = v.pm; u.pn = v.pn | (i << 8); return true; }
    __device__ __forceinline__ void desc(const Unit& u, const char*& Ab, const char*& Bb, int& K) const {
        const int sub = u.pn >> 8, pn = u.pn & 255; K = sub == 0 ? 1024 : 512;
        const size_t ao = sub == 0 ? WS_YATT : (sub == 1 ? WS_CB : WS_QM), bo = sub == 0 ? WS_WA : (sub == 1 ? WS_WC : WS_WM);
        Ab = ws + ao + (size_t)u.pm * 256 * K * 2; Bb = ws + bo + (size_t)pn * 256 * K * 2; }
    __device__ __forceinline__ int arow(const Unit&, int r) const { return r; }
};
struct OutOrder {
    static constexpr bool GATHER = false;
    StaticOrder so; const char* ws;
    __device__ __forceinline__ bool next(int i, Unit& u) const { return so.next(i, u); }
    __device__ __forceinline__ void desc(const Unit& u, const char*& Ab, const char*& Bb, int& K) const { K = 1024;
        Ab = (u.pm < TC / 256) ? ws + WS_MERGED0 + (size_t)u.pm * 256 * 2048 : ws + WS_MERGED + (size_t)(u.pm - TC / 256) * 256 * 2048; Bb = ws + WS_WO + (size_t)u.pn * 256 * 2048; }
    __device__ __forceinline__ int arow(const Unit&, int r) const { return r; }
};
struct EpiMixAll {
    static constexpr bool PERM = true, AFTER_DRAIN = false, KEEP_ACC = false;
    bf16_t* O;
    __device__ __forceinline__ bool keep(const Unit&) const { return false; }
    __device__ __forceinline__ void operator()(const f32x4 (&acc)[2][2][4][2], const Unit& u, int wr, int wc, int fr, int fq) const {
        const int row0 = u.pm * BM + wr * 64 + fr; bf16_t* base = O + u.pn * BM + wc * 32 + 8 * fq;
#pragma unroll
        for (int ai = 0; ai < 2; ++ai)
#pragma unroll
            for (int m = 0; m < 4; ++m) { bf16_t* rp = base + (size_t)(row0 + ai * HALF + m * 16) * 1024;
#pragma unroll
                for (int bj = 0; bj < 2; ++bj) *(u32x4*)(rp + bj * HALF) = pack8(acc[ai][bj][m][0], acc[ai][bj][m][1]); }
    }
};
}
constexpr int RING_OFF = 0, RING_BYTES = 143360;
constexpr int LDSCTL_OFF = RING_BYTES, MISC_OFF = LDSCTL_OFF + 320, TILEE_OFF = LDSCTL_OFF + 1024, TILER_OFF = LDSCTL_OFF + 2304;
constexpr int LDS_BYTES = 147456;
static_assert(TILEE_OFF + MAXTILES * 4 + 256 <= LDS_BYTES, "LDS map");

struct Frame {
    LAS unsigned char* lds;
    unsigned char* ws;
    int wave, vcu;
};
__device__ __forceinline__ int lane_id() { return pg8::lane_id_v(); }
#define F_LANE lane_id()
#define F_TID (F.wave * 64 + lane_id())
#define F_G GRID
#define F_BX ((F.vcu & 31) * 8 + (F.vcu >> 5))
#define F_CTL ((gu32*)(F.ws + WS_CTL))
#define F_MISC ((volatile LAS unsigned*)(F.lds + MISC_OFF))
__device__ __forceinline__ float wave_sum(float v) {
    v += pg8::shx<1>(v); v += pg8::shx<2>(v); v += pg8::shx<4>(v); v += pg8::shx<8>(v); v += pg8::shx<16>(v); v += pg8::shx<32>(v);
    return v;
}
__device__ __forceinline__ f32x4 f8x4(unsigned w) {
    typedef float f32x2v __attribute__((ext_vector_type(2)));
    const f32x2v lo = __builtin_amdgcn_cvt_pk_f32_fp8((int)w, false), hi = __builtin_amdgcn_cvt_pk_f32_fp8((int)w, true); return (f32x4){lo.x, lo.y, hi.x, hi.y}; }
__device__ __forceinline__ float bfl(unsigned w) { return __uint_as_float(w << 16); }
__device__ __forceinline__ float bfh(unsigned w) { return __uint_as_float(w & 0xffff0000u); }

__device__ __forceinline__ void transpose_item(const float* W, int ldw, int k0, int nsrc, bf16* WT, int ldk, int ndst, LAS float* scr, int lane) {
    {
        f32x4 v[8]; const int kr = lane >> 3, nq = 4 * (lane & 7);
#pragma unroll
        for (int i = 0; i < 8; ++i) v[i] = *(const GAS f32x4*)(W + (size_t)(k0 + 8 * i + kr) * ldw + nsrc + nq);
#pragma unroll
        for (int i = 0; i < 8; ++i) { LAS float* d = scr + (8 * i + kr) * 33 + nq; d[0] = v[i].x; d[1] = v[i].y; d[2] = v[i].z; d[3] = v[i].w; }
    }
    LDS_WAIT(); asm volatile("" ::: "memory");
    const int c = lane & 7;
#pragma unroll
    for (int j = 0; j < 4; ++j) { const int n = (lane >> 3) + 8 * j; const LAS float* s = scr + (8 * c) * 33 + n;
        v4u o; o.x = pk2(s[0 * 33], s[1 * 33]); o.y = pk2(s[2 * 33], s[3 * 33]); o.z = pk2(s[4 * 33], s[5 * 33]); o.w = pk2(s[6 * 33], s[7 * 33]);
        *(GAS v4u*)(WT + (size_t)(ndst + n) * ldk + k0 + 8 * c) = o; }
    LDS_WAIT(); asm volatile("" ::: "memory");
}
__device__ __forceinline__ void transpose_item8(const float* W, int ldw, int k0, int nsrc, unsigned char* WT, int ldk, int ndst, float scale, LAS float* scr, int lane) {
    {   f32x4 v[8]; const int kr = lane >> 3, nq = 4 * (lane & 7);
#pragma unroll
        for (int i = 0; i < 8; ++i) v[i] = *(const GAS f32x4*)(W + (size_t)(k0 + 8 * i + kr) * ldw + nsrc + nq);
#pragma unroll
        for (int i = 0; i < 8; ++i) { LAS float* d = scr + (8 * i + kr) * 33 + nq; d[0] = v[i].x; d[1] = v[i].y; d[2] = v[i].z; d[3] = v[i].w; }
    }
    LDS_WAIT(); asm volatile("" ::: "memory");
    const int c = lane & 3;
#pragma unroll
    for (int j = 0; j < 2; ++j) { const int n = (lane >> 2) + 16 * j; const LAS float* q = scr + (16 * c) * 33 + n;
        v4u o; o.x = pg8::pk4_fp8(q[0 * 33] * scale, q[1 * 33] * scale, q[2 * 33] * scale, q[3 * 33] * scale); o.y = pg8::pk4_fp8(q[4 * 33] * scale, q[5 * 33] * scale, q[6 * 33] * scale, q[7 * 33] * scale);
        o.z = pg8::pk4_fp8(q[8 * 33] * scale, q[9 * 33] * scale, q[10 * 33] * scale, q[11 * 33] * scale); o.w = pg8::pk4_fp8(q[12 * 33] * scale, q[13 * 33] * scale, q[14 * 33] * scale, q[15 * 33] * scale);
        *(GAS v4u*)(WT + (size_t)(ndst + n) * ldk + k0 + 16 * c) = o; }
    LDS_WAIT(); asm volatile("" ::: "memory");
}
struct Args { const void* in[24]; float* out; unsigned char* ws; int ph_lo, ph_hi; };
static_assert(sizeof(Args) == 24 * 8 + 8 + 8 + 8, "no padding in Args");
__device__ __forceinline__ const void* lptr(const void* p) { const GAS unsigned char* g = (const GAS unsigned char*)p; asm volatile("" : "+s"(g)); return (const void*)g; }
__device__ __forceinline__ unsigned char* lws(unsigned char* p) { GAS unsigned char* g = (GAS unsigned char*)p; asm volatile("" : "+s"(g)); return (unsigned char*)g; }
#define INF(k) ((const float*)lptr(A.in[k]))
#define INI(k) ((const int*)lptr(A.in[k]))

__device__ __forceinline__ void convert_layer_weights(Frame& F, const Args& A, int l) {
    LAS float* scr = (LAS float*)(F.lds + RING_OFF + F.wave * 16384);
    const int gw = F.vcu * NWAVES + F.wave, NGW = F_G * NWAVES;
    unsigned char* const ws = lws(F.ws);
    bf16* Win_t = (bf16*)(ws + WS_WIN); bf16* Wa_t = (bf16*)(ws + WS_WA); bf16* Wc_t = (bf16*)(ws + WS_WC); bf16* Wm_t = (bf16*)(ws + WS_WM);
    bf16* Wo_t = (bf16*)(ws + WS_WO); bf16* Wgu_t = (bf16*)(ws + WS_WGU); bf16* Wd_t = (bf16*)(ws + WS_WD);
    const float* w_in = INF(3) + (size_t)l * D * INC;
    constexpr int I_IN = 16 * 256, I_A = 16 * 32, I_C = 8 * 32, I_O = 16 * 32, I_GU = NE * 16 * 32, I_D = NE * 8 * 32;
    constexpr int NITEMS = I_IN + I_A + 2 * I_C + I_O + I_GU + I_D;
    for (int it = gw; it < NITEMS; it += NGW) {
        int r = it;
        if (r < I_IN) { const int kb = r >> 8, n0 = (r & 255) * 32, pn = n0 >> 8, p = n0 & 255; int src;
            if (pn < 8) src = 256 * pn + 64 * ((p >> 5) & 3) + 32 * (p >> 7);
            else if (pn >= 14 && pn < 18) src = (p < 128 ? 3584 : 4096) + 128 * (pn - 14) + (p & 127);
            else src = n0;
            if (pn >= 20) transpose_item8(w_in, INC, kb * 64, src, (unsigned char*)(ws + WS_WING8), 1024, n0 - 5120, 32.0f, scr, F_LANE);
            else transpose_item(w_in, INC, kb * 64, src, Win_t, 1024, n0, scr, F_LANE);
            continue; }
        r -= I_IN;
        if (r < I_A) { transpose_item(INF(11) + (size_t)l * 1024 * 1024, 1024, (r >> 5) * 64, (r & 31) * 32, Wa_t, 1024, (r & 31) * 32, scr, F_LANE); continue; }
        r -= I_A;
        if (r < I_C) { transpose_item(INF(12) + (size_t)l * 512 * 1024, 1024, (r >> 5) * 64, (r & 31) * 32, Wc_t, 512, (r & 31) * 32, scr, F_LANE); continue; }
        r -= I_C;
        if (r < I_C) { transpose_item(INF(13) + (size_t)l * 512 * 1024, 1024, (r >> 5) * 64, (r & 31) * 32, Wm_t, 512, (r & 31) * 32, scr, F_LANE); continue; }
        r -= I_C;
        if (r < I_O) { transpose_item(INF(14) + (size_t)l * 1024 * 1024, 1024, (r >> 5) * 64, (r & 31) * 32, Wo_t, 1024, (r & 31) * 32, scr, F_LANE); continue; }
        r -= I_O;
        if (r < I_GU) { const int e = r >> 9, q = r & 511, kb = q >> 5, n0 = (q & 31) * 32, pnl = n0 >> 8, p = n0 & 255;
            const float* src = (p < 128 ? INF(21) : INF(22)) + (size_t)(l * NE + e) * 1024 * 512;
            transpose_item8(src, 512, kb * 64, 128 * pnl + (p & 127), (unsigned char*)Wgu_t + (size_t)e * 1024 * 1024, 1024, n0, pg8::F8_WSCALE, scr, F_LANE); continue; }
        r -= I_GU;
        { const int e = r >> 8, q = r & 255; transpose_item8(INF(23) + (size_t)(l * NE + e) * 512 * 1024, 1024, (q >> 5) * 64, (q & 31) * 32, (unsigned char*)Wd_t + (size_t)e * 1024 * 512, 512, (q & 31) * 32, pg8::F8_WSCALE, scr, F_LANE); }
    }
}

__device__ __forceinline__ void row_to_bf16(const float* xrow, bf16* orow, int lane) {
    const GAS f32x4* xr = (const GAS f32x4*)xrow + lane; GAS unsigned long long* o8 = (GAS unsigned long long*)orow + lane;
#pragma unroll
    for (int j = 0; j < 4; ++j) { const f32x4 v = xr[64 * j]; o8[64 * j] = (unsigned long long)pk2(v.x, v.y) | ((unsigned long long)pk2(v.z, v.w) << 32); }
}

__device__ __forceinline__ void p0_prologue(Frame& F, const Args& A) {
    const int gw = F.vcu * NWAVES + F.wave, NGW = F_G * NWAVES;
    unsigned char* const ws = lws(F.ws);
    convert_layer_weights(F, A, 0);
    {
        LAS float* scr = (LAS float*)(F.lds + RING_OFF + F.wave * 16384); bf16* Wkv_t = (bf16*)(ws + WS_WKV);
        for (int it = gw; it < 2 * 512; it += NGW) { const int l = it >> 9, r = it & 511;
            transpose_item(INF(10) + (size_t)l * 1024 * 1024, 1024, (r >> 5) * 64, (r & 31) * 32, Wkv_t + (size_t)l * 1024 * 1024, 1024, (r & 31) * 32, scr, F_LANE); }
    }
    bf16* XBp = (bf16*)(ws + WS_XB); bf16* MEMB = (bf16*)(ws + WS_MEMB);
    {
        const float* xsrc = INF(0); const int lane = F_LANE;
        for (int m0 = gw; m0 < T; m0 += 4 * NGW) {
            f32x4 v[4][4];
#pragma unroll
            for (int q = 0; q < 4; ++q) { const GAS f32x4* xr = (const GAS f32x4*)(xsrc + (size_t)(m0 + q * NGW) * D) + lane;
#pragma unroll
                for (int j = 0; j < 4; ++j) v[q][j] = xr[64 * j]; }
#pragma unroll
            for (int q = 0; q < 4; ++q) { GAS unsigned long long* o8 = (GAS unsigned long long*)(XBp + (size_t)(m0 + q * NGW) * D) + lane; GAS unsigned* x8 = (GAS unsigned*)(ws + WS_XBIN8 + (size_t)(m0 + q * NGW) * D) + lane;
#pragma unroll
                for (int j = 0; j < 4; ++j) { o8[64 * j] = (unsigned long long)pk2(v[q][j].x, v[q][j].y) | ((unsigned long long)pk2(v[q][j].z, v[q][j].w) << 32); x8[64 * j] = pg8::pk4_fp8(v[q][j].x, v[q][j].y, v[q][j].z, v[q][j].w); } }
        }
    }
    for (int m = gw; m < NB * MEML; m += NGW) row_to_bf16(INF(1) + (size_t)m * D, MEMB + (size_t)m * D, F_LANE);
    {
        float* cosT = (float*)(ws + WS_COS); float* sinT = (float*)(ws + WS_SIN);
        const int gt = F.vcu * (NWAVES * 64) + F_TID, NGT = F_G * NWAVES * 64;
        for (int i = gt; i < T * 32; i += NGT) { const int t = i >> 5, d = i & 31;
            const float inv = (float)exp2(-(double)d * (13.287712379549449 / 32.0));
            const float ang = (float)INI(2)[t] * inv;
            const double a = (double)ang; const double n = rint(a * 0.15915494309189535); const float r = (float)(a - n * 6.283185307179586);
            cosT[i] = cosf(r); sinT[i] = sinf(r); }
        bf16* WRH = (bf16*)(ws + WS_WRH); bf16* WRL = (bf16*)(ws + WS_WRL);
        for (int i = gt; i < 32 * 64 * 8; i += NGT) { const int j = i & 7, L = (i >> 3) & 63, ks = i >> 9;
            const float w = INF(19)[(size_t)(32 * ks + 8 * (L >> 4) + j) * NE + (L & 15)]; const unsigned h = f2bf(w); const float rem = w - __uint_as_float(h << 16);
            WRH[i] = (bf16)h; WRL[i] = (bf16)f2bf(rem); }
    }
}

namespace memattn {
typedef short bf16x8 __attribute__((ext_vector_type(8)));
typedef short s16x4 __attribute__((ext_vector_type(4)));
typedef float f32x16 __attribute__((ext_vector_type(16)));
constexpr int KS_STRIDE = 272, VT_STRIDE = 528, LDS_VT = 256 * KS_STRIDE, LDS_TOTAL = LDS_VT + 128 * VT_STRIDE;
__device__ __forceinline__ void unit(int bglob, int blocal, int hm, int qblk, bf16* QM, const bf16* KV, int ldkv, LAS unsigned char* lds, int wave_id) {
    int tid_ = wave_id * 64 + pg8::lane_id_v(); asm volatile("" : "+v"(tid_)); const int tid = tid_, lane = tid & 63, r32 = lane & 31, hi = lane >> 5, wid = tid >> 6;
#pragma unroll
    for (int j = 0; j < 8; ++j) { const int id = tid + 512 * j, key = id >> 4, ch = id & 15;
        const v4u v = *(const v4u*)(KV + (size_t)(bglob * MEML + key) * ldkv + hm * MHD + ch * 8);
        *(LAS v4u*)(lds + key * KS_STRIDE + ch * 16) = v; }
#pragma unroll
    for (int j = 0; j < 8; ++j) { const int id = tid + 512 * j, key = id >> 4, ch = id & 15;
        const v4u v = *(const v4u*)(KV + (size_t)(bglob * MEML + key) * ldkv + 512 + hm * MHD + ch * 8);
        const unsigned w[4] = {v.x, v.y, v.z, v.w};
#pragma unroll
        for (int e = 0; e < 8; ++e) *(LAS unsigned short*)(lds + LDS_VT + (ch * 8 + e) * VT_STRIDE + key * 2) = (unsigned short)((w[e >> 1] >> (16 * (e & 1))) & 0xffffu); }
    bf16* qrow = QM + (size_t)(blocal * SEQ + qblk * 256 + wid * 32 + r32) * 512 + hm * MHD;
    bf16x8 qf[8];
#pragma unroll
    for (int ks = 0; ks < 8; ++ks) qf[ks] = *(const bf16x8*)(qrow + 16 * ks + 8 * hi);
    __syncthreads();
    f32x16 p[8];
#pragma unroll
    for (int kb = 0; kb < 8; ++kb) { p[kb] = (f32x16){};
#pragma unroll
        for (int ks = 0; ks < 8; ++ks) { const bf16x8 kf = *(const LAS bf16x8*)(lds + (32 * kb + r32) * KS_STRIDE + (16 * ks + 8 * hi) * 2);
            p[kb] = __builtin_amdgcn_mfma_f32_32x32x16_bf16(kf, qf[ks], p[kb], 0, 0, 0); }
        __builtin_amdgcn_sched_barrier(0); }
    float m = -INFINITY;
#pragma unroll
    for (int kb = 0; kb < 8; ++kb)
#pragma unroll
        for (int r = 0; r < 16; ++r) m = fmaxf(m, p[kb][r]);
    m = fmaxf(m, pg8::shx<32>(m));
    float l = 0.f;
#pragma unroll
    for (int kb = 0; kb < 8; ++kb)
#pragma unroll
        for (int r = 0; r < 16; ++r) { const float e = __builtin_amdgcn_exp2f(p[kb][r] - m); p[kb][r] = e; l += e; }
    l += pg8::shx<32>(l);
    bf16x8 pf[8][2];
#pragma unroll
    for (int kb = 0; kb < 8; ++kb)
#pragma unroll
        for (int s = 0; s < 2; ++s) { v4u w; w.x = pg8::cvt_pk_bf16(p[kb][8 * s + 0], p[kb][8 * s + 1]); w.y = pg8::cvt_pk_bf16(p[kb][8 * s + 2], p[kb][8 * s + 3]);
            w.z = pg8::cvt_pk_bf16(p[kb][8 * s + 4], p[kb][8 * s + 5]); w.w = pg8::cvt_pk_bf16(p[kb][8 * s + 6], p[kb][8 * s + 7]); pf[kb][s] = __builtin_bit_cast(bf16x8, w); }
    f32x16 o[4];
#pragma unroll
    for (int db = 0; db < 4; ++db) { o[db] = (f32x16){};
#pragma unroll
        for (int kb = 0; kb < 8; ++kb)
#pragma unroll
            for (int s = 0; s < 2; ++s) { const LAS unsigned char* vp = lds + LDS_VT + (32 * db + r32) * VT_STRIDE + (32 * kb + 16 * s + 4 * hi) * 2;
                const s16x4 a = *(const LAS s16x4*)vp, b = *(const LAS s16x4*)(vp + 16);
                const bf16x8 vf = (bf16x8){a[0], a[1], a[2], a[3], b[0], b[1], b[2], b[3]};
                o[db] = __builtin_amdgcn_mfma_f32_32x32x16_bf16(vf, pf[kb][s], o[db], 0, 0, 0); }
        __builtin_amdgcn_sched_barrier(0); }
    const float rl = 1.0f / l;
    int qb2 = qblk; asm volatile("" : "+s"(qb2));
    bf16* orow = QM + (size_t)(blocal * SEQ + qb2 * 256 + wid * 32 + r32) * 512 + hm * MHD;
#pragma unroll
    for (int db = 0; db < 4; ++db)
#pragma unroll
        for (int g = 0; g < 4; ++g) { const unsigned lo = pk2(o[db][4 * g] * rl, o[db][4 * g + 1] * rl), hi2 = pk2(o[db][4 * g + 2] * rl, o[db][4 * g + 3] * rl);
            *(unsigned long long*)(orow + 32 * db + 8 * g + 4 * hi) = (unsigned long long)lo | ((unsigned long long)hi2 << 32); }
    __syncthreads();
}
}

#define XB ((bf16*)(ws + WS_XB))
#define Qb ((bf16*)(ws + WS_Q))
#define Kb ((bf16*)(ws + WS_K))
#define Vb ((bf16*)(ws + WS_V))
#define CBb ((bf16*)(ws + WS_CB))
#define Zb ((bf16*)(ws + WS_Z))
#define QMb ((bf16*)(ws + WS_QM))
#define Gb ((bf16*)(ws + WS_G))
#define O1b ((bf16*)(ws + WS_O1))
#define O2b ((bf16*)(ws + WS_O2))
#define YATT ((bf16*)(ws + WS_YATT))
#define MERGED ((bf16*)(ws + WS_MERGED))
#define MIX ((bf16*)(ws + WS_MIX))
#define XG ((bf16*)(ws + WS_XG))
#define Hb ((bf16*)(ws + WS_H))
#define YC ((bf16*)(ws + WS_YC))
#define TOKPOS ((unsigned*)(ws + WS_TOKPOS))
#define TOKW ((float*)(ws + WS_TOKW))
#define ROWINFO ((int*)(ws + WS_ROWINFO))
#define ROWW ((float*)(ws + WS_ROWW))
#define MEMKV ((const bf16*)(ws + WS_MEMKV))
__global__ void __launch_bounds__(NWAVES * 64, 2) mega_fwd(Args A) {
    extern __shared__ __attribute__((aligned(16))) unsigned char lds[];
    Frame F;
    F.lds = (LAS unsigned char*)lds;
    F.wave = __builtin_amdgcn_readfirstlane((int)threadIdx.x >> 6);
    { const int bx = blockIdx.x; F.vcu = (bx % 8) * (GRID / 8) + bx / 8; }
    F.ws = A.ws;
    if (gridDim.x != GRID) return;
    for (int u = threadIdx.x; u < (LDS_BYTES - LDSCTL_OFF) / 4; u += NWAVES * 64) ((LAS unsigned*)(F.lds + LDSCTL_OFF))[u] = 0u;
    __syncthreads();
    const int lo = A.ph_lo, hi = A.ph_hi;
    const bool single = (hi - lo) > 1;
    XcdBarrier bar; bar.wave = F.wave; bar.bar = (unsigned*)(F_CTL + CW_BAR); bar.x = 0; bar.st = nullptr;
    if (single) { bar = xcd_barrier_post((unsigned*)(F_CTL + CW_BAR), F_MISC + 8); bar.wave = F.wave; }
    int ph = 0;
#ifdef MK_TIME_SITE
#define PH_T0 const unsigned long long tph0 = __builtin_amdgcn_s_memrealtime(); (void)tph0;
    unsigned long long tsum = 0;
#else
#define PH_T0
#endif
#ifndef MK_DOUBLE
#define MK_DOUBLE (-99)
#endif
#define NREP(site) (((site) == (MK_DOUBLE)) ? 2 : 1)
#define PH_BEGIN(site) if (ph >= lo && ph < hi) { for (int rep_ = 0; rep_ < NREP(site); ++rep_) { asm volatile("" : "+s"(F.wave), "+s"(F.vcu), "+s"(F.lds)); unsigned char* const ws = lws(F.ws); float* const OUT = (float*)lptr(A.out); const int gw = F.vcu * NWAVES + F.wave, NGW = F_G * NWAVES; (void)ws; (void)OUT; (void)gw; (void)NGW; PH_T0
#ifdef MK_TIME_SITE
#define PH_END(site)   if (rep_ + 1 < NREP(site) || ph + 1 < hi) xcd_barrier(bar); if ((site) == (MK_TIME_SITE) || (MK_TIME_SITE) < 0) tsum += __builtin_amdgcn_s_memrealtime() - tph0; } } ++ph;
#else
#define PH_END(site)   if (rep_ + 1 < NREP(site) || ph + 1 < hi) xcd_barrier(bar); } } ++ph;
#endif

    PH_BEGIN(0) p0_prologue(F, A); PH_END(0)

    for (int lc = 0; lc < DEPTH * NCHUNK; ++lc) {
        const int l = lc >> 1, c = lc & 1;
        const size_t tok0 = (size_t)c * TC;
        const float lam_init = (l == 0) ? 0.2f : 0.35550906758f;

        PH_BEGIN(1)
            {
                pg8::Gemm g{XB + tok0 * D, (const bf16*)(ws + WS_WIN), TC, 5120, D}; pg8::StaticOrder S; S.init(TC, 5120, F_G, F_BX);
                pg8::EpiP1 E{ws, (int)tok0};
                pg8::gemm_phase<pg8::EpiP1, pg8::StaticOrder, true, true>(F.lds + RING_OFF, g, S, E, F.wave);
            }
            __syncthreads();
            {
                pg8::GateOrder S; S.so.init(TC, 3072, F_G, F_BX); S.X8 = (const char*)(ws + WS_XBIN8) + tok0 * D; S.W8 = (const char*)(ws + WS_WING8);
                pg8::EpiGates8 E{(unsigned char*)Gb};
                pg8::gemm_phase2<pg8::EpiGates8, pg8::GateOrder, true>(F.lds + RING_OFF, S, E, F.wave);
            }
            if (lc == 0) {
                __syncthreads();
                pg8::Gemm g{(const bf16*)(ws + WS_MEMB), (const bf16*)(ws + WS_WKV), NB * MEML, 2048, D}; pg8::StaticOrder S; S.init(NB * MEML, 2048, F_G, F_BX);
                pg8::EpiBf16<0> E{(bf16*)(ws + WS_MEMKV), 2048, nullptr, 0, 0, 1.f};
                pg8::gemm_phase<pg8::EpiBf16<0>, pg8::StaticOrder, true, true>(F.lds + RING_OFF, g, S, E, F.wave);
            }
        PH_END(1)

        PH_BEGIN(2)
            {
                const float a1 = wave_sum(INF(4)[l * 64 + F_LANE] * INF(5)[l * 64 + F_LANE]), a2 = wave_sum(INF(6)[l * 64 + F_LANE] * INF(7)[l * 64 + F_LANE]);
                const float lam = expf(a1) - expf(a2) + lam_init;
                const dattn::DiffTensors AT{(const dattn::bf16*)Qb, (const dattn::bf16*)Kb, (const dattn::bf16*)Vb, (dattn::bf16*)O1b, (dattn::bf16*)O2b, (dattn::bf16*)YATT, INF(8) + l * 128, lam, 1.0f - lam_init};
#if MK_FUSEC
                dattn::diff_attn_phase<8>((char*)lds + RING_OFF, AT, F.vcu, F.wave);
#else
                dattn::diff_attn_phase_sep<8>((char*)lds + RING_OFF, AT, F.vcu, F.wave);
#endif
            }
            __syncthreads();
            if (rep_ == 0) { const int v = F.vcu; memattn::unit(c * BPC + (v >> 7), v >> 7, (v >> 5) & 3, v & 31, QMb, MEMKV + l * 1024, 2048, F.lds + RING_OFF, F.wave); }
            if (rep_ == 0) {
                const int L = F_LANE;
                float cw0[8], cw1[8], cw2[8];
#pragma unroll
                for (int j = 0; j < 8; ++j) { cw0[j] = INF(9)[(l * 3 + 0) * 512 + 8 * L + j]; cw1[j] = INF(9)[(l * 3 + 1) * 512 + 8 * L + j]; cw2[j] = INF(9)[(l * 3 + 2) * 512 + 8 * L + j]; }
                v4u z0[8], z1[8], z2[8], cbv[8];
#pragma unroll
                for (int i = 0; i < 8; ++i) { const int r = gw * 8 + i, s = r & (SEQ - 1);
                    z0[i] = *(const v4u*)(Zb + (size_t)r * 512 + 8 * L); z1[i] = (v4u){0u, 0u, 0u, 0u}; z2[i] = (v4u){0u, 0u, 0u, 0u};
                    if (s >= 1) z1[i] = *(const v4u*)(Zb + (size_t)(r - 1) * 512 + 8 * L);
                    if (s >= 2) z2[i] = *(const v4u*)(Zb + (size_t)(r - 2) * 512 + 8 * L);
                    cbv[i] = *(const v4u*)(CBb + (size_t)r * 512 + 8 * L); }
#pragma unroll
                for (int i = 0; i < 8; ++i) { const int r = gw * 8 + i;
                    const unsigned z0w[4] = {z0[i].x, z0[i].y, z0[i].z, z0[i].w}, z1w[4] = {z1[i].x, z1[i].y, z1[i].z, z1[i].w}, z2w[4] = {z2[i].x, z2[i].y, z2[i].z, z2[i].w}, cbw[4] = {cbv[i].x, cbv[i].y, cbv[i].z, cbv[i].w};
                    unsigned ow[4];
#pragma unroll
                    for (int j = 0; j < 4; ++j) {
                        const float ylo = bfl(cbw[j]) * (cw0[2 * j] * bfl(z2w[j]) + cw1[2 * j] * bfl(z1w[j]) + cw2[2 * j] * bfl(z0w[j]));
                        const float yhi = bfh(cbw[j]) * (cw0[2 * j + 1] * bfh(z2w[j]) + cw1[2 * j + 1] * bfh(z1w[j]) + cw2[2 * j + 1] * bfh(z0w[j]));
                        ow[j] = pk2(ylo, yhi); }
                    *(v4u*)(CBb + (size_t)r * 512 + 8 * L) = (v4u){ow[0], ow[1], ow[2], ow[3]}; }
                if (c == 0) { const int gt = F.vcu * (NWAVES * 64) + F_TID; for (int i = gt; i < NE * CAP; i += F_G * NWAVES * 64) ROWINFO[i] = -1; }
            }
        PH_END(2)

#if !MK_FUSEC
        PH_BEGIN(3)
            {
                const float a1 = wave_sum(INF(4)[l * 64 + F_LANE] * INF(5)[l * 64 + F_LANE]), a2 = wave_sum(INF(6)[l * 64 + F_LANE] * INF(7)[l * 64 + F_LANE]);
                const float lam = expf(a1) - expf(a2) + lam_init, osc = 1.0f - lam_init;
                const int L = F_LANE;
                float gs[16];
#pragma unroll
                for (int j = 0; j < 16; ++j) gs[j] = INF(8)[l * 128 + ((16 * L + j) & 127)] * osc;
                for (int r0 = gw; r0 < TC; r0 += 8 * NGW) {
                    v4u a0[8], a1v[8], b0[8], b1v[8];
#pragma unroll
                    for (int q = 0; q < 8; ++q) { const size_t r = (size_t)r0 + (size_t)q * NGW;
                        a0[q] = *(const v4u*)(O1b + r * 1024 + 16 * L); a1v[q] = *(const v4u*)(O1b + r * 1024 + 16 * L + 8); b0[q] = *(const v4u*)(O2b + r * 1024 + 16 * L); b1v[q] = *(const v4u*)(O2b + r * 1024 + 16 * L + 8); }
#pragma unroll
                    for (int q = 0; q < 8; ++q) { const size_t r = (size_t)r0 + (size_t)q * NGW;
                        const unsigned aw[8] = {a0[q].x, a0[q].y, a0[q].z, a0[q].w, a1v[q].x, a1v[q].y, a1v[q].z, a1v[q].w}, bw[8] = {b0[q].x, b0[q].y, b0[q].z, b0[q].w, b1v[q].x, b1v[q].y, b1v[q].z, b1v[q].w};
                        float o[16]; float ss = 0.f;
#pragma unroll
                        for (int j = 0; j < 8; ++j) { o[2 * j] = bfl(aw[j]) - lam * bfl(bw[j]); o[2 * j + 1] = bfh(aw[j]) - lam * bfh(bw[j]); ss += o[2 * j] * o[2 * j] + o[2 * j + 1] * o[2 * j + 1]; }
                        ss += pg8::shx<1>(ss); ss += pg8::shx<2>(ss); ss += pg8::shx<4>(ss);
                        const float rs = 1.0f / sqrtf(ss * (1.0f / 128.0f) + RMS_EPS);
                        v4u w0, w1;
                        w0.x = pk2(o[0] * rs * gs[0], o[1] * rs * gs[1]); w0.y = pk2(o[2] * rs * gs[2], o[3] * rs * gs[3]); w0.z = pk2(o[4] * rs * gs[4], o[5] * rs * gs[5]); w0.w = pk2(o[6] * rs * gs[6], o[7] * rs * gs[7]);
                        w1.x = pk2(o[8] * rs * gs[8], o[9] * rs * gs[9]); w1.y = pk2(o[10] * rs * gs[10], o[11] * rs * gs[11]); w1.z = pk2(o[12] * rs * gs[12], o[13] * rs * gs[13]); w1.w = pk2(o[14] * rs * gs[14], o[15] * rs * gs[15]);
                        *(v4u*)(YATT + r * 1024 + 16 * L) = w0; *(v4u*)(YATT + r * 1024 + 16 * L + 8) = w1; }
                }
            }
        PH_END(3)
#endif

        PH_BEGIN(4)
            {
                pg8::BranchOrder S; S.so.init(TC, D, F_G, F_BX); S.ws = (const char*)ws;
                pg8::EpiGate3 E{c == 0 ? (bf16*)(ws + WS_MERGED0) : MERGED, (const unsigned char*)Gb};
                pg8::gemm_phase2<pg8::EpiGate3, pg8::BranchOrder>(F.lds + RING_OFF, S, E, F.wave);
            }
        PH_END(4)


        if (c == NCHUNK - 1) {
            PH_BEGIN(5)
            {
                pg8::OutOrder S; S.so.init(T, D, F_G, F_BX); S.ws = (const char*)ws;
                pg8::EpiMixAll E{(bf16*)(ws + WS_MIXALL)};
                pg8::gemm_phase2<pg8::EpiMixAll, pg8::OutOrder>(F.lds + RING_OFF, S, E, F.wave);
            }
            PH_END(5)

            PH_BEGIN(6)
            {
                LAS unsigned* lcnt = (LAS unsigned*)(F.lds + RING_OFF);
                LAS unsigned* rec = (LAS unsigned*)(F.lds + RING_OFF + 256);
                if (F_TID < 32) lcnt[F_TID] = 0u;
                __syncthreads();
                const float* xin = INF(0);
                const float* g1 = INF(15) + l * D; const float* b1 = INF(16) + l * D;
                const int rbase = gw * 16;
                const bf16* mixb = (const bf16*)(ws + WS_MIXALL) + (size_t)rbase * D;
                f32x4 gg4[4], bb4[4];
#pragma unroll
                for (int j = 0; j < 4; ++j) { gg4[j] = *((const GAS f32x4*)g1 + F_LANE + 64 * j); bb4[j] = *((const GAS f32x4*)b1 + F_LANE + 64 * j); }
                f32x4 xvA[2][4], xvB[2][4]; unsigned long long mwA[2][4], mwB[2][4];
#define F_LD(X_, M_, k_) do { _Pragma("unroll") for (int q = 0; q < 2; ++q) { const size_t t = (size_t)rbase + (k_) + q; \
                        const GAS unsigned long long* mr = (const GAS unsigned long long*)(mixb + (size_t)((k_) + q) * D) + F_LANE; \
                        if (l == 0) { const GAS f32x4* xr = (const GAS f32x4*)(xin + t * D) + F_LANE; \
                            _Pragma("unroll") for (int j = 0; j < 4; ++j) X_[q][j] = xr[64 * j]; } \
                        else { const GAS unsigned long long* xr = (const GAS unsigned long long*)(XB + t * D) + F_LANE; \
                            _Pragma("unroll") for (int j = 0; j < 4; ++j) { const unsigned long long w = xr[64 * j]; const unsigned w0 = (unsigned)w, w1 = (unsigned)(w >> 32); X_[q][j] = (f32x4){bfl(w0), bfh(w0), bfl(w1), bfh(w1)}; } } \
                        _Pragma("unroll") for (int j = 0; j < 4; ++j) M_[q][j] = mr[64 * j]; } } while (0)
#define F_CS(X_, M_, k_) do { _Pragma("unroll") for (int q = 0; q < 2; ++q) { const size_t t = (size_t)rbase + (k_) + q; \
                        f32x4 v[4]; float sm = 0.f; \
                        _Pragma("unroll") for (int j = 0; j < 4; ++j) { const f32x4 x4 = X_[q][j]; const unsigned m0 = (unsigned)M_[q][j], m1 = (unsigned)(M_[q][j] >> 32); \
                            v[j] = (f32x4){ALPHA * x4.x + bfl(m0), ALPHA * x4.y + bfh(m0), ALPHA * x4.z + bfl(m1), ALPHA * x4.w + bfh(m1)}; sm += (v[j].x + v[j].y) + (v[j].z + v[j].w); } \
                        const float mean = wave_sum(sm) * (1.f / D); float s2 = 0.f; \
                        _Pragma("unroll") for (int j = 0; j < 4; ++j) { v[j] = v[j] - mean; s2 += (v[j].x * v[j].x + v[j].y * v[j].y) + (v[j].z * v[j].z + v[j].w * v[j].w); } \
                        const float rstd = 1.f / sqrtf(wave_sum(s2) * (1.f / D) + LN_EPS); \
                        GAS unsigned long long* o8 = (GAS unsigned long long*)(XB + t * D) + F_LANE; GAS unsigned* x8 = (GAS unsigned*)(ws + WS_XB8 + t * D) + F_LANE; \
                        _Pragma("unroll") for (int j = 0; j < 4; ++j) { const f32x4 y = v[j] * rstd * gg4[j] + bb4[j]; o8[64 * j] = (unsigned long long)pk2(y.x, y.y) | ((unsigned long long)pk2(y.z, y.w) << 32); x8[64 * j] = pg8::pk4_fp8(y.x, y.y, y.z, y.w); } } } while (0)
                F_LD(xvA, mwA, 0);
                for (int k = 0; k < 16; k += 4) {
                    F_LD(xvB, mwB, k + 2); F_CS(xvA, mwA, k);
                    if (k + 4 < 16) F_LD(xvA, mwA, k + 4);
                    F_CS(xvB, mwB, k + 2);
                }
#undef F_LD
#undef F_CS
                asm volatile("s_waitcnt vmcnt(0)" ::: "memory");
                {
                    const int tt = F_LANE & 15, kg = F_LANE >> 4; const size_t t = (size_t)rbase + tt;
                    const bf16* yrow = XB + t * D + 8 * kg; const bf16* WRH = (const bf16*)(ws + WS_WRH) + F_LANE * 8; const bf16* WRL = (const bf16*)(ws + WS_WRL) + F_LANE * 8;
                    f32x4 acc = (f32x4){0.f, 0.f, 0.f, 0.f};
#pragma unroll 8
                    for (int ks = 0; ks < 32; ++ks) {
                        const bf16x8 yb = __builtin_bit_cast(bf16x8, __builtin_nontemporal_load((const v4u*)(yrow + 32 * ks)));
                        const bf16x8 wh = *(const bf16x8*)(WRH + ks * 512), wl = *(const bf16x8*)(WRL + ks * 512);
                        acc = __builtin_amdgcn_mfma_f32_16x16x32_bf16(wh, yb, acc, 0, 0, 0);
                        acc = __builtin_amdgcn_mfma_f32_16x16x32_bf16(wl, yb, acc, 0, 0, 0);
                    }
                    float lg[4];
#pragma unroll
                    for (int j = 0; j < 4; ++j) lg[j] = acc[j] + INF(20)[4 * kg + j];
                    int a1i = 0; float l1 = lg[0];
#pragma unroll
                    for (int j = 1; j < 4; ++j) if (lg[j] > l1) { l1 = lg[j]; a1i = j; }
                    int a2i = -1; float l2 = -INFINITY;
#pragma unroll
                    for (int j = 0; j < 4; ++j) if (j != a1i && lg[j] > l2) { l2 = lg[j]; a2i = j; }
                    bool win = true;
#pragma unroll
                    for (int x = 1; x < 4; ++x) { const float om = (x == 1) ? pg8::shx<16>(l1) : (x == 2) ? pg8::shx<32>(l1) : pg8::shx<48>(l1); const int og = kg ^ x; if (om > l1 || (om == l1 && og < kg)) win = false; }
                    if (win) {
                        const int e1 = 4 * kg + a1i, e2 = 4 * kg + a2i; const float ex = expf(l2 - l1), w1 = 1.0f / (1.0f + ex), w2 = ex / (1.0f + ex);
                        const unsigned p1 = atomicAdd((unsigned*)&lcnt[e1], 1u), p2 = atomicAdd((unsigned*)&lcnt[e2], 1u);
                        LAS unsigned* rc = rec + (F.wave * 16 + tt) * 6; rc[0] = (unsigned)e1; rc[1] = p1; rc[2] = (unsigned)e2; rc[3] = p2; rc[4] = __float_as_uint(w1); rc[5] = __float_as_uint(w2);
                    }
                }
                __syncthreads();
                if (F_TID < 16) lcnt[16 + F_TID] = __hip_atomic_fetch_add(F_CTL + CW_CNT + (l * 16 + F_TID) * 64, lcnt[F_TID], __ATOMIC_RELAXED, __HIP_MEMORY_SCOPE_AGENT);
                __syncthreads();
                if (F_TID < 128) { const LAS unsigned* rc = rec + F_TID * 6; const size_t t = (size_t)(F.vcu * NWAVES + (F_TID >> 4)) * 16 + (F_TID & 15);
                    const unsigned r1 = rc[0] * (unsigned)CAP + lcnt[16 + rc[0]] + rc[1], r2 = rc[2] * (unsigned)CAP + lcnt[16 + rc[2]] + rc[3];
                    ROWINFO[r1] = (int)(2 * t); ROWW[r1] = __uint_as_float(rc[4]); ROWINFO[r2] = (int)(2 * t + 1); ROWW[r2] = __uint_as_float(rc[5]); }
                __syncthreads();
            }
            PH_END(6)


            PH_BEGIN(8)
                {
                    LAS int* tile_e = (LAS int*)(F.lds + TILEE_OFF); LAS int* tile_r = (LAS int*)(F.lds + TILER_OFF);
                    if (F_TID == 0) { unsigned a = 0;
#pragma unroll 1
                        for (int e_ = 0; e_ < NE; ++e_) { int e = e_; asm volatile("" : "+s"(e));
                            const unsigned n = __hip_atomic_load(F_CTL + CW_CNT + (l * 16 + e) * 64, __ATOMIC_RELAXED, __HIP_MEMORY_SCOPE_AGENT); const unsigned nt = (n + 255u) >> 8;
                            for (unsigned i = 0; i < nt; ++i) { tile_e[a + i] = e; tile_r[a + i] = e * CAP + (int)i * 256; } a += nt; } tile_e[MAXTILES] = (int)a; }
                    __syncthreads();
                    pg8::MoeGatherOrder S{tile_e[MAXTILES], F.vcu, F_G, tile_e, tile_r, ROWINFO, (const char*)(ws + WS_XB8), (const char*)(ws + WS_WGU)};
                    pg8::EpiSwiglu8 E{(unsigned char*)Hb};
                    pg8::gemm_phase2<pg8::EpiSwiglu8, pg8::MoeGatherOrder, true>(F.lds + RING_OFF, S, E, F.wave);
                }
            PH_END(8)

            PH_BEGIN(9)
                {
                    LAS int* tile_e = (LAS int*)(F.lds + TILEE_OFF); LAS int* tile_r = (LAS int*)(F.lds + TILER_OFF);
                    __syncthreads();
                    if (F_TID == 0) { unsigned a = 0;
#pragma unroll 1
                        for (int e_ = 0; e_ < NE; ++e_) { int e = e_; asm volatile("" : "+s"(e));
                            const unsigned n = __hip_atomic_load(F_CTL + CW_CNT + (l * 16 + e) * 64, __ATOMIC_RELAXED, __HIP_MEMORY_SCOPE_AGENT); const unsigned nt = (n + 255u) >> 8;
                            for (unsigned i = 0; i < nt; ++i) { tile_e[a + i] = e; tile_r[a + i] = e * CAP + (int)i * 256; } a += nt; } tile_e[MAXTILES] = (int)a; }
                    __syncthreads();
                    pg8::MoeDownOrder S{tile_e[MAXTILES], F.vcu, F_G, tile_e, (const char*)Hb, (const char*)(ws + WS_WD)};
                    pg8::EpiScatter8 E{YC, ROWINFO, ROWW, tile_r};
                    pg8::gemm_phase2<pg8::EpiScatter8, pg8::MoeDownOrder, true>(F.lds + RING_OFF, S, E, F.wave);
                }
            PH_END(9)

            PH_BEGIN(10)
                {
                    const float* g2 = INF(17) + l * D; const float* b2 = INF(18) + l * D;
                    f32x4 gg4[4], bb4[4];
#pragma unroll
                    for (int j = 0; j < 4; ++j) { gg4[j] = *((const GAS f32x4*)g2 + F_LANE + 64 * j); bb4[j] = *((const GAS f32x4*)b2 + F_LANE + 64 * j); }
                    unsigned long long xvA[2][4], yaA[2][4], ybA[2][4], xvB[2][4], yaB[2][4], ybB[2][4];
#define J_LD(X_, YA_, YB_, k_) do { _Pragma("unroll") for (int q = 0; q < 2; ++q) { const size_t t = (size_t)gw + (size_t)((k_) + q) * NGW; \
                            const GAS unsigned long long* xr = (const GAS unsigned long long*)(XB + t * D) + F_LANE; \
                            const GAS unsigned long long* y0 = (const GAS unsigned long long*)(YC + (2 * t) * D) + F_LANE; const GAS unsigned long long* y1 = (const GAS unsigned long long*)(YC + (2 * t + 1) * D) + F_LANE; \
                            _Pragma("unroll") for (int j = 0; j < 4; ++j) { X_[q][j] = xr[64 * j]; YA_[q][j] = y0[64 * j]; YB_[q][j] = y1[64 * j]; } } } while (0)
#define J_CS(X_, YA_, YB_, k_) do { _Pragma("unroll") for (int q = 0; q < 2; ++q) { const size_t t = (size_t)gw + (size_t)((k_) + q) * NGW; \
                            f32x4 v[4]; float sm = 0.f; \
                            _Pragma("unroll") for (int j = 0; j < 4; ++j) { const unsigned x0 = (unsigned)X_[q][j], x1 = (unsigned)(X_[q][j] >> 32); const f32x4 x4 = (f32x4){bfl(x0), bfh(x0), bfl(x1), bfh(x1)}; \
                                const unsigned a0 = (unsigned)YA_[q][j], a1 = (unsigned)(YA_[q][j] >> 32), b0 = (unsigned)YB_[q][j], b1 = (unsigned)(YB_[q][j] >> 32); \
                                v[j] = (f32x4){ALPHA * x4.x + (bfl(a0) + bfl(b0)), ALPHA * x4.y + (bfh(a0) + bfh(b0)), ALPHA * x4.z + (bfl(a1) + bfl(b1)), ALPHA * x4.w + (bfh(a1) + bfh(b1))}; sm += (v[j].x + v[j].y) + (v[j].z + v[j].w); } \
                            const float mean = wave_sum(sm) * (1.f / D); float s2 = 0.f; \
                            _Pragma("unroll") for (int j = 0; j < 4; ++j) { v[j] = v[j] - mean; s2 += (v[j].x * v[j].x + v[j].y * v[j].y) + (v[j].z * v[j].z + v[j].w * v[j].w); } \
                            const float rstd = 1.f / sqrtf(wave_sum(s2) * (1.f / D) + LN_EPS); \
                            GAS f32x4* xw = (GAS f32x4*)(OUT + t * D) + F_LANE; GAS unsigned long long* o8 = (GAS unsigned long long*)(XB + t * D) + F_LANE; \
                            _Pragma("unroll") for (int j = 0; j < 4; ++j) { const f32x4 y = v[j] * rstd * gg4[j] + bb4[j]; if (l + 1 < DEPTH) { o8[64 * j] = (unsigned long long)pk2(y.x, y.y) | ((unsigned long long)pk2(y.z, y.w) << 32); ((GAS unsigned*)(ws + WS_XBIN8 + t * D) + F_LANE)[64 * j] = pg8::pk4_fp8(y.x, y.y, y.z, y.w); } else xw[64 * j] = y; } } } while (0)
                    static_assert(T == 16 * GRID * NWAVES, "16 rows per wave");
                    J_LD(xvA, yaA, ybA, 0);
                    for (int k = 0; k < 16; k += 4) {
                        J_LD(xvB, yaB, ybB, k + 2); J_CS(xvA, yaA, ybA, k);
                        if (k + 4 < 16) J_LD(xvA, yaA, ybA, k + 4);
                        J_CS(xvB, yaB, ybB, k + 2);
                    }
#undef J_LD
#undef J_CS
                    if (l + 1 < DEPTH) convert_layer_weights(F, A, l + 1);
                }
            PH_END(10)
        }
    }
#undef PH_BEGIN
#undef PH_END
#ifdef MK_TIME_SITE
    {
#ifdef MK_GPROBE
        tsum += *(LAS unsigned*)(F.lds + LDSCTL_OFF + 3584);
#endif
        if (blockIdx.x == 0) { const unsigned long long t_end = __builtin_amdgcn_s_memrealtime() + tsum * (unsigned long long)(MK_TIME_MULT);
            while (__builtin_amdgcn_s_memrealtime() < t_end) __builtin_amdgcn_s_sleep(20); }
    }
#endif
}

__global__ void dump_bf16_kernel(const unsigned char* ws, size_t off, float* out) {
    const bf16* src = (const bf16*)(ws + off); const size_t n = (size_t)T * D;
#ifndef MK_DUMP_N
#define MK_DUMP_N n
#endif
    for (size_t i = (size_t)blockIdx.x * blockDim.x + threadIdx.x; i < n; i += (size_t)gridDim.x * blockDim.x) out[i] = i < (size_t)(MK_DUMP_N) ? __uint_as_float((unsigned)src[i] << 16) : 0.f;
}
constexpr int N_PHASES = 1 + DEPTH * (NCHUNK * (MK_FUSEC ? 3 : 4) + 5);
#ifndef MK_PER_PHASE
#define MK_PER_PHASE 0
#endif
extern "C" void kernel_launch(void* const* d_in, const int* in_sizes, int n_in, void* d_out, int out_size, void* d_ws, size_t ws_size, hipStream_t stream) {
    static int grid = 0;
    if (grid == 0) {
        if (n_in != 24 || in_sizes[0] != T * D || out_size != T * D || ws_size < WS_END) { fprintf(stderr, "kernel_launch: unexpected shapes / workspace (n_in %d, in0 %d, out %d, ws %zu); nothing launched\n", n_in, n_in > 0 ? in_sizes[0] : -1, out_size, ws_size); grid = -1; return; }
        int dev = 0, cus = 0, per_cu = 0;
        if (hipGetDevice(&dev) != hipSuccess || hipDeviceGetAttribute(&cus, hipDeviceAttributeMultiprocessorCount, dev) != hipSuccess) { grid = -1; return; }
        if (hipFuncSetAttribute((const void*)mega_fwd, hipFuncAttributeMaxDynamicSharedMemorySize, LDS_BYTES) != hipSuccess) { fprintf(stderr, "kernel_launch: hipFuncSetAttribute failed\n"); grid = -1; return; }
        if (hipOccupancyMaxActiveBlocksPerMultiprocessor(&per_cu, (const void*)mega_fwd, NWAVES * 64, LDS_BYTES) != hipSuccess || per_cu < 1) { fprintf(stderr, "kernel_launch: occupancy query says %d blocks per CU\n", per_cu); }
        (void)hipGetLastError();
        if (cus != GRID) { fprintf(stderr, "kernel_launch: built for %d CUs, device has %d; nothing launched\n", GRID, cus); grid = -1; return; }
        grid = cus;
    }
    if (grid < 0) return;
    if (hipMemsetAsync((char*)d_ws + WS_CTL, 0, CTL_ZERO_BYTES, stream) != hipSuccess) return;
    Args a{};
    for (int i = 0; i < 24; ++i) a.in[i] = d_in[i];
    a.out = (float*)d_out; a.ws = (unsigned char*)d_ws;
#ifndef MK_STOP
#define MK_STOP N_PHASES
#endif
#if MK_PER_PHASE
    for (int p = 0; p < MK_STOP; ++p) { a.ph_lo = p; a.ph_hi = p + 1; hipLaunchKernelGGL(mega_fwd, dim3(grid), dim3(NWAVES * 64), LDS_BYTES, stream, a); }
#ifdef MK_DUMP_OFF
    hipLaunchKernelGGL(dump_bf16_kernel, dim3(2048), dim3(256), 0, stream, (const unsigned char*)d_ws, (size_t)(MK_DUMP_OFF), (float*)d_out);
#endif
#else
    a.ph_lo = 0; a.ph_hi = N_PHASES;
    hipLaunchKernelGGL(mega_fwd, dim3(grid), dim3(NWAVES * 64), LDS_BYTES, stream, a);
#endif
}
```

```cpp
#define MK_YROT 2
#include <hip/hip_runtime.h>
#include <cstdio>
#include <cstdint>
#ifndef MK_FUSEC
#define MK_FUSEC 1
#endif
namespace pg8 {
#define PG8_LAS __attribute__((address_space(3)))
typedef unsigned short bf16_t;
typedef short bf16x8 __attribute__((ext_vector_type(8)));
typedef float f32x4 __attribute__((ext_vector_type(4)));
typedef unsigned u32x4 __attribute__((ext_vector_type(4)));
__device__ __forceinline__ int lane_id_v() { int l; asm volatile("v_mbcnt_lo_u32_b32 %0, -1, 0\n\tv_mbcnt_hi_u32_b32 %0, -1, %0" : "=v"(l)); return l; }
template <int M> __device__ __forceinline__ float shx(float v) {
    static_assert(M >= 1 && M < 64, "xor mask");
    if constexpr (M < 32) return __builtin_bit_cast(float, __builtin_amdgcn_ds_swizzle(__builtin_bit_cast(int, v), (M << 10) | 0x1f));
    else if constexpr (M == 32) { const unsigned u = __builtin_bit_cast(unsigned, v); auto rr = __builtin_amdgcn_permlane32_swap(u, u, false, false);
        return __builtin_bit_cast(float, rr[0] == u ? rr[1] : rr[0]); }
    else return shx<32>(shx<M - 32>(v));
}
constexpr int BM = 256, BK = 64, HALF = 128, HTB = HALF * BK * 2  , STAGE_BYTES = 8 * HTB, NXCD = 8, WGM = 8;

__host__ __device__ __forceinline__ int lds_byte(int r, int c) { const int st = (r >> 4) * 2 + (c >> 5), rr = r & 15, cc = c & 31, ob = rr * 64 + cc * 2; return st * 1024 + (ob ^ (((ob >> 9) & 1) << 5)); }
__host__ __device__ __forceinline__ void stage_rc(int b, int& R, int& C) { const int st = b / 1024, sb = b % 1024, swz = sb ^ (((sb >> 9) & 1) << 5); R = (st >> 1) * 16 + swz / 64; C = (st & 1) * 32 + (swz % 64) / 2; }
__host__ __device__ __forceinline__ int perm32(int rho) { const int n = rho >> 4, i = rho & 15; return 8 * (i >> 2) + 4 * n + (i & 3); }

struct Unit { int pm, pn; };
struct Gemm { const bf16_t* A; const bf16_t* Bt; int M, N, K; };

struct StaticOrder {
    int nM, nN, nwg, G, c;
    __host__ __device__ void init(int M, int N, int G_, int c_) { nM = M / BM; nN = N / BM; nwg = nM * nN; G = G_; c = c_; }
    __host__ __device__ bool next(int i, Unit& u) const {
        const long L = (long)i * G + c; if (L >= nwg) return false;
        int wgid = (int)L; { const int q = nwg / NXCD, r = nwg % NXCD, xcd = wgid % NXCD, off = wgid / NXCD; wgid = (xcd < r ? xcd * (q + 1) : r * (q + 1) + (xcd - r) * q) + off; }
        const int nig = WGM * nN, gid = wgid / nig, fm = gid * WGM, gsz = (nM - fm) < WGM ? (nM - fm) : WGM;
        u.pm = fm + ((wgid % nig) % gsz); u.pn = (wgid % nig) / gsz; return true;
    }
    __device__ __forceinline__ void a_ready(const Unit&) const {}
    __device__ __forceinline__ void done(const Unit&) const {}
};

typedef float f32x2c_t __attribute__((ext_vector_type(2))); typedef __bf16 bf16x2c_t __attribute__((ext_vector_type(2)));
__device__ __forceinline__ unsigned cvt_pk_bf16(float lo, float hi) { f32x2c_t v = {lo, hi}; bf16x2c_t b = __builtin_convertvector(v, bf16x2c_t); return __builtin_bit_cast(unsigned, b); }
typedef float f32x2 __attribute__((ext_vector_type(2)));
__device__ __forceinline__ f32x2 gelu_pk(f32x2 v) {
    const f32x2 av = __builtin_elementwise_abs(v), d = av * 0.2316418882f + 1.0f;
    f32x2 t; t.x = __builtin_amdgcn_rcpf(d.x); t.y = __builtin_amdgcn_rcpf(d.y);
    f32x2 q = t * 0.5307027145f + (-0.7265760135f); q = q * t + 0.7107068705f; q = q * t + (-0.142248368f); q = q * t + 0.127414796f; q = q * t;
    const f32x2 s = (v * v) * (-0.72134752044f);
    f32x2 e; e.x = __builtin_amdgcn_exp2f(s.x); e.y = __builtin_amdgcn_exp2f(s.y);
    const f32x2 m = v * (q * e), r = v - m;
    f32x2 o; o.x = v.x < 0.f ? m.x : r.x; o.y = v.y < 0.f ? m.y : r.y; return o;
}

template <int ACT  > struct EpiBf16 {
    static constexpr bool PERM = true, AFTER_DRAIN = false; static_assert(ACT == 0 || ACT == 1, "EpiBf16: ACT is 0 (none) or 1 (gelu_pk)");
    bf16_t* O; int ldc; const float* bias; int split_cols; size_t split_stride; float scale0;
    __device__ __forceinline__ void operator()(const f32x4 (&acc)[2][2][4][2], const Unit& u, int wr, int wc, int fr, int fq) const {
        const int row0 = u.pm * BM + wr * 64 + fr; int colt = u.pn * BM; bf16_t* base = O;
        float sc = 1.f; if (split_cols) { const int t = colt / split_cols; base += (size_t)t * split_stride; colt -= t * split_cols; if (t == 0) sc = scale0; }
        const int col0 = colt + wc * 32 + 8 * fq, bcol0 = u.pn * BM + wc * 32 + 8 * fq;
        f32x4 bv[2][2];
#pragma unroll
        for (int bj = 0; bj < 2; ++bj)
#pragma unroll
            for (int n = 0; n < 2; ++n) bv[bj][n] = bias ? *(const f32x4*)(bias + bcol0 + bj * HALF + 4 * n) : (f32x4){0.f, 0.f, 0.f, 0.f};
#pragma unroll
        for (int ai = 0; ai < 2; ++ai)
#pragma unroll
            for (int m = 0; m < 4; ++m) { bf16_t* rowp = base + (size_t)(row0 + ai * HALF + m * 16) * ldc + col0;
#pragma unroll
                for (int bj = 0; bj < 2; ++bj) { f32x4 v0 = acc[ai][bj][m][0] + bv[bj][0], v1 = acc[ai][bj][m][1] + bv[bj][1];
                    if (ACT == 1) { f32x2 a = gelu_pk((f32x2){v0[0], v0[1]}), b = gelu_pk((f32x2){v0[2], v0[3]}), c = gelu_pk((f32x2){v1[0], v1[1]}), d = gelu_pk((f32x2){v1[2], v1[3]});
                        v0 = (f32x4){a.x, a.y, b.x, b.y}; v1 = (f32x4){c.x, c.y, d.x, d.y}; }
                    v0 = v0 * sc; v1 = v1 * sc; u32x4 w; w.x = cvt_pk_bf16(v0[0], v0[1]); w.y = cvt_pk_bf16(v0[2], v0[3]); w.z = cvt_pk_bf16(v1[0], v1[1]); w.w = cvt_pk_bf16(v1[2], v1[3]);
                    *(u32x4*)(rowp + bj * HALF) = w; } }
    }
};

struct PanelStats {
    unsigned* xbuf;
    unsigned* cnt;
    unsigned* tmo;
    int ntn; float eps;
    unsigned code;
    __device__ __forceinline__ bool run(const f32x4 (&v)[2][2][4][2], const Unit& u, int wr, int wc, int fr, int fq, PG8_LAS unsigned char* lds, int wid, int lane) const {
        typedef float f32x2v __attribute__((ext_vector_type(2)));
        PG8_LAS f32x2v* P = (PG8_LAS f32x2v*)lds;
        PG8_LAS f32x2v* S = (PG8_LAS f32x2v*)(lds + 8192);
        PG8_LAS unsigned* flag = (PG8_LAS unsigned*)(lds + 8192 + 2048);
#pragma unroll
        for (int ai = 0; ai < 2; ++ai)
#pragma unroll
            for (int m = 0; m < 4; ++m) {
                float s = 0.f;
#pragma unroll
                for (int bj = 0; bj < 2; ++bj)
#pragma unroll
                    for (int n = 0; n < 2; ++n) { const f32x4 x = v[ai][bj][m][n]; s += (x[0] + x[1]) + (x[2] + x[3]); }
                s += shx<16>(s); s += shx<32>(s);
                const float mw = s * (1.0f / 64.0f); float q = 0.f;
#pragma unroll
                for (int bj = 0; bj < 2; ++bj)
#pragma unroll
                    for (int n = 0; n < 2; ++n) { const f32x4 d = v[ai][bj][m][n] - mw; q += (d[0] * d[0] + d[1] * d[1]) + (d[2] * d[2] + d[3] * d[3]); }
                q += shx<16>(q); q += shx<32>(q);
                if (fq == 0) P[(ai * HALF + wr * 64 + m * 16 + fr) * 4 + wc] = (f32x2v){mw, q};
            }
        asm volatile("s_waitcnt lgkmcnt(0)" ::: "memory"); __builtin_amdgcn_s_barrier(); asm volatile("" ::: "memory");
#if defined(BROKEN_EXCHANGE_NO_WAIT)
#warning BROKEN CONTROL BUILD: the row-statistics exchange does not wait; results are wrong by design
        if (blockIdx.x >= 64) { const long long t0_ = clock64(); while (clock64() - t0_ < 60000) __builtin_amdgcn_s_sleep(8); }
#endif
        const int row = wid * 32 + (lane & 31);
        if (lane < 32) {
            const f32x2v a = P[row * 4 + 0], b = P[row * 4 + 1], c = P[row * 4 + 2], d = P[row * 4 + 3];
            const float mt = (a.x + b.x + c.x + d.x) * 0.25f;
            const float da = a.x - mt, db = b.x - mt, dc = c.x - mt, dd = d.x - mt;
            const float m2 = (a.y + b.y) + (c.y + d.y) + 64.0f * ((da * da + db * db) + (dc * dc + dd * dd));
            unsigned long long* slot = (unsigned long long*)xbuf + ((size_t)(u.pm * BM + row) * 4 + u.pn);
            __hip_atomic_store(slot, ((unsigned long long)__float_as_uint(m2) << 32) | __float_as_uint(mt), __ATOMIC_RELAXED, __HIP_MEMORY_SCOPE_AGENT);
        }
        asm volatile("s_waitcnt vmcnt(0)" ::: "memory");
        if (lane == 0) __hip_atomic_fetch_add(cnt + 64 * u.pm, 1u, __ATOMIC_RELAXED, __HIP_MEMORY_SCOPE_AGENT);
        if (wid == 0) {
            bool dead = false; const unsigned long long t0 = __builtin_amdgcn_s_memrealtime(); const unsigned want = 8u * (unsigned)ntn;
            for (;;) {
#if defined(BROKEN_EXCHANGE_NO_WAIT)
                break;
#endif
                if ((unsigned)__builtin_amdgcn_readfirstlane(__hip_atomic_load(cnt + 64 * u.pm, __ATOMIC_RELAXED, __HIP_MEMORY_SCOPE_AGENT)) >= want) break;
                if (__builtin_amdgcn_s_memrealtime() - t0 > 2000000ull) {
                    if (lane == 0) { unsigned expect = 0u; __hip_atomic_compare_exchange_strong(tmo + 1, &expect, code | (unsigned)(u.pm & 0xff), __ATOMIC_RELAXED, __ATOMIC_RELAXED, __HIP_MEMORY_SCOPE_AGENT);
                                     __hip_atomic_store(tmo, 1u, __ATOMIC_RELAXED, __HIP_MEMORY_SCOPE_AGENT); }
                    dead = true; break; }
                __builtin_amdgcn_s_sleep(2);
            }
            __builtin_amdgcn_fence(__ATOMIC_ACQUIRE, "agent");
            if (lane == 0) flag[0] = dead ? 1u : 0u;
        }
        asm volatile("s_waitcnt vmcnt(0) lgkmcnt(0)" ::: "memory"); __builtin_amdgcn_s_barrier(); asm volatile("" ::: "memory");
        const bool bad = flag[0] != 0u;
        if (lane < 32) {
            const unsigned long long* slot = (const unsigned long long*)xbuf + (size_t)(u.pm * BM + row) * 4; float mt[4], m2[4]; float ms = 0.f;
#pragma unroll
            for (int t = 0; t < 4; ++t) { if (t < ntn) { const unsigned long long w = __hip_atomic_load(slot + t, __ATOMIC_RELAXED, __HIP_MEMORY_SCOPE_AGENT); mt[t] = __uint_as_float((unsigned)w); m2[t] = __uint_as_float((unsigned)(w >> 32)); } else { mt[t] = 0.f; m2[t] = 0.f; } ms += mt[t]; }
            const float mean = ms / (float)ntn; float q = 0.f;
#pragma unroll
            for (int t = 0; t < 4; ++t) if (t < ntn) { const float dm = mt[t] - mean; q += m2[t] + 256.0f * dm * dm; }
            S[row] = (f32x2v){mean, 1.0f / sqrtf(q / (256.0f * (float)ntn) + eps)};
        }
        asm volatile("s_waitcnt lgkmcnt(0)" ::: "memory"); __builtin_amdgcn_s_barrier(); asm volatile("" ::: "memory");
        return bad;
    }
};
struct EpiLnRes {
    static constexpr bool PERM = false, AFTER_DRAIN = true;
    const float* base; float* out; int ldc; const float* bias; PanelStats st; unsigned poison;
    __device__ __forceinline__ void fused(f32x4 (&acc)[2][2][4][2], const Unit& u, int wr, int wc, int fr, int fq, PG8_LAS unsigned char* lds, int wid, int lane) const {
        typedef float f32x2v __attribute__((ext_vector_type(2)));
        const PG8_LAS f32x2v* S = (const PG8_LAS f32x2v*)(lds + 8192);
        const int col0 = u.pn * BM + wc * 32 + 4 * fq;
#pragma unroll
        for (int bj = 0; bj < 2; ++bj)
#pragma unroll
            for (int n = 0; n < 2; ++n) { const f32x4 bv = bias ? *(const f32x4*)(bias + col0 + bj * HALF + n * 16) : (f32x4){0.f, 0.f, 0.f, 0.f};
#pragma unroll
                for (int ai = 0; ai < 2; ++ai)
#pragma unroll
                    for (int m = 0; m < 4; ++m) acc[ai][bj][m][n] += bv; }
        f32x4 pre[4][2][2];
#pragma unroll
        for (int m = 0; m < 4; ++m) { const size_t off = (size_t)(u.pm * BM + wr * 64 + m * 16 + fr) * ldc + col0;
#pragma unroll
            for (int bj = 0; bj < 2; ++bj)
#pragma unroll
                for (int n = 0; n < 2; ++n) pre[m][bj][n] = *(const f32x4*)(base + off + bj * HALF + n * 16); }
        const bool bad = st.run(acc, u, wr, wc, fr, fq, lds, wid, lane) || poison != 0u;
        const float qnan = __builtin_nanf("");
#pragma unroll
        for (int ai = 0; ai < 2; ++ai)
#pragma unroll
            for (int m = 0; m < 4; ++m) { const int r = ai * HALF + wr * 64 + m * 16 + fr; const f32x2v sr = S[r]; const size_t off = (size_t)(u.pm * BM + r) * ldc + col0;
#pragma unroll
                for (int bj = 0; bj < 2; ++bj)
#pragma unroll
                    for (int n = 0; n < 2; ++n) { const f32x4 bs = ai == 0 ? pre[m][bj][n] : *(const f32x4*)(base + off + bj * HALF + n * 16); f32x4 o = bs + (acc[ai][bj][m][n] - sr.x) * sr.y;
                        if (bad) o = (f32x4){qnan, qnan, qnan, qnan}; *(f32x4*)(out + off + bj * HALF + n * 16) = o; }
                if (m & 1) asm volatile("" ::: "memory"); }
    }
};
struct EpiLnResLn {
    static constexpr bool PERM = false, AFTER_DRAIN = true;
    const float* base; float* out; bf16_t* xn; int ldc; const float* bias; PanelStats st1, st2; unsigned poison;
    __device__ __forceinline__ void fused(f32x4 (&acc)[2][2][4][2], const Unit& u, int wr, int wc, int fr, int fq, PG8_LAS unsigned char* lds, int wid, int lane) const {
        typedef float f32x2v __attribute__((ext_vector_type(2))); typedef unsigned u32x2v __attribute__((ext_vector_type(2)));
        const PG8_LAS f32x2v* S = (const PG8_LAS f32x2v*)(lds + 8192);
        const int col0 = u.pn * BM + wc * 32 + 4 * fq;
#pragma unroll
        for (int bj = 0; bj < 2; ++bj)
#pragma unroll
            for (int n = 0; n < 2; ++n) { const f32x4 bv = bias ? *(const f32x4*)(bias + col0 + bj * HALF + n * 16) : (f32x4){0.f, 0.f, 0.f, 0.f};
#pragma unroll
                for (int ai = 0; ai < 2; ++ai)
#pragma unroll
                    for (int m = 0; m < 4; ++m) acc[ai][bj][m][n] += bv; }
        bool bad = st1.run(acc, u, wr, wc, fr, fq, lds, wid, lane) || poison != 0u;
        const float qnan = __builtin_nanf("");
#pragma unroll
        for (int ai = 0; ai < 2; ++ai)
#pragma unroll
            for (int m = 0; m < 4; ++m) { const int r = ai * HALF + wr * 64 + m * 16 + fr; const f32x2v sr = S[r]; const size_t off = (size_t)(u.pm * BM + r) * ldc + col0;
#pragma unroll
                for (int bj = 0; bj < 2; ++bj)
#pragma unroll
                    for (int n = 0; n < 2; ++n) { const f32x4 bs = *(const f32x4*)(base + off + bj * HALF + n * 16); acc[ai][bj][m][n] = bs + (acc[ai][bj][m][n] - sr.x) * sr.y; }
                asm volatile("" : "+v"(acc[ai][0][m][0]), "+v"(acc[ai][0][m][1]), "+v"(acc[ai][1][m][0]), "+v"(acc[ai][1][m][1]));
                if (m & 1) asm volatile("" ::: "memory"); }
        const bool bad1 = bad;
        bad = st2.run(acc, u, wr, wc, fr, fq, lds, wid, lane) || bad;
#pragma unroll
        for (int ai = 0; ai < 2; ++ai)
#pragma unroll
            for (int m = 0; m < 4; ++m) { const int r = ai * HALF + wr * 64 + m * 16 + fr; const f32x2v sr = S[r]; const size_t off = (size_t)(u.pm * BM + r) * ldc + col0;
#pragma unroll
                for (int bj = 0; bj < 2; ++bj)
#pragma unroll
                    for (int n = 0; n < 2; ++n) { const f32x4 x1 = acc[ai][bj][m][n]; *(f32x4*)(out + off + bj * HALF + n * 16) = bad1 ? (f32x4){qnan, qnan, qnan, qnan} : x1;
                        const f32x4 o = (x1 - sr.x) * sr.y; u32x2v w; w.x = cvt_pk_bf16(o[0], o[1]); w.y = cvt_pk_bf16(o[2], o[3]);
                        if (bad) { w.x = 0x7fc07fc0u; w.y = 0x7fc07fc0u; } *(u32x2v*)(xn + off + bj * HALF + n * 16) = w; }
                asm volatile("" ::: "memory"); }
    }
};

template <class Epi, class Sched, bool ALIGN_EPI = false, bool SP2 = false>
__device__ __forceinline__ void gemm_phase(PG8_LAS unsigned char* lds, const Gemm g, const Sched& S, const Epi& E, int wave_id) {
    int tid_ = wave_id * 64 + lane_id_v(); asm volatile("" : "+v"(tid_));
    const int tid = tid_, wid = __builtin_amdgcn_readfirstlane(tid >> 6), lane = tid & 63, wr = wid >> 2, wc = wid & 3, fr = lane & 15, fq = lane >> 4;
    const int K = g.K, nt = K / BK;
    unsigned voffA[2], voffB[2];
#pragma unroll
    for (int i = 0; i < 2; ++i) { int R, C; stage_rc(tid * 16 + i * 8192, R, C); const int Rb = Epi::PERM ? ((R & ~31) + perm32(R & 31)) : R;
        voffA[i] = (unsigned)(R * K + C) * 2u; voffB[i] = (unsigned)(Rb * K + C) * 2u; }
    const size_t kstep = (size_t)(BK * 2);
    const size_t hstep = (size_t)HALF * K * 2;
    const size_t tstep = 2 * hstep;
    const unsigned ldsw = (unsigned)wid * 1024u;
    const int aoff = lds_byte(wr * 64 + fr, fq * 8), boff = lds_byte(wc * 32 + fr, fq * 8);
#define PG8_SA(b, h) (((b) * 2 + (h)) * HTB)
#define PG8_SB(b, h) ((4 + (b) * 2 + (h)) * HTB)
#define PG8_STAGE(bufoff, gbase, voff) do { _Pragma("unroll") for (int _i = 0; _i < 2; ++_i) \
        __builtin_amdgcn_global_load_lds((const unsigned*)((const char*)(gbase) + (voff)[_i]), (PG8_LAS unsigned*)(lds + (bufoff) + ldsw + _i * 8192), 16, 0, 0); } while (0)
#define PG8_LDA(dst, b, h) do { _Pragma("unroll") for (int m = 0; m < 4; ++m) _Pragma("unroll") for (int k = 0; k < 2; ++k) dst[m][k] = *(const PG8_LAS bf16x8*)(lds + PG8_SA(b, h) + aoff + m * 2048 + k * 1024); } while (0)
#define PG8_LDB(dst, b, h) do { _Pragma("unroll") for (int n = 0; n < 2; ++n) _Pragma("unroll") for (int k = 0; k < 2; ++k) dst[n][k] = *(const PG8_LAS bf16x8*)(lds + PG8_SB(b, h) + boff + n * 2048 + k * 1024); } while (0)
#define PG8_MMA(ai, bj, At, Bt) do { __builtin_amdgcn_s_setprio(1); _Pragma("unroll") for (int m = 0; m < 4; ++m) _Pragma("unroll") for (int n = 0; n < 2; ++n) _Pragma("unroll") for (int k = 0; k < 2; ++k) \
        acc[ai][bj][m][n] = __builtin_amdgcn_mfma_f32_16x16x32_bf16(Bt[n][k], At[m][k], acc[ai][bj][m][n], 0, 0, 0); __builtin_amdgcn_s_setprio(0); } while (0)
#define PG8_WAIT_V(n) asm volatile("s_waitcnt vmcnt(" #n ")" ::: "memory")
#define PG8_WAIT_L(n) asm volatile("s_waitcnt lgkmcnt(" #n ")" ::: "memory")
#define PG8_BAR __builtin_amdgcn_s_barrier()
#define PG8_SCHED __builtin_amdgcn_sched_barrier(0)
    Unit cur, nxt; int ui = 0;
#if defined(MK_GPROBE) && MK_GPROBE == 2
    unsigned gp_last = 0;
#endif
    if (!S.next(0, cur)) return;
    f32x4 acc[2][2][4][2];
#pragma unroll
    for (int a = 0; a < 2; ++a)
#pragma unroll
        for (int b = 0; b < 2; ++b)
#pragma unroll
            for (int m = 0; m < 4; ++m)
#pragma unroll
                for (int n = 0; n < 2; ++n) acc[a][b][m][n] = (f32x4){0.f, 0.f, 0.f, 0.f};
    bf16x8 At[4][2], B0[2][2], B1[2][2];
    const char* cA = (const char*)g.A + (size_t)cur.pm * tstep; const char* cB = (const char*)g.Bt + (size_t)cur.pn * tstep;
    S.a_ready(cur);
    if constexpr (SP2) {
        PG8_STAGE(PG8_SB(0, 0), cB, voffB); PG8_STAGE(PG8_SB(0, 1), cB + hstep, voffB); PG8_STAGE(PG8_SA(0, 0), cA, voffA); PG8_STAGE(PG8_SA(0, 1), cA + hstep, voffA);
        if (wr == 1) PG8_BAR;
        PG8_WAIT_V(2); PG8_BAR;
        PG8_STAGE(PG8_SB(1, 0), cB + kstep, voffB); PG8_STAGE(PG8_SA(1, 0), cA + kstep, voffA); PG8_STAGE(PG8_SB(1, 1), cB + hstep + kstep, voffB);
        PG8_WAIT_V(6); PG8_BAR;
    } else {
        PG8_STAGE(PG8_SB(0, 0), cB, voffB); PG8_STAGE(PG8_SA(0, 0), cA, voffA); PG8_STAGE(PG8_SB(0, 1), cB + hstep, voffB); PG8_STAGE(PG8_SA(0, 1), cA + hstep, voffA);
        if (wr == 1) PG8_BAR;
        PG8_WAIT_V(4); PG8_BAR;
        PG8_STAGE(PG8_SB(1, 0), cB + kstep, voffB); PG8_STAGE(PG8_SA(1, 0), cA + kstep, voffA); PG8_STAGE(PG8_SB(1, 1), cB + hstep + kstep, voffB);
        PG8_WAIT_V(6); PG8_BAR;
    }
    for (;;) {
        const bool has_next = S.next(ui + 1, nxt);
        const char* nA = has_next ? (const char*)g.A + (size_t)nxt.pm * tstep : cA; const char* nB = has_next ? (const char*)g.Bt + (size_t)nxt.pn * tstep : cB;
#if defined(MK_GPROBE) && MK_GPROBE == 3
        unsigned gp_k0 = 0; if (wid == 0) gp_k0 = (unsigned)__builtin_amdgcn_s_memrealtime();
#endif
        for (int t = 0; t < nt; t += 2) {
            const bool last = (t == nt - 2);
            const char* a1 = cA + (size_t)(t + 1) * kstep;
            const char* a2 = last ? nA : cA + (size_t)(t + 2) * kstep; const char* b2 = last ? nB : cB + (size_t)(t + 2) * kstep;
            const char* a3 = a2 + kstep; const char* b3 = b2 + kstep;
            if (last && has_next) S.a_ready(nxt);
            if constexpr (SP2) {
            PG8_LDB(B0, 0, 0); PG8_LDB(B1, 0, 1); PG8_SCHED; PG8_LDA(At, 0, 0); PG8_STAGE(PG8_SA(1, 1), a1 + hstep, voffA);
            PG8_WAIT_V(8); PG8_WAIT_L(0); PG8_BAR;
#if defined(MK_GPROBE) && MK_GPROBE == 2
            if (wid == 0 && t == 2 && ui > 0) { const unsigned gp_t3 = (unsigned)__builtin_amdgcn_s_memrealtime(); if (lane == 0) ((PG8_LAS unsigned*)(lds + 143360 + 3584))[0] += gp_t3 - gp_last; }
#endif
            PG8_MMA(0, 0, At, B0); PG8_MMA(0, 1, At, B1); PG8_BAR; PG8_SCHED;
            PG8_LDA(At, 0, 1); PG8_STAGE(PG8_SB(0, 0), b2, voffB); PG8_STAGE(PG8_SB(0, 1), b2 + hstep, voffB); PG8_STAGE(PG8_SA(0, 0), a2, voffA);
            PG8_WAIT_V(8); PG8_WAIT_L(0); PG8_BAR; PG8_MMA(1, 0, At, B0); PG8_MMA(1, 1, At, B1); PG8_BAR; PG8_SCHED;
            PG8_LDB(B0, 1, 0); PG8_LDB(B1, 1, 1); PG8_SCHED; PG8_LDA(At, 1, 0); PG8_STAGE(PG8_SA(0, 1), a2 + hstep, voffA);
            PG8_WAIT_V(8); PG8_WAIT_L(0); PG8_BAR; PG8_MMA(0, 0, At, B0); PG8_MMA(0, 1, At, B1); PG8_BAR; PG8_SCHED;
            PG8_LDA(At, 1, 1); PG8_STAGE(PG8_SB(1, 0), b3, voffB); PG8_STAGE(PG8_SB(1, 1), b3 + hstep, voffB); PG8_STAGE(PG8_SA(1, 0), a3, voffA);
            PG8_WAIT_V(8); PG8_WAIT_L(0); PG8_BAR; PG8_MMA(1, 0, At, B0); PG8_MMA(1, 1, At, B1); PG8_BAR; PG8_SCHED;
            } else {
            PG8_LDB(B0, 0, 0); PG8_SCHED; PG8_LDA(At, 0, 0); PG8_STAGE(PG8_SA(1, 1), a1 + hstep, voffA);
            PG8_WAIT_L(8); PG8_BAR; PG8_WAIT_L(0); PG8_MMA(0, 0, At, B0); PG8_BAR; PG8_SCHED;
            PG8_LDB(B1, 0, 1); PG8_STAGE(PG8_SB(0, 0), b2, voffB);
            PG8_BAR; PG8_WAIT_L(0); PG8_MMA(0, 1, At, B1); PG8_BAR;
            PG8_LDA(At, 0, 1); PG8_STAGE(PG8_SA(0, 0), a2, voffA);
            PG8_BAR; PG8_WAIT_L(0); PG8_MMA(1, 0, At, B0); PG8_BAR; PG8_SCHED;
            PG8_STAGE(PG8_SB(0, 1), b2 + hstep, voffB);
            PG8_WAIT_V(6); PG8_BAR; PG8_MMA(1, 1, At, B1); PG8_BAR;
            PG8_LDB(B0, 1, 0); PG8_SCHED; PG8_LDA(At, 1, 0); PG8_STAGE(PG8_SA(0, 1), a2 + hstep, voffA);
            PG8_WAIT_L(8); PG8_BAR; PG8_WAIT_L(0); PG8_MMA(0, 0, At, B0); PG8_BAR; PG8_SCHED;
            PG8_LDB(B1, 1, 1); PG8_STAGE(PG8_SB(1, 0), b3, voffB);
            PG8_BAR; PG8_WAIT_L(0); PG8_MMA(0, 1, At, B1); PG8_BAR;
            PG8_LDA(At, 1, 1); PG8_STAGE(PG8_SA(1, 0), a3, voffA);
            PG8_BAR; PG8_WAIT_L(0); PG8_MMA(1, 0, At, B0); PG8_BAR; PG8_SCHED;
            PG8_STAGE(PG8_SB(1, 1), b3 + hstep, voffB);
            PG8_WAIT_V(6); PG8_BAR; PG8_MMA(1, 1, At, B1); PG8_BAR;
            }
        }
#if defined(MK_GPROBE) && MK_GPROBE == 1
        unsigned gp_t0 = 0; if (wid == 0) gp_t0 = (unsigned)__builtin_amdgcn_s_memrealtime();
#endif
#if defined(MK_GPROBE) && MK_GPROBE == 3
        if (wid == 0) { const unsigned gp_k1 = (unsigned)__builtin_amdgcn_s_memrealtime(); if (lane == 0) ((PG8_LAS unsigned*)(lds + 143360 + 3584))[0] += gp_k1 - gp_k0; }
#endif
        if constexpr (ALIGN_EPI) { if (wr == 0) PG8_BAR; }
        if constexpr (!Epi::AFTER_DRAIN) { E(acc, cur, wr, wc, fr, fq); S.done(cur); }
#if defined(MK_GPROBE) && MK_GPROBE == 1
        if (wid == 0) { const unsigned gp_t1 = (unsigned)__builtin_amdgcn_s_memrealtime(); if (lane == 0) ((PG8_LAS unsigned*)(lds + 143360 + 3584))[0] += gp_t1 - gp_t0; }
#endif
#if defined(MK_GPROBE) && MK_GPROBE == 2
        if (wid == 0) gp_last = (unsigned)__builtin_amdgcn_s_memrealtime();
#endif
        if (!has_next) break;
#pragma unroll
        for (int a = 0; a < 2; ++a)
#pragma unroll
            for (int b = 0; b < 2; ++b)
#pragma unroll
                for (int m = 0; m < 4; ++m)
#pragma unroll
                    for (int n = 0; n < 2; ++n) acc[a][b][m][n] = (f32x4){0.f, 0.f, 0.f, 0.f};
        cur = nxt; cA = nA; cB = nB; ++ui;
        if constexpr (ALIGN_EPI) { if (wr == 1) PG8_BAR; }
    }
    PG8_WAIT_V(0);
    if constexpr (!ALIGN_EPI) { if (wr == 0) PG8_BAR; }
    PG8_BAR;
    if constexpr (Epi::AFTER_DRAIN) { E.fused(acc, cur, wr, wc, fr, fq, lds, wid, lane); S.done(cur); }
#undef PG8_SA
#undef PG8_SB
#undef PG8_STAGE
#undef PG8_LDA
#undef PG8_LDB
#undef PG8_MMA
#undef PG8_WAIT_V
#undef PG8_WAIT_L
#undef PG8_BAR
#undef PG8_SCHED
}
}
namespace pg8 {
__device__ __forceinline__ u32x4 pack8(const f32x4& a, const f32x4& b) { u32x4 w; w.x = cvt_pk_bf16(a[0], a[1]); w.y = cvt_pk_bf16(a[2], a[3]); w.z = cvt_pk_bf16(b[0], b[1]); w.w = cvt_pk_bf16(b[2], b[3]); return w; }
__device__ __forceinline__ f32x4 bf_lo4(const u32x4& w) { return (f32x4){__uint_as_float(w.x << 16), __uint_as_float(w.x & 0xffff0000u), __uint_as_float(w.y << 16), __uint_as_float(w.y & 0xffff0000u)}; }
__device__ __forceinline__ f32x4 bf_hi4(const u32x4& w) { return (f32x4){__uint_as_float(w.z << 16), __uint_as_float(w.z & 0xffff0000u), __uint_as_float(w.w << 16), __uint_as_float(w.w & 0xffff0000u)}; }
__device__ __forceinline__ float sigmoid_f(float x) { return __builtin_amdgcn_rcpf(1.0f + __builtin_amdgcn_exp2f(-1.4426950408889634f * x)); }
__device__ __forceinline__ f32x4 sigmoid4(const f32x4& v) { return (f32x4){sigmoid_f(v[0]), sigmoid_f(v[1]), sigmoid_f(v[2]), sigmoid_f(v[3])}; }

constexpr float QSCALE = 0.125f * 1.4426950408889634f;
constexpr float QMSCALE = 0.08838834764831845f * 1.4426950408889634f;

constexpr size_t P1_MiB = 1u << 20;
constexpr size_t P1_COS = 12 * P1_MiB, P1_SIN = 16 * P1_MiB, P1_Q = 156 * P1_MiB, P1_K = P1_Q + 32 * P1_MiB, P1_V = P1_K + 32 * P1_MiB, P1_CB = P1_V + 32 * P1_MiB, P1_Z = P1_CB + 16 * P1_MiB, P1_QM = P1_Z + 16 * P1_MiB, P1_G = P1_QM + 16 * P1_MiB;
__device__ __forceinline__ unsigned pk4f8(const f32x4& v) { int w = 0; w = __builtin_amdgcn_cvt_pk_fp8_f32(v[0], v[1], w, false); w = __builtin_amdgcn_cvt_pk_fp8_f32(v[2], v[3], w, true); return (unsigned)w; }
struct EpiP1 {
    static constexpr bool PERM = true, AFTER_DRAIN = false;
    unsigned char* ws; int tok0;
    __device__ __forceinline__ void operator()(const f32x4 (&acc)[2][2][4][2], const Unit& u, int wr, int wc, int fr, int fq) const {
        const int pn = u.pn; const int row0 = u.pm * BM + wr * 64 + fr;
        bf16_t* const Q = (bf16_t*)(ws + P1_Q); bf16_t* const K = (bf16_t*)(ws + P1_K); bf16_t* const V = (bf16_t*)(ws + P1_V); bf16_t* const CB = (bf16_t*)(ws + P1_CB);
        bf16_t* const Z = (bf16_t*)(ws + P1_Z); bf16_t* const QM = (bf16_t*)(ws + P1_QM); bf16_t* const G = (bf16_t*)(ws + P1_G);
        const float* const cosT = (const float*)(ws + P1_COS) + (size_t)tok0 * 32; const float* const sinT = (const float*)(ws + P1_SIN) + (size_t)tok0 * 32;
        if (pn < 8) {
            unsigned char* base = (unsigned char*)(pn < 4 ? Q : K) + (pn & 3) * 256 + wc * 64 + 8 * fq; const float sc = pn < 4 ? QSCALE * 8.0f : 1.0f;
            f32x4 cs[3][4];
#define P1_LD(it) do { const int row_ = row0 + ((it) >> 2) * HALF + ((it) & 3) * 16; const float* cp_ = cosT + (size_t)row_ * 32 + 8 * fq; const float* sp_ = sinT + (size_t)row_ * 32 + 8 * fq; \
                cs[(it) % 3][0] = *(const f32x4*)cp_; cs[(it) % 3][1] = *(const f32x4*)(cp_ + 4); cs[(it) % 3][2] = *(const f32x4*)sp_; cs[(it) % 3][3] = *(const f32x4*)(sp_ + 4); } while (0)
            P1_LD(0); P1_LD(1); __builtin_amdgcn_sched_barrier(0);
#pragma unroll
            for (int it = 0; it < 8; ++it) { const int ai = it >> 2, m = it & 3; const int row = row0 + ai * HALF + m * 16;
                if (it + 2 < 8) P1_LD(it + 2);
                __builtin_amdgcn_sched_barrier(0);
                const f32x4 c0 = cs[it % 3][0], c1 = cs[it % 3][1], s0 = cs[it % 3][2], s1 = cs[it % 3][3];
                const f32x4 lo0 = acc[ai][0][m][0], lo1 = acc[ai][0][m][1], hi0 = acc[ai][1][m][0], hi1 = acc[ai][1][m][1];
                const f32x4 a0 = (lo0 * c0 - hi0 * s0) * sc, a1 = (lo1 * c1 - hi1 * s1) * sc, b0 = (hi0 * c0 + lo0 * s0) * sc, b1 = (hi1 * c1 + lo1 * s1) * sc;
                unsigned char* rp = base + (size_t)row * 1024; typedef unsigned u32x2q __attribute__((ext_vector_type(2)));
                *(u32x2q*)rp = (u32x2q){pk4f8(a0), pk4f8(a1)}; *(u32x2q*)(rp + 32) = (u32x2q){pk4f8(b0), pk4f8(b1)};
                __builtin_amdgcn_sched_barrier(0); }
#undef P1_LD
        } else if (pn < 12) {
            unsigned char* const VT = (unsigned char*)V;
#pragma unroll
            for (int ai = 0; ai < 2; ++ai)
#pragma unroll
                for (int m = 0; m < 4; ++m) { const int row = row0 + ai * HALF + m * 16; const int bb = row >> 13, sq = row & 8191, kk = sq & 63;
                    const int pos = (sq & ~63) + 32 * ((kk >> 2) & 1) + 16 * (kk >> 5) + (kk & 3) + 4 * ((kk >> 3) & 3);
#pragma unroll
                    for (int bj = 0; bj < 2; ++bj) { unsigned char* rp = VT + (size_t)((bb * 8 + (pn - 8) * 2 + bj) * 128 + wc * 32 + 8 * fq) * 8192 + pos;
#pragma unroll
                        for (int n2 = 0; n2 < 2; ++n2) { const f32x4 v4 = acc[ai][bj][m][n2] * 4.0f;
                            const unsigned w0 = (unsigned)__builtin_amdgcn_cvt_pk_fp8_f32(v4[0], v4[1], 0, false), w1 = (unsigned)__builtin_amdgcn_cvt_pk_fp8_f32(v4[2], v4[3], 0, false);
                            rp[(size_t)(4 * n2 + 0) * 8192] = (unsigned char)w0; rp[(size_t)(4 * n2 + 1) * 8192] = (unsigned char)(w0 >> 8);
                            rp[(size_t)(4 * n2 + 2) * 8192] = (unsigned char)w1; rp[(size_t)(4 * n2 + 3) * 8192] = (unsigned char)(w1 >> 8); } } }
        } else if (pn < 14) {
            bf16_t* base; int ldc;
            { base = CB + (pn - 12) * 256; ldc = 512; }
            base += wc * 32 + 8 * fq;
#pragma unroll
            for (int ai = 0; ai < 2; ++ai)
#pragma unroll
                for (int m = 0; m < 4; ++m) { bf16_t* rp = base + (size_t)(row0 + ai * HALF + m * 16) * ldc;
#pragma unroll
                    for (int bj = 0; bj < 2; ++bj) *(u32x4*)(rp + bj * HALF) = pack8(acc[ai][bj][m][0], acc[ai][bj][m][1]); }
        } else if (pn < 18) {
            bf16_t* base = Z + (pn - 14) * 128 + wc * 32 + 8 * fq;
#pragma unroll
            for (int ai = 0; ai < 2; ++ai)
#pragma unroll
                for (int m = 0; m < 4; ++m) { bf16_t* rp = base + (size_t)(row0 + ai * HALF + m * 16) * 512;
                    *(u32x4*)rp = pack8(acc[ai][0][m][0] * acc[ai][1][m][0], acc[ai][0][m][1] * acc[ai][1][m][1]); }
        } else if (pn < 20) {
            bf16_t* base = QM + (pn - 18) * 256 + wc * 32 + 8 * fq;
#pragma unroll
            for (int ai = 0; ai < 2; ++ai)
#pragma unroll
                for (int m = 0; m < 4; ++m) { bf16_t* rp = base + (size_t)(row0 + ai * HALF + m * 16) * 512;
#pragma unroll
                    for (int bj = 0; bj < 2; ++bj) *(u32x4*)(rp + bj * HALF) = pack8(acc[ai][bj][m][0] * QMSCALE, acc[ai][bj][m][1] * QMSCALE); }
        } else {
            unsigned char* base = (unsigned char*)G + (pn - 20) * 256 + wc * 32 + 8 * fq;
#pragma unroll
            for (int ai = 0; ai < 2; ++ai)
#pragma unroll
                for (int m = 0; m < 4; ++m) { unsigned char* rp = base + (size_t)(row0 + ai * HALF + m * 16) * 3072;
#pragma unroll
                    for (int bj = 0; bj < 2; ++bj) { const f32x4 g0 = sigmoid4(acc[ai][bj][m][0]) * 255.0f + 0.5f, g1 = sigmoid4(acc[ai][bj][m][1]) * 255.0f + 0.5f;
                        unsigned q[8];
#pragma unroll
                        for (int i = 0; i < 4; ++i) { const unsigned a = (unsigned)g0[i], b = (unsigned)g1[i]; q[i] = a < 1u ? 1u : a; q[4 + i] = b < 1u ? 1u : b; }
                        typedef unsigned u32x2e __attribute__((ext_vector_type(2))); u32x2e w;
                        w.x = q[0] | (q[1] << 8) | (q[2] << 16) | (q[3] << 24); w.y = q[4] | (q[5] << 8) | (q[6] << 16) | (q[7] << 24);
                        *(u32x2e*)(rp + bj * HALF) = w; } }
        }
    }
};

template <bool FIRST> struct EpiGate {
    static constexpr bool PERM = true, AFTER_DRAIN = false;
    bf16_t* Mg; const bf16_t* G; int gi;
    __device__ __forceinline__ void operator()(const f32x4 (&acc)[2][2][4][2], const Unit& u, int wr, int wc, int fr, int fq) const {
        const int row0 = u.pm * BM + wr * 64 + fr, col0 = u.pn * BM + wc * 32 + 8 * fq;
#pragma unroll
        for (int ai = 0; ai < 2; ++ai)
#pragma unroll
            for (int m = 0; m < 4; ++m) { const size_t row = (size_t)(row0 + ai * HALF + m * 16);
#pragma unroll
                for (int bj = 0; bj < 2; ++bj) { const int col = col0 + bj * HALF;
                    const u32x4 gv = *(const u32x4*)(G + row * 3072 + gi * 1024 + col);
                    f32x4 v0 = acc[ai][bj][m][0] * bf_lo4(gv), v1 = acc[ai][bj][m][1] * bf_hi4(gv);
                    bf16_t* mp = Mg + row * 1024 + col;
                    if (!FIRST) { const u32x4 pv = __builtin_nontemporal_load((const u32x4*)mp); v0 += bf_lo4(pv); v1 += bf_hi4(pv); }
                    *(u32x4*)mp = pack8(v0, v1); } }
    }
};

struct EpiSwiglu {
    static constexpr bool PERM = true, AFTER_DRAIN = false, KEEP_ACC = false;
    __device__ __forceinline__ bool keep(const Unit&) const { return false; }
    bf16_t* H;
    __device__ __forceinline__ void operator()(const f32x4 (&acc)[2][2][4][2], const Unit& u, int wr, int wc, int fr, int fq) const {
        const int row0 = u.pm * BM + wr * 64 + fr; bf16_t* base = H + (u.pn & 3) * 128 + wc * 32 + 8 * fq;
#pragma unroll
        for (int ai = 0; ai < 2; ++ai)
#pragma unroll
            for (int m = 0; m < 4; ++m) { bf16_t* rp = base + (size_t)(row0 + ai * HALF + m * 16) * 512;
                const f32x4 g0 = acc[ai][0][m][0], g1 = acc[ai][0][m][1];
                *(u32x4*)rp = pack8(g0 * sigmoid4(g0) * acc[ai][1][m][0], g1 * sigmoid4(g1) * acc[ai][1][m][1]); }
    }
};
struct EpiScatter {
    static constexpr bool PERM = true, AFTER_DRAIN = false;
    bf16_t* Yc; const int* rowinfo; const float* roww;
    __device__ __forceinline__ void operator()(const f32x4 (&acc)[2][2][4][2], const Unit& u, int wr, int wc, int fr, int fq) const {
        const int row0 = u.pm * BM + wr * 64 + fr, col0 = (u.pn & 3) * BM + wc * 32 + 8 * fq;
        int info[8]; float w[8];
#pragma unroll
        for (int it = 0; it < 8; ++it) { const int row = row0 + (it >> 2) * HALF + (it & 3) * 16; info[it] = rowinfo[row]; w[it] = roww[row]; }
        __builtin_amdgcn_sched_barrier(0);
#pragma unroll
        for (int it = 0; it < 8; ++it) { const int ai = it >> 2, m = it & 3;
            if (info[it] >= 0) { bf16_t* rp = Yc + (size_t)info[it] * 1024 + col0;
#pragma unroll
                for (int bj = 0; bj < 2; ++bj) *(u32x4*)(rp + bj * HALF) = pack8(acc[ai][bj][m][0] * w[it], acc[ai][bj][m][1] * w[it]); } }
    }
};
struct MoeOrder {
    int ntiles, vcu, G; const PG8_LAS int* tile_e;
    __device__ __forceinline__ bool next(int i, Unit& u) const {
        const int L = i * G + vcu; if (L >= ntiles * 4) return false;
        u.pm = L >> 2; u.pn = __builtin_amdgcn_readfirstlane(tile_e[L >> 2]) * 4 + (L & 3); return true;
    }
    __device__ __forceinline__ void a_ready(const Unit&) const {}
    __device__ __forceinline__ void done(const Unit&) const {}
};

struct EpiLn1 {
    static constexpr bool PERM = false, AFTER_DRAIN = true;
    const float* base; float* out; bf16_t* xb; const float* gamma; const float* beta; PanelStats st;
    static constexpr float alpha = 1.4142135623730951f;
    __device__ __forceinline__ void fused(f32x4 (&acc)[2][2][4][2], const Unit& u, int wr, int wc, int fr, int fq, PG8_LAS unsigned char* lds, int wid, int lane) const {
        typedef float f32x2v __attribute__((ext_vector_type(2))); typedef unsigned u32x2v __attribute__((ext_vector_type(2)));
        const PG8_LAS f32x2v* S = (const PG8_LAS f32x2v*)(lds + 8192);
        const int col0 = u.pn * BM + wc * 32 + 4 * fq;
#pragma unroll
        for (int ai = 0; ai < 2; ++ai)
#pragma unroll
            for (int m = 0; m < 4; ++m) { const unsigned off = (unsigned)(u.pm * BM + ai * HALF + wr * 64 + m * 16 + fr) * 1024u + (unsigned)col0;
#pragma unroll
                for (int bj = 0; bj < 2; ++bj)
#pragma unroll
                    for (int n = 0; n < 2; ++n) acc[ai][bj][m][n] += *(const f32x4*)(base + (off + bj * HALF + n * 16)) * alpha;
                asm volatile("" : "+v"(acc[ai][0][m][0]), "+v"(acc[ai][0][m][1]), "+v"(acc[ai][1][m][0]), "+v"(acc[ai][1][m][1]));
                asm volatile("" ::: "memory"); }
        const bool bad = st.run(acc, u, wr, wc, fr, fq, lds, wid, lane);
        const float qnan = __builtin_nanf("");
#pragma unroll
        for (int bj = 0; bj < 2; ++bj)
#pragma unroll
            for (int n = 0; n < 2; ++n) { const f32x4 gv = *(const f32x4*)(gamma + col0 + bj * HALF + n * 16), bv = *(const f32x4*)(beta + col0 + bj * HALF + n * 16);
#pragma unroll
                for (int ai = 0; ai < 2; ++ai)
#pragma unroll
                    for (int m = 0; m < 4; ++m) { const int r = ai * HALF + wr * 64 + m * 16 + fr; const f32x2v sr = S[r]; const unsigned off = (unsigned)(u.pm * BM + r) * 1024u + (unsigned)(col0 + bj * HALF + n * 16);
                        f32x4 o = (acc[ai][bj][m][n] - sr.x) * sr.y * gv + bv;
                        if (bad) o = (f32x4){qnan, qnan, qnan, qnan};
                        *(f32x4*)(out + off) = o;
                        u32x2v w; w.x = cvt_pk_bf16(o[0], o[1]); w.y = cvt_pk_bf16(o[2], o[3]); *(u32x2v*)(xb + off) = w; }
                asm volatile("" ::: "memory"); }
    }
};
}
#include <hip/hip_bf16.h>
#include <cmath>
namespace dattn {
using bf16=__hip_bfloat16;
using bf16x8=__attribute__((ext_vector_type(8)))short;
using s16x4=__attribute__((ext_vector_type(4)))short;
using f32x16=__attribute__((ext_vector_type(16)))float;
using u32x4=__attribute__((ext_vector_type(4)))unsigned;
using f32x4v=__attribute__((ext_vector_type(4)))float;
constexpr int BATCH=2,NHEAD=16,SEQ=8192,D=64,DM=NHEAD*D;
constexpr int NW=8,QBLK=32,QB=QBLK*NW,KVBLK=64,NQB=SEQ/QB;
constexpr int ATTN_PITCH=DM, ATTN_UNIT_ROWS=QB;
__device__ __forceinline__ int crow(int r,int hi){return (r&3)+8*(r>>2)+4*hi;}
#define SBAR() __builtin_amdgcn_sched_barrier(0)
__device__ __forceinline__ void cmask(f32x16&p0,f32x16&p1,int jb,int qrel,int hi){
  const float NEG=-INFINITY; int kb=64*jb+4*hi;
  #pragma unroll
  for(int r=0;r<16;++r){int kv=kb+(r&3)+8*(r>>2); if(kv>qrel)p0[r]=NEG; if(kv+32>qrel)p1[r]=NEG;}
}

constexpr int NSLOT=3, SLOTB=4096;
constexpr int LDS_K=0, LDS_V=NSLOT*SLOTB, LDS_WS=3*NSLOT*SLOTB, LDS_OST=LDS_WS+NW*64*4, LDS_PARK=LDS_OST+NW*4096, LDS_BYTES=LDS_PARK+NW*8192;
constexpr float C2=0.125f*1.4426950408889634f;
__device__ __forceinline__ void glds16(const void*gsrc,unsigned lds_dst){unsigned keep;
  asm volatile("s_mov_b32 %0, m0\n\ts_mov_b32 m0, %2\n\ts_nop 0\n\tglobal_load_lds_dwordx4 %1, off\n\ts_mov_b32 m0, %0":"=&s"(keep):"v"(gsrc),"s"(lds_dst):"memory");}
__device__ __forceinline__ void glds16o(unsigned voff,const void*sbase,unsigned lds_dst){unsigned keep;
  asm volatile("s_mov_b32 %0, m0\n\ts_mov_b32 m0, %2\n\ts_nop 0\n\tglobal_load_lds_dwordx4 %1, %3\n\ts_mov_b32 m0, %0":"=&s"(keep):"v"(voff),"s"(lds_dst),"s"(sbase):"memory");}
__device__ __forceinline__ float max3f(float a,float b,float c){float r;asm("v_max3_f32 %0, %1, %2, %3":"=v"(r):"v"(a),"v"(b),"v"(c));return r;}
__device__ __forceinline__ float max2f(float a,float b){float r;asm("v_max_f32_e32 %0, %1, %2":"=v"(r):"v"(a),"v"(b));return r;}
__device__ __forceinline__ float fadd_s(float a,float b){float r;asm("v_add_f32_e32 %0, %1, %2":"=v"(r):"v"(a),"v"(b));return r;}
__device__ __forceinline__ float fsub_s(float a,float b){float r;asm("v_sub_f32_e32 %0, %1, %2":"=v"(r):"v"(a),"v"(b));return r;}
typedef float f32x2_t __attribute__((ext_vector_type(2))); typedef __bf16 bf16x2_t __attribute__((ext_vector_type(2)));
__device__ __forceinline__ unsigned cvtpk_s(float lo,float hi){f32x2_t v={lo,hi};bf16x2_t b=__builtin_convertvector(v,bf16x2_t);return __builtin_bit_cast(unsigned,b);}
#define WAIT_BAR(N) asm volatile("s_waitcnt vmcnt(" #N ") lgkmcnt(0)\n\ts_barrier":::"memory")

typedef int v4i_t __attribute__((ext_vector_type(4))); typedef int v8i_t __attribute__((ext_vector_type(8)));
__device__ __forceinline__ v8i_t cat44(v4i_t a,v4i_t b){return (v8i_t){a[0],a[1],a[2],a[3],b[0],b[1],b[2],b[3]};}
#define QK8(KF,QFR,C) __builtin_amdgcn_mfma_scale_f32_32x32x64_f8f6f4(KF,QFR,C,0,0,0,0x7f7f7f7f,0,0x7c7c7c7c)
#define PV8(PF,VF,C) __builtin_amdgcn_mfma_scale_f32_32x32x64_f8f6f4(PF,VF,C,0,0,0,0x7f7f7f7f,0,0x7d7d7d7d)
constexpr float PBIAS=4.0f;
#define PVS(PF,ONES,C) __builtin_amdgcn_mfma_scale_f32_32x32x64_f8f6f4(PF,ONES,C,0,0,0,0x7f7f7f7f,0,0x7f7f7f7f)
typedef __attribute__((address_space(3))) const char* lds_cptr;
typedef short v4i16_t __attribute__((ext_vector_type(4)));
typedef const __attribute__((address_space(3))) v4i_t* lds_v4p;
__device__ __forceinline__ v8i_t kfrag(lds_cptr kp,int kb){ return cat44(*(lds_v4p)(kp+kb*512),*(lds_v4p)(kp+1024+kb*512)); }
__device__ __forceinline__ s16x4 vtr(lds_cptr p){ return __builtin_bit_cast(s16x4,__builtin_amdgcn_ds_read_tr16_b64_v4i16((__attribute__((address_space(3))) v4i16_t*)p)); }
__device__ __forceinline__ float rowmax(const f32x16&p0,const f32x16&p1){
  float a=max3f(p0[0],p0[1],p1[0]),b=max3f(p0[2],p0[3],p1[1]);a=max3f(a,p1[2],p1[3]);
  #pragma unroll
  for(int r=4;r<16;r+=4){a=max3f(a,p0[r],p0[r+1]);b=max3f(b,p0[r+2],p0[r+3]);a=max3f(a,p1[r],p1[r+1]);b=max3f(b,p1[r+2],p1[r+3]);}
  const float m=max2f(a,b);
  auto rr=__builtin_amdgcn_permlane32_swap(__float_as_uint(m),__float_as_uint(m),false,false);
  return max2f(__uint_as_float(rr[0]),__uint_as_float(rr[1]));
}
__device__ __forceinline__ void pv(f32x16*o,int vb,bf16x8 pa0,bf16x8 pa1,bf16x8 pa2,bf16x8 pa3){
  #pragma unroll
  for(int d0=0;d0<4;++d0){s16x4 lo[4],hi[4];
    #pragma unroll
    for(int ks=0;ks<4;++ks){
      asm volatile("ds_read_b64_tr_b16 %0,%1 offset:%c2":"=&v"(lo[ks]):"v"(vb),"i"(d0*4096+ks*1024):"memory");
      asm volatile("ds_read_b64_tr_b16 %0,%1 offset:%c2":"=&v"(hi[ks]):"v"(vb),"i"(d0*4096+ks*1024+512):"memory");}
    asm volatile("s_waitcnt lgkmcnt(0)":::"memory");SBAR();
    #define PK(k) (bf16x8){lo[k][0],lo[k][1],lo[k][2],lo[k][3],hi[k][0],hi[k][1],hi[k][2],hi[k][3]}
    o[d0]=__builtin_amdgcn_mfma_f32_32x32x16_bf16(pa0,PK(0),o[d0],0,0,0);
    o[d0]=__builtin_amdgcn_mfma_f32_32x32x16_bf16(pa1,PK(1),o[d0],0,0,0);
    o[d0]=__builtin_amdgcn_mfma_f32_32x32x16_bf16(pa2,PK(2),o[d0],0,0,0);
    o[d0]=__builtin_amdgcn_mfma_f32_32x32x16_bf16(pa3,PK(3),o[d0],0,0,0);
    #undef PK
  }
}

#ifndef ATTN_STORE16
#define ATTN_STORE16(p,v) (*(u32x4*)(p)=(v))
#endif
template<int THRL,bool ROT> __device__ __forceinline__ void attn_unit(int b,int qkcol,int vcol,int qb,const bf16*Q,const bf16*__restrict__ K,const bf16*__restrict__ V,bf16*O,char*shm,int wave_id,int mode=0,float lam=0.f,float osc=0.f,const float*subg=nullptr){
  int tid_=wave_id*64+pg8::lane_id_v(); asm volatile("":"+v"(tid_)); const int tid=tid_,lane=tid&63,r32=lane&31,hi=lane>>5; const int wid=__builtin_amdgcn_readfirstlane(tid>>6);
  const long rowbase=(long)b*SEQ; const int q0=qb*QB;
  const unsigned char*Qw8=(const unsigned char*)Q+(rowbase+q0+wid*QBLK)*1024+qkcol;
  const unsigned char*Kh8=(const unsigned char*)K+rowbase*1024+qkcol; const unsigned char*VTh=(const unsigned char*)V+(size_t)((b*8+(vcol>>7))*128)*SEQ;
  const unsigned lds0=(unsigned)(uintptr_t)shm;
  float*wsf=(float*)(shm+LDS_WS)+wid*64;
  const unsigned koff=(unsigned)(lane*1024+(wid&3)*16);
  const unsigned voff=(unsigned)((64*(wid>>2)+lane)*SEQ+16*(wid&3));
  const unsigned kdst=lds0+LDS_K+(wid&3)*1024, vdst=lds0+LDS_V+(wid&3)*2048+(wid>>2)*1024;
  #define DMA_K(t,slot) glds16o(koff,Kh8+(long)(t)*KVBLK*1024,(unsigned)__builtin_amdgcn_readfirstlane(kdst+(slot)))
  #define DMA_V(t,slot) glds16o(voff,VTh+(long)(t)*KVBLK,(unsigned)__builtin_amdgcn_readfirstlane(vdst+2*(slot)))
  const char*Kbase=shm+LDS_K; v8i_t kf[2];
  const lds_cptr shm3=(lds_cptr)shm; const lds_cptr kp0=shm3+LDS_K+hi*2048+r32*16; const lds_cptr vp0=shm3+LDS_V+hi*4096+r32*16;
  const int NT=(q0+QB)/KVBLK;
  DMA_K(0,0);DMA_V(0,0);DMA_K(1,SLOTB);
  const v8i_t qf=cat44(*reinterpret_cast<const v4i_t*>(Qw8+(long)r32*1024+hi*32),*reinterpret_cast<const v4i_t*>(Qw8+(long)r32*1024+hi*32+16));
  float mhat=0.f;f32x16 o[4];o[0]=f32x16{};o[1]=f32x16{};o[2]=f32x16{};o[3]=f32x16{}; f32x16 lacc=f32x16{};
  v8i_t ones8; { int o1_; asm volatile("v_mov_b32 %0, 0x38383838":"=v"(o1_)); ones8=(v8i_t){o1_,o1_,o1_,o1_,o1_,o1_,o1_,o1_}; asm volatile("":"+v"(ones8)); }
  f32x16 negm;
  #pragma unroll
  for(int r=0;r<16;++r){ float z_; asm volatile("v_mov_b32 %0, 0":"=v"(z_)); negm[r]=z_; }
  asm volatile("":"+v"(negm));
  #define ZERO16 negm
  const int qrel=wid*QBLK+r32;
  #define CMASK(P0,P1,t) do{int jb_=(t)-(NT-4); if(jb_>=0)cmask(P0,P1,jb_,qrel,hi);}while(0)
  bool resc=false;
  #define START(P0,P1) do{ const float rm=rowmax(P0,P1); resc=false; \
    { const float dl=rm-PBIAS; mhat=fadd_s(mhat,dl); \
      _Pragma("unroll") for(int r=0;r<16;++r){P0[r]=fsub_s(P0[r],dl);P1[r]=fsub_s(P1[r],dl);} \
      _Pragma("unroll") for(int r=0;r<16;++r)negm[r]=-mhat; asm volatile("":"+v"(negm)); } \
    _Pragma("unroll") for(int r=0;r<16;++r)P0[r]=__builtin_amdgcn_exp2f(P0[r]); }while(0)
  #define RESC() do{ if(resc){ asm volatile("s_waitcnt lgkmcnt(0)":::"memory"); \
      _Pragma("unroll") for(int r=0;r<16;++r){ const float f_=wsf[crow(r,hi)]; o[0][r]*=f_; o[1][r]*=f_; o[2][r]*=f_; o[3][r]*=f_; lacc[r]*=f_; } } }while(0)
  f32x16 pA0,pA1,pB0,pB1;
  int sl_prev=0,sl_cur=0,sl_next=SLOTB;
  #define ROT() do{sl_prev=sl_cur;sl_cur=sl_next;sl_next=(sl_next==(NSLOT-1)*SLOTB)?0:sl_next+SLOTB;}while(0)
  DMA_K(2,2*SLOTB);
  WAIT_BAR(3);
  { const f32x16 z0_=f32x16{}; const char*kb_=Kbase+hi*2048+r32*16;
    const v8i_t k0_=cat44(*reinterpret_cast<const v4i_t*>(kb_),*reinterpret_cast<const v4i_t*>(kb_+1024)), k1_=cat44(*reinterpret_cast<const v4i_t*>(kb_+512),*reinterpret_cast<const v4i_t*>(kb_+1536));
    pA0=QK8(k0_,qf,z0_); pA1=QK8(k1_,qf,z0_); }asm volatile("s_nop 15\n\ts_nop 7":"+v"(pA0),"+v"(pA1));CMASK(pA0,pA1,0);
  START(pA0,pA1);
  _Pragma("unroll") for(int r=0;r<16;++r)pA1[r]=__builtin_amdgcn_exp2f(pA1[r]);
  WAIT_BAR(0);
  DMA_K(3,0);DMA_V(1,SLOTB);
  ROT();
  kf[0]=kfrag(kp0+sl_cur,0); kf[1]=kfrag(kp0+sl_cur,1);
  WAIT_BAR(2);
  v8i_t vf[2]; int pf0,pf1,pf2,pf3,pf4,pf5,pf6,pf7;
  asm volatile("v_mov_b32 %0, 0\n\tv_mov_b32 %1, 0\n\tv_mov_b32 %2, 0\n\tv_mov_b32 %3, 0\n\tv_mov_b32 %4, 0\n\tv_mov_b32 %5, 0\n\tv_mov_b32 %6, 0\n\tv_mov_b32 %7, 0":"=v"(pf0),"=v"(pf1),"=v"(pf2),"=v"(pf3),"=v"(pf4),"=v"(pf5),"=v"(pf6),"=v"(pf7));
  #define PK8(P,B,W) do{ W=__builtin_amdgcn_cvt_pk_fp8_f32(P[B],P[B+1],W,false); W=__builtin_amdgcn_cvt_pk_fp8_f32(P[B+2],P[B+3],W,true); }while(0)
  #define PFV ((v8i_t){pf0,pf1,pf2,pf3,pf4,pf5,pf6,pf7})
  #define PIN(x) asm volatile("":"+v"(x))
  #define MX3(a,b,c) __builtin_fmaxf(__builtin_fmaxf((a),(b)),(c))
  #define EX(v) __builtin_amdgcn_exp2f(v)
  #define VLD(i,d0) do{ vf[i]=cat44(*(lds_v4p)(vp_+(d0)*512),*(lds_v4p)(vp_+2048+(d0)*512)); }while(0)
  #define GAPD(MF,RD,X,B) do{ MF; RD; X[B]=EX(X[B]); X[B+1]=EX(X[B+1]); X[B+2]=EX(X[B+2]); X[B+3]=EX(X[B+3]); X[B+4]=EX(X[B+4]); X[B+5]=EX(X[B+5]); X[B+6]=EX(X[B+6]); X[B+7]=EX(X[B+7]); PIN(X); SBAR(); }while(0)
  #define KRD(G,j) do{ if(G){ kf[j]=kfrag(kp0+sl_next,j); SBAR(); } }while(0)
  #define STEP(C0,C1,P0,P1,t,GK,GV,GL) do{ SBAR(); \
    const lds_cptr vp_=vp0+2*sl_prev; \
    VLD(0,0); SBAR(); \
    C0=QK8(kf[0],qf,ZERO16); \
    PK8(P0,0,pf0); PK8(P0,4,pf1); PK8(P0,8,pf2); PK8(P0,12,pf3); PIN(pf0); PIN(pf1); PIN(pf2); PIN(pf3); SBAR(); \
    VLD(1,1); SBAR(); \
    C1=QK8(kf[1],qf,ZERO16); \
    PK8(P1,0,pf4); PK8(P1,4,pf5); PK8(P1,8,pf6); PK8(P1,12,pf7); PIN(pf4); PIN(pf5); PIN(pf6); PIN(pf7); SBAR(); \
    lacc=PVS(PFV,ones8,lacc); \
    if(GK){DMA_K((t)+3,sl_cur);} if(GV){DMA_V((t)+1,sl_next);} \
    CMASK(C0,C1,t); \
    { float a=MX3(C0[0],C0[1],C1[0]),b=MX3(C0[2],C0[3],C1[1]); a=MX3(a,C1[2],C1[3]); \
      _Pragma("unroll") for(int r=4;r<16;r+=4){a=MX3(a,C0[r],C0[r+1]);b=MX3(b,C0[r+2],C0[r+3]);a=MX3(a,C1[r],C1[r+1]);b=MX3(b,C1[r+2],C1[r+3]);} \
      float rm=__builtin_fmaxf(a,b); { auto rr=__builtin_amdgcn_permlane32_swap(__float_as_uint(rm),__float_as_uint(rm),false,false); rm=__builtin_fmaxf(__uint_as_float(rr[0]),__uint_as_float(rr[1])); } \
      resc=false; \
      if(__builtin_expect(__any(rm>(float)THRL),0)){ const float dl=__builtin_fmaxf(rm-PBIAS,0.f); mhat+=dl; \
        _Pragma("unroll") for(int r=0;r<16;++r){C0[r]-=dl;C1[r]-=dl;} \
        _Pragma("unroll") for(int r=0;r<16;++r)negm[r]=-mhat; asm volatile("":"+v"(negm)); \
        const float f=__builtin_amdgcn_exp2f(-dl); if(hi==0)wsf[r32]=f; resc=true; } } \
    SBAR(); \
    GAPD(o[0]=PV8(PFV,vf[0],o[0]), VLD(0,2), C0,0); \
    GAPD(o[1]=PV8(PFV,vf[1],o[1]), VLD(1,3), C0,8); \
    KRD(GL,0); GAPD(o[2]=PV8(PFV,vf[0],o[2]), (void)0, C1,0); \
    KRD(GL,1); GAPD(o[3]=PV8(PFV,vf[1],o[3]), (void)0, C1,8); \
    }while(0)
  #define YSTEP(X0,X1,t,GK,GV,GL) do{ SBAR(); \
    const lds_cptr vp_=vp0+2*sl_prev; \
    VLD(0,0); VLD(1,1); SBAR(); \
    if(GK){DMA_K((t)+3,sl_cur);} if(GV){DMA_V((t)+1,sl_next);} \
    { float a=MX3(X0[0],X0[1],X1[0]),b=MX3(X0[2],X0[3],X1[1]); a=MX3(a,X1[2],X1[3]); \
      _Pragma("unroll") for(int r=4;r<16;r+=4){a=MX3(a,X0[r],X0[r+1]);b=MX3(b,X0[r+2],X0[r+3]);a=MX3(a,X1[r],X1[r+1]);b=MX3(b,X1[r+2],X1[r+3]);} \
      float rm=__builtin_fmaxf(a,b); { auto rr=__builtin_amdgcn_permlane32_swap(__float_as_uint(rm),__float_as_uint(rm),false,false); rm=__builtin_fmaxf(__uint_as_float(rr[0]),__uint_as_float(rr[1])); } \
      resc=false; \
      if(__builtin_expect(__any(rm>(float)THRL),0)){ const float dl=__builtin_fmaxf(rm-PBIAS,0.f); mhat+=dl; \
        _Pragma("unroll") for(int r=0;r<16;++r){X0[r]-=dl;X1[r]-=dl;} \
        _Pragma("unroll") for(int r=0;r<16;++r)negm[r]=-mhat; asm volatile("":"+v"(negm)); \
        const float f=__builtin_amdgcn_exp2f(-dl); if(hi==0)wsf[r32]=f; resc=true; } } \
    SBAR(); \
    GAPD(o[0]=PV8(PFV,vf[0],o[0]), VLD(0,2), X0,0); \
    GAPD(o[1]=PV8(PFV,vf[1],o[1]), VLD(1,3), X0,8); \
    KRD(GL,0); GAPD(o[2]=PV8(PFV,vf[0],o[2]), (void)0, X1,0); \
    KRD(GL,1); GAPD(o[3]=PV8(PFV,vf[1],o[3]), (void)0, X1,8); \
    RESC(); SBAR(); \
    PK8(X0,0,pf0); PK8(X0,4,pf1); PK8(X0,8,pf2); PK8(X0,12,pf3); PK8(X1,0,pf4); PK8(X1,4,pf5); PK8(X1,8,pf6); PK8(X1,12,pf7); \
    PIN(pf0); PIN(pf1); PIN(pf2); PIN(pf3); PIN(pf4); PIN(pf5); PIN(pf6); PIN(pf7); SBAR(); \
    lacc=PVS(PFV,ones8,lacc); \
    if(GL){ X0=QK8(kf[0],qf,ZERO16); X1=QK8(kf[1],qf,ZERO16); CMASK(X0,X1,(t)+1); } \
    }while(0)
  #define ENDW(tt) do{ if((tt)+3<NT){WAIT_BAR(2);} else if((tt)+2<NT){WAIT_BAR(1);} else {WAIT_BAR(0);} }while(0)
  int t=1;
  if constexpr(ROT){
    PK8(pA0,0,pf0); PK8(pA0,4,pf1); PK8(pA0,8,pf2); PK8(pA0,12,pf3); PK8(pA1,0,pf4); PK8(pA1,4,pf5); PK8(pA1,8,pf6); PK8(pA1,12,pf7);
    PIN(pf0); PIN(pf1); PIN(pf2); PIN(pf3); PIN(pf4); PIN(pf5); PIN(pf6); PIN(pf7); SBAR();
    lacc=PVS(PFV,ones8,lacc);
    pA0=QK8(kf[0],qf,ZERO16); pA1=QK8(kf[1],qf,ZERO16); CMASK(pA0,pA1,1);
    for(;t+5<NT;t+=2){
      YSTEP(pA0,pA1,t,true,true,true);     WAIT_BAR(2); ROT();
      YSTEP(pA0,pA1,t+1,true,true,true);   WAIT_BAR(2); ROT();
    }
    for(;t+1<NT;t+=2){
      YSTEP(pA0,pA1,t,(t+3<NT),(t+1<NT),(t+1<NT));       ENDW(t);   ROT();
      YSTEP(pA0,pA1,t+1,(t+4<NT),(t+2<NT),(t+2<NT));     ENDW(t+1); ROT();
    }
    YSTEP(pA0,pA1,NT-1,false,false,false);
    { SBAR(); const lds_cptr vp_=vp0+2*sl_cur;
      VLD(0,0); VLD(1,1); o[0]=PV8(PFV,vf[0],o[0]); o[1]=PV8(PFV,vf[1],o[1]); VLD(0,2); VLD(1,3); o[2]=PV8(PFV,vf[0],o[2]); o[3]=PV8(PFV,vf[1],o[3]); }
  } else {
  #undef CMASK
  #define CMASK(P0,P1,t) do{}while(0)
  for(;t+5<NT;t+=2){
    STEP(pB0,pB1,pA0,pA1,t,true,true,true);     WAIT_BAR(2); RESC(); ROT();
    STEP(pA0,pA1,pB0,pB1,t+1,true,true,true);   WAIT_BAR(2); RESC(); ROT();
  }
  #undef CMASK
  #define CMASK(P0,P1,t) do{int jb_=(t)-(NT-4); if(jb_>=0)cmask(P0,P1,jb_,qrel,hi);}while(0)
  for(;t+1<NT;t+=2){
    STEP(pB0,pB1,pA0,pA1,t,(t+3<NT),(t+1<NT),(t+1<NT));       ENDW(t);   RESC(); ROT();
    STEP(pA0,pA1,pB0,pB1,t+1,(t+4<NT),(t+2<NT),(t+2<NT));     ENDW(t+1); RESC(); ROT();
  }
  STEP(pB0,pB1,pA0,pA1,NT-1,false,false,false); RESC();
  { PK8(pB0,0,pf0); PK8(pB0,4,pf1); PK8(pB0,8,pf2); PK8(pB0,12,pf3); PK8(pB1,0,pf4); PK8(pB1,4,pf5); PK8(pB1,8,pf6); PK8(pB1,12,pf7);
    SBAR(); const lds_cptr vp_=vp0+2*sl_cur; lacc=PVS(PFV,ones8,lacc);
    VLD(0,0); VLD(1,1); o[0]=PV8(PFV,vf[0],o[0]); o[1]=PV8(PFV,vf[1],o[1]); VLD(0,2); VLD(1,3); o[2]=PV8(PFV,vf[0],o[2]); o[3]=PV8(PFV,vf[1],o[3]); }
  }
  #undef YSTEP
  #undef PK8
  #undef PFV
  #undef VLD
  #undef GAPD
  #undef PIN
  #undef MX3
  #undef EX
  #undef KRD
  #undef STEP
  #undef ENDW
  float rli[16];
  #pragma unroll
  for(int r=0;r<16;++r)rli[r]=__builtin_amdgcn_rcpf(lacc[r]);
  bf16*Ow=O+(rowbase+q0+wid*QBLK)*DM+vcol;
  typedef __attribute__((address_space(3))) unsigned* lds_uptr;
  const lds_uptr pk=(lds_uptr)(shm3+LDS_PARK)+wid*2048+lane;
  if(mode==1){
    #pragma unroll
    for(int d0=0;d0<4;++d0){
      #pragma unroll
      for(int r2=0;r2<8;++r2)pk[(d0*8+r2)*64]=cvtpk_s(o[d0][2*r2]*rli[2*r2],o[d0][2*r2+1]*rli[2*r2+1]); }
  } else {
    if(mode==2){
      #pragma unroll
      for(int d0=0;d0<4;++d0){
        #pragma unroll
        for(int r2=0;r2<8;++r2){ const unsigned w=pk[(d0*8+r2)*64];
          o[d0][2*r2]=__uint_as_float(w<<16)-lam*(o[d0][2*r2]*rli[2*r2]); o[d0][2*r2+1]=__uint_as_float(w&0xffff0000u)-lam*(o[d0][2*r2+1]*rli[2*r2+1]); } }
      #pragma unroll
      for(int r=0;r<16;++r){ float ss=(o[0][r]*o[0][r]+o[1][r]*o[1][r])+(o[2][r]*o[2][r]+o[3][r]*o[3][r]);
        ss+=pg8::shx<1>(ss); ss+=pg8::shx<2>(ss); ss+=pg8::shx<4>(ss); ss+=pg8::shx<8>(ss); ss+=pg8::shx<16>(ss);
        rli[r]=osc/sqrtf(ss*(1.0f/128.0f)+1e-5f); }
      #pragma unroll
      for(int d0=0;d0<4;++d0){ const float g_=subg[32*d0+r32];
        #pragma unroll
        for(int r=0;r<16;++r)o[d0][r]*=g_; }
    }
    { bf16*stg=(bf16*)(shm+LDS_OST)+wid*2048;
      #pragma unroll
      for(int hf=0;hf<2;++hf){
        #pragma unroll
        for(int r=0;r<16;++r){const int orow=crow(r,hi);
          #pragma unroll
          for(int d0=0;d0<2;++d0)stg[orow*64+d0*32+r32]=__float2bfloat16(o[2*hf+d0][r]*rli[r]);}
        asm volatile("s_waitcnt lgkmcnt(0)":::"memory");
        #pragma unroll
        for(int i=0;i<4;++i){const int row=i*8+(lane>>3),ch=lane&7; const u32x4 v=*(const u32x4*)(stg+row*64+ch*8); ATTN_STORE16(Ow+(long)row*DM+hf*64+ch*8,v);}
        asm volatile("s_waitcnt lgkmcnt(0)":::"memory"); } }
  }
  asm volatile("s_waitcnt lgkmcnt(0)\n\ts_barrier":::"memory");
  #undef DMA_K
  #undef DMA_V
  #undef CMASK
  #undef START
  #undef RESC
  #undef ROT
  #undef ZERO16
}
constexpr int ATTN_LDS_BYTES=LDS_BYTES;
struct DiffTensors { const bf16* Q; const bf16* K; const bf16* V; bf16* O1; bf16* O2; bf16* Y; const float* subg; float lam, osc; };
#if !MK_FUSEC
template<int THRL=8> __device__ __forceinline__ void diff_attn_phase_sep(char*lds,const DiffTensors&T,int vcu,int wave_id){
  const int s=vcu&7, st=vcu>>3, b=st>>4, h=(st>>1)&7, c=st&1;
  for(int i=0;i<4;++i){ const int qb=(i==0)?s:(i==1)?15-s:(i==2)?16+s:31-s;
    attn_unit<THRL,false>(b,(2*h+c)*64,h*128,qb,T.Q,T.K,T.V,c?T.O2:T.O1,lds,wave_id); }
}
#else
template<int THRL=8> __device__ __forceinline__ void diff_attn_phase(char*lds,const DiffTensors&T,int vcu,int wave_id){
  const int j=vcu&15, bh=vcu>>4, b=bh>>3, h=bh&7;
  #pragma unroll 1
  for(int i=0;i<4;++i){ const int qb=(i>>1)?31-j:j, c=i&1;
#ifndef MK_YROT
#define MK_YROT 1
#endif
    if(MK_YROT && ((MK_YROT==1)?(wave_id>=4):(MK_YROT==2)?(wave_id<4):true)) attn_unit<THRL,true>(b,(2*h+c)*64,h*128,qb,T.Q,T.K,T.V,T.Y,lds,wave_id,c+1,T.lam,T.osc,T.subg);
    else attn_unit<THRL,false>(b,(2*h+c)*64,h*128,qb,T.Q,T.K,T.V,T.Y,lds,wave_id,c+1,T.lam,T.osc,T.subg); }
}
#endif
#undef SBAR
#undef WAIT_BAR
}
namespace pg8 {
typedef int v8i32 __attribute__((ext_vector_type(8)));
__device__ __forceinline__ v8i32 cat8(const bf16x8& lo, const bf16x8& hi) { typedef int v4i32 __attribute__((ext_vector_type(4)));
    const v4i32 a = __builtin_bit_cast(v4i32, lo), b = __builtin_bit_cast(v4i32, hi); return (v8i32){a[0], a[1], a[2], a[3], b[0], b[1], b[2], b[3]}; }
template <class Epi, class Sched, bool FP8 = false>
__device__ __forceinline__ void gemm_phase2(PG8_LAS unsigned char* lds, const Sched& S, const Epi& E, int wave_id) {
    int tid_ = wave_id * 64 + lane_id_v(); asm volatile("" : "+v"(tid_));
    const int tid = tid_, wid = __builtin_amdgcn_readfirstlane(tid >> 6), lane = tid & 63, wr = wid >> 2, wc = wid & 3, fr = lane & 15, fq = lane >> 4;
    const size_t kstep = (size_t)(BK * 2);
    const unsigned ldsw = (unsigned)wid * 1024u;
    const int aoff = lds_byte(wr * 64 + fr, fq * 8), boff = lds_byte(wc * 32 + fr, fq * 8);
#define PG8_SA(b, h) (((b) * 2 + (h)) * HTB)
#define PG8_SB(b, h) ((4 + (b) * 2 + (h)) * HTB)
#define PG8_STAGE(bufoff, gbase, voff) do { _Pragma("unroll") for (int _i = 0; _i < 2; ++_i) \
        __builtin_amdgcn_global_load_lds((const unsigned*)((const char*)(gbase) + (voff)[_i]), (PG8_LAS unsigned*)(lds + (bufoff) + ldsw + _i * 8192), 16, 0, 0); } while (0)
#define PG8_LDA(dst, b, h) do { _Pragma("unroll") for (int m = 0; m < 4; ++m) _Pragma("unroll") for (int k = 0; k < 2; ++k) dst[m][k] = *(const PG8_LAS bf16x8*)(lds + PG8_SA(b, h) + aoff + m * 2048 + k * 1024); } while (0)
#define PG8_LDB(dst, b, h) do { _Pragma("unroll") for (int n = 0; n < 2; ++n) _Pragma("unroll") for (int k = 0; k < 2; ++k) dst[n][k] = *(const PG8_LAS bf16x8*)(lds + PG8_SB(b, h) + boff + n * 2048 + k * 1024); } while (0)
#define PG8_MMA(ai, bj, At, Bt) do { __builtin_amdgcn_s_setprio(1); _Pragma("unroll") for (int m = 0; m < 4; ++m) _Pragma("unroll") for (int n = 0; n < 2; ++n) { \
        if constexpr (FP8) acc[ai][bj][m][n] = __builtin_amdgcn_mfma_scale_f32_16x16x128_f8f6f4(cat8(Bt[n][0], Bt[n][1]), cat8(At[m][0], At[m][1]), acc[ai][bj][m][n], 0, 0, 0, 0x7f7f7f7f, 0, 0x7f7f7f7f); \
        else { _Pragma("unroll") for (int k = 0; k < 2; ++k) acc[ai][bj][m][n] = __builtin_amdgcn_mfma_f32_16x16x32_bf16(Bt[n][k], At[m][k], acc[ai][bj][m][n], 0, 0, 0); } } \
        __builtin_amdgcn_s_setprio(0); } while (0)
#define PG8_WAIT_V(n) asm volatile("s_waitcnt vmcnt(" #n ")" ::: "memory")
#define PG8_WAIT_L(n) asm volatile("s_waitcnt lgkmcnt(" #n ")" ::: "memory")
#define PG8_BAR __builtin_amdgcn_s_barrier()
#define PG8_SCHED __builtin_amdgcn_sched_barrier(0)
    constexpr int NH = Sched::GATHER ? 2 : 1;
#define PG8_ROWS(u, ar) do { if (Sched::GATHER) { _Pragma("unroll") for (int h_ = 0; h_ < 2; ++h_) _Pragma("unroll") for (int i_ = 0; i_ < 2; ++i_) { int R_, C_; stage_rc(tid * 16 + i_ * 8192, R_, C_); \
        ar[h_][i_] = S.arow(u, h_ * HALF + R_); } } } while (0)
#define PG8_OFFS(ar, K_, ao, bo) do { _Pragma("unroll") for (int i_ = 0; i_ < 2; ++i_) { int R_, C_; stage_rc(tid * 16 + i_ * 8192, R_, C_); \
        const int Rb_ = Epi::PERM ? ((R_ & ~31) + perm32(R_ & 31)) : R_; bo[i_] = (unsigned)(Rb_ * (K_) + C_) * 2u; \
        _Pragma("unroll") for (int h_ = 0; h_ < NH; ++h_) ao[h_][i_] = (unsigned)((Sched::GATHER ? ar[h_][i_] : R_) * (K_) + C_) * 2u; } } while (0)
#define PG8_AH(h) (Sched::GATHER ? 0 : (size_t)(h) * hsA)
    Unit cur, nxt; int ui = 0;
    if (!S.next(0, cur)) return;
    f32x4 acc[2][2][4][2];
#pragma unroll
    for (int a = 0; a < 2; ++a)
#pragma unroll
        for (int b = 0; b < 2; ++b)
#pragma unroll
            for (int m = 0; m < 4; ++m)
#pragma unroll
                for (int n = 0; n < 2; ++n) acc[a][b][m][n] = (f32x4){0.f, 0.f, 0.f, 0.f};
    bf16x8 At[4][2], B0[2][2], B1[2][2];
    const char* cA; const char* cB; int cK; S.desc(cur, cA, cB, cK);
    unsigned ao2[NH][2], bo2[2]; int arN[2][2];
    PG8_ROWS(cur, arN); PG8_OFFS(arN, cK, ao2, bo2);
    size_t hsA = (size_t)HALF * cK * 2, hsB = hsA;
    int nt = cK / BK;
    PG8_STAGE(PG8_SB(0, 0), cB, bo2); PG8_STAGE(PG8_SB(0, 1), cB + hsB, bo2); PG8_STAGE(PG8_SA(0, 0), cA, ao2[0]); PG8_STAGE(PG8_SA(0, 1), cA + PG8_AH(1), ao2[NH - 1]);
    if (wr == 1) PG8_BAR;
    PG8_WAIT_V(2); PG8_BAR;
    PG8_STAGE(PG8_SB(1, 0), cB + kstep, bo2); PG8_STAGE(PG8_SA(1, 0), cA + kstep, ao2[0]); PG8_STAGE(PG8_SB(1, 1), cB + hsB + kstep, bo2);
    PG8_WAIT_V(6); PG8_BAR;
    for (;;) {
        const bool has_next = S.next(ui + 1, nxt);
        const char* nA = cA; const char* nB = cB; int nK = cK;
        if (has_next) { S.desc(nxt, nA, nB, nK); PG8_ROWS(nxt, arN); }
#pragma unroll 1
        for (int t = 0; t < nt; t += 2) {
            const bool last = (t == nt - 2);
            _Pragma("unroll") for (int h_ = 0; h_ < NH; ++h_) asm volatile("" : "+v"(ao2[h_][0]), "+v"(ao2[h_][1]));
            asm volatile("" : "+v"(bo2[0]), "+v"(bo2[1]));
            const char* a1 = cA + (size_t)(t + 1) * kstep;
            const char* a2 = last ? nA : cA + (size_t)(t + 2) * kstep; const char* b2 = last ? nB : cB + (size_t)(t + 2) * kstep;
            const char* a3 = a2 + kstep; const char* b3 = b2 + kstep;
            PG8_LDB(B0, 0, 0); PG8_LDB(B1, 0, 1); PG8_SCHED; PG8_LDA(At, 0, 0); PG8_STAGE(PG8_SA(1, 1), a1 + PG8_AH(1), ao2[NH - 1]);
            PG8_WAIT_V(8); PG8_WAIT_L(0); PG8_BAR; PG8_MMA(0, 0, At, B0); PG8_MMA(0, 1, At, B1); PG8_BAR; PG8_SCHED;
            if (last && has_next) { PG8_OFFS(arN, nK, ao2, bo2); hsA = (size_t)HALF * nK * 2; hsB = hsA; }
            PG8_LDA(At, 0, 1); PG8_STAGE(PG8_SB(0, 0), b2, bo2); PG8_STAGE(PG8_SB(0, 1), b2 + hsB, bo2); PG8_STAGE(PG8_SA(0, 0), a2, ao2[0]);
            PG8_WAIT_V(8); PG8_WAIT_L(0); PG8_BAR; PG8_MMA(1, 0, At, B0); PG8_MMA(1, 1, At, B1); PG8_BAR; PG8_SCHED;
            PG8_LDB(B0, 1, 0); PG8_LDB(B1, 1, 1); PG8_SCHED; PG8_LDA(At, 1, 0); PG8_STAGE(PG8_SA(0, 1), a2 + PG8_AH(1), ao2[NH - 1]);
            PG8_WAIT_V(8); PG8_WAIT_L(0); PG8_BAR; PG8_MMA(0, 0, At, B0); PG8_MMA(0, 1, At, B1); PG8_BAR; PG8_SCHED;
            PG8_LDA(At, 1, 1); PG8_STAGE(PG8_SB(1, 0), b3, bo2); PG8_STAGE(PG8_SB(1, 1), b3 + hsB, bo2); PG8_STAGE(PG8_SA(1, 0), a3, ao2[0]);
            PG8_WAIT_V(8); PG8_WAIT_L(0); PG8_BAR; PG8_MMA(1, 0, At, B0); PG8_MMA(1, 1, At, B1); PG8_BAR; PG8_SCHED;
        }
        if (wr == 0) PG8_BAR;
        E(acc, cur, wr, wc, fr, fq);
        if (!has_next) break;
        if (!(Epi::KEEP_ACC && E.keep(cur))) {
#pragma unroll
        for (int a = 0; a < 2; ++a)
#pragma unroll
            for (int b = 0; b < 2; ++b)
#pragma unroll
                for (int m = 0; m < 4; ++m)
#pragma unroll
                    for (int n = 0; n < 2; ++n) acc[a][b][m][n] = (f32x4){0.f, 0.f, 0.f, 0.f}; }
        cur = nxt; cA = nA; cB = nB; cK = nK; nt = cK / BK; ++ui;
        if (wr == 1) PG8_BAR;
    }
    PG8_WAIT_V(0);
    PG8_BAR;
#undef PG8_SA
#undef PG8_SB
#undef PG8_STAGE
#undef PG8_LDA
#undef PG8_LDB
#undef PG8_MMA
#undef PG8_WAIT_V
#undef PG8_WAIT_L
#undef PG8_BAR
#undef PG8_SCHED
#undef PG8_OFFS
#undef PG8_ROWS
#undef PG8_AH
}
}
namespace pg8 {
struct EpiGate3 {
    static constexpr bool PERM = true, AFTER_DRAIN = false, KEEP_ACC = true;
    bf16_t* Mg; const unsigned char* G;
    __device__ __forceinline__ bool keep(const Unit& u) const { return (u.pn >> 8) < 2; }
    typedef unsigned u32x2e __attribute__((ext_vector_type(2)));
    static __device__ __forceinline__ f32x4 ub4(unsigned w) { return (f32x4){(float)(w & 0xffu), (float)((w >> 8) & 0xffu), (float)((w >> 16) & 0xffu), (float)(w >> 24)}; }
    static __device__ __forceinline__ f32x4 rcp4(const f32x4& v) { return (f32x4){__builtin_amdgcn_rcpf(v[0]), __builtin_amdgcn_rcpf(v[1]), __builtin_amdgcn_rcpf(v[2]), __builtin_amdgcn_rcpf(v[3])}; }
    __device__ __forceinline__ void operator()(f32x4 (&acc)[2][2][4][2], const Unit& u, int wr, int wc, int fr, int fq) const {
        const int sub = u.pn >> 8; const int row0 = u.pm * BM + wr * 64 + fr, col0 = (u.pn & 255) * BM + wc * 32 + 8 * fq;
        if (sub < 2) {
            u32x2e ga[2][4][2], gb[2][4][2];
#pragma unroll
            for (int ai = 0; ai < 2; ++ai)
#pragma unroll
                for (int m = 0; m < 4; ++m) { const size_t row = (size_t)(row0 + ai * HALF + m * 16);
#pragma unroll
                    for (int bj = 0; bj < 2; ++bj) { const int col = col0 + bj * HALF;
                        ga[ai][m][bj] = *(const u32x2e*)(G + row * 3072 + sub * 1024 + col); gb[ai][m][bj] = *(const u32x2e*)(G + row * 3072 + (sub + 1) * 1024 + col); } }
            __builtin_amdgcn_sched_barrier(0);
#pragma unroll
            for (int ai = 0; ai < 2; ++ai)
#pragma unroll
                for (int m = 0; m < 4; ++m)
#pragma unroll
                    for (int bj = 0; bj < 2; ++bj) {
                        acc[ai][bj][m][0] = acc[ai][bj][m][0] * (ub4(ga[ai][m][bj].x) * rcp4(ub4(gb[ai][m][bj].x))); acc[ai][bj][m][1] = acc[ai][bj][m][1] * (ub4(ga[ai][m][bj].y) * rcp4(ub4(gb[ai][m][bj].y))); }
        } else {
            u32x2e gv[2][4][2];
#pragma unroll
            for (int ai = 0; ai < 2; ++ai)
#pragma unroll
                for (int m = 0; m < 4; ++m) { const size_t row = (size_t)(row0 + ai * HALF + m * 16);
#pragma unroll
                    for (int bj = 0; bj < 2; ++bj) gv[ai][m][bj] = *(const u32x2e*)(G + row * 3072 + 2048 + col0 + bj * HALF); }
            __builtin_amdgcn_sched_barrier(0);
#pragma unroll
            for (int ai = 0; ai < 2; ++ai)
#pragma unroll
                for (int m = 0; m < 4; ++m) { const size_t row = (size_t)(row0 + ai * HALF + m * 16);
#pragma unroll
                    for (int bj = 0; bj < 2; ++bj) { const int col = col0 + bj * HALF;
                        *(u32x4*)(Mg + row * 1024 + col) = pack8(acc[ai][bj][m][0] * (ub4(gv[ai][m][bj].x) * (1.0f / 255.0f)), acc[ai][bj][m][1] * (ub4(gv[ai][m][bj].y) * (1.0f / 255.0f))); } }
        }
    }
};
struct MoeGatherOrder {
    static constexpr bool GATHER = true;
    int ntiles, vcu, G; const PG8_LAS int* tile_e; const PG8_LAS int* tile_r; const int* rowinfo; const char* Xp; const char* W;
    __device__ __forceinline__ bool next(int i, Unit& u) const {
        const int L = i * G + vcu; if (L >= ntiles * 4) return false;
        u.pm = L >> 2; u.pn = __builtin_amdgcn_readfirstlane(tile_e[L >> 2]) * 4 + (L & 3); return true; }
    __device__ __forceinline__ void desc(const Unit& u, const char*& Ab, const char*& Bb, int& K) const { K = 512; Ab = Xp; Bb = W + (size_t)u.pn * 256 * 1024; }
    __device__ __forceinline__ int arow(const Unit& u, int r) const { const int info = rowinfo[2 * (__builtin_amdgcn_readfirstlane(tile_r[u.pm]) + r)]; return info < 0 ? 0 : (info >> 1); }
};
struct MoeDownOrder {
    static constexpr bool GATHER = false;
    int ntiles, vcu, G; const PG8_LAS int* tile_e; const char* Hp; const char* W;
    __device__ __forceinline__ bool next(int i, Unit& u) const {
        const int L = i * G + vcu; if (L >= ntiles * 4) return false;
        u.pm = L >> 2; u.pn = __builtin_amdgcn_readfirstlane(tile_e[L >> 2]) * 4 + (L & 3); return true; }
    __device__ __forceinline__ void desc(const Unit& u, const char*& Ab, const char*& Bb, int& K) const { K = 256; Ab = Hp + (size_t)u.pm * 256 * 512; Bb = W + (size_t)u.pn * 256 * 512; }
    __device__ __forceinline__ int arow(const Unit&, int r) const { return r; }
};
__device__ __forceinline__ unsigned pk4_fp8(float a, float b, float c, float d) { int w = 0; w = __builtin_amdgcn_cvt_pk_fp8_f32(a, b, w, false); w = __builtin_amdgcn_cvt_pk_fp8_f32(c, d, w, true); return (unsigned)w; }
constexpr float F8_WSCALE = 64.0f, F8_HSCALE = 8.0f;
struct EpiSwiglu8 {
    static constexpr bool PERM = true, AFTER_DRAIN = false, KEEP_ACC = false;
    unsigned char* H;
    __device__ __forceinline__ bool keep(const Unit&) const { return false; }
    __device__ __forceinline__ void operator()(const f32x4 (&acc)[2][2][4][2], const Unit& u, int wr, int wc, int fr, int fq) const {
        typedef unsigned u32x2e __attribute__((ext_vector_type(2)));
        const int row0 = u.pm * BM + wr * 64 + fr; unsigned char* base = H + (u.pn & 3) * 128 + wc * 32 + 8 * fq;
        constexpr float ds = 1.0f / F8_WSCALE;
#pragma unroll
        for (int ai = 0; ai < 2; ++ai)
#pragma unroll
            for (int m = 0; m < 4; ++m) { unsigned char* rp = base + (size_t)(row0 + ai * HALF + m * 16) * 512;
                const f32x4 g0 = acc[ai][0][m][0] * ds, g1 = acc[ai][0][m][1] * ds;
                const f32x4 h0 = g0 * sigmoid4(g0) * acc[ai][1][m][0] * (ds * F8_HSCALE), h1 = g1 * sigmoid4(g1) * acc[ai][1][m][1] * (ds * F8_HSCALE);
                u32x2e w; w.x = pk4_fp8(h0[0], h0[1], h0[2], h0[3]); w.y = pk4_fp8(h1[0], h1[1], h1[2], h1[3]); *(u32x2e*)rp = w; }
    }
};
struct EpiScatter8 {
    static constexpr bool PERM = true, AFTER_DRAIN = false, KEEP_ACC = false;
    bf16_t* Yc; const int* rowinfo; const PG8_LAS int* tile_r;
    __device__ __forceinline__ bool keep(const Unit&) const { return false; }
    __device__ __forceinline__ void operator()(const f32x4 (&acc)[2][2][4][2], const Unit& u, int wr, int wc, int fr, int fq) const {
        const int row0 = __builtin_amdgcn_readfirstlane(tile_r[u.pm]) + wr * 64 + fr, col0 = (u.pn & 3) * BM + wc * 32 + 8 * fq;
        int info[8]; float w[8];
#pragma unroll
        for (int it = 0; it < 8; ++it) { const int row = row0 + (it >> 2) * HALF + (it & 3) * 16; typedef int v2ie __attribute__((ext_vector_type(2))); const v2ie e_ = ((const v2ie*)rowinfo)[row]; info[it] = e_.x; w[it] = __int_as_float(e_.y) * (1.0f / (F8_WSCALE * F8_HSCALE)); }
        __builtin_amdgcn_sched_barrier(0);
#pragma unroll
        for (int it = 0; it < 8; ++it) { const int ai = it >> 2, m = it & 3;
            if (info[it] >= 0) { bf16_t* rp = Yc + (size_t)info[it] * 1024 + col0;
#pragma unroll
                for (int bj = 0; bj < 2; ++bj) *(u32x4*)(rp + bj * HALF) = pack8(acc[ai][bj][m][0] * w[it], acc[ai][bj][m][1] * w[it]); } }
    }
};
struct GateOrder {
    static constexpr bool GATHER = false;
    StaticOrder so; const char* X8; const char* W8;
    __device__ __forceinline__ bool next(int i, Unit& u) const { return so.next(i, u); }
    __device__ __forceinline__ void desc(const Unit& u, const char*& Ab, const char*& Bb, int& K) const { K = 512; Ab = X8 + (size_t)u.pm * 256 * 1024; Bb = W8 + (size_t)u.pn * 256 * 1024; }
    __device__ __forceinline__ int arow(const Unit&, int r) const { return r; }
};
struct EpiGates8 {
    static constexpr bool PERM = true, AFTER_DRAIN = false, KEEP_ACC = false;
    unsigned char* G;
    __device__ __forceinline__ bool keep(const Unit&) const { return false; }
    __device__ __forceinline__ void operator()(const f32x4 (&acc)[2][2][4][2], const Unit& u, int wr, int wc, int fr, int fq) const {
        typedef unsigned u32x2e __attribute__((ext_vector_type(2)));
        const int row0 = u.pm * BM + wr * 64 + fr; unsigned char* base = G + u.pn * 256 + wc * 32 + 8 * fq;
#pragma unroll
        for (int ai = 0; ai < 2; ++ai)
#pragma unroll
            for (int m = 0; m < 4; ++m) { unsigned char* rp = base + (size_t)(row0 + ai * HALF + m * 16) * 3072;
#pragma unroll
                for (int bj = 0; bj < 2; ++bj) { const f32x4 g0 = sigmoid4(acc[ai][bj][m][0] * (1.0f / 32.0f)) * 255.0f + 0.5f, g1 = sigmoid4(acc[ai][bj][m][1] * (1.0f / 32.0f)) * 255.0f + 0.5f;
                    unsigned q[8];
#pragma unroll
                    for (int i = 0; i < 4; ++i) { const unsigned a = (unsigned)g0[i], b = (unsigned)g1[i]; q[i] = a < 1u ? 1u : a; q[4 + i] = b < 1u ? 1u : b; }
                    u32x2e w; w.x = q[0] | (q[1] << 8) | (q[2] << 16) | (q[3] << 24); w.y = q[4] | (q[5] << 8) | (q[6] << 16) | (q[7] << 24);
                    *(u32x2e*)(rp + bj * HALF) = w; } }
    }
};
}
#define GAS __attribute__((address_space(1)))
#define LAS __attribute__((address_space(3)))
typedef unsigned short bf16;
typedef unsigned v4u __attribute__((ext_vector_type(4)));
typedef float f32x4 __attribute__((ext_vector_type(4)));
typedef short bf16x8 __attribute__((ext_vector_type(8)));
typedef GAS unsigned gu32;
typedef GAS unsigned long long gu64;
#define RLX_AGENT __ATOMIC_RELAXED, __HIP_MEMORY_SCOPE_AGENT
#define LDS_WAIT() asm volatile("s_waitcnt lgkmcnt(0)" ::: "memory")
#define VM_WAIT() asm volatile("s_waitcnt vmcnt(0)" ::: "memory")
__device__ __forceinline__ unsigned long long rt() { return __builtin_amdgcn_s_memrealtime(); }
__device__ __forceinline__ unsigned f2bf(float f) { unsigned u = __builtin_bit_cast(unsigned, f); return (u + 0x7fffu + ((u >> 16) & 1u)) >> 16; }
__device__ __forceinline__ unsigned pk2(float lo, float hi) { return f2bf(lo) | (f2bf(hi) << 16); }

#define XB_TMO      128
#define XB_XCNT(j)  (256  + 64 * (j))
#define XB_XSUB(j)  (1280 + 64 * (j))
#define XB_XGEN(j)  (2304 + 64 * (j))
#define XB_TOP      3328
#define XB_TOPGEN   3392
#define XCD_BAR_WORDS 3456
#define XB_SPIN_CAP (1u << 18)

__device__ __forceinline__ unsigned xb_ld(unsigned* p)              { return __hip_atomic_load(p, __ATOMIC_RELAXED, __HIP_MEMORY_SCOPE_AGENT); }
__device__ __forceinline__ unsigned xb_add(unsigned* p, unsigned v) { return __hip_atomic_fetch_add(p, v, __ATOMIC_RELAXED, __HIP_MEMORY_SCOPE_AGENT); }
__device__ __forceinline__ unsigned xb_xcc_id() { return (unsigned)__builtin_amdgcn_s_getreg((3 << 11) | 20) & 0xFu; }
#define XB_SPIN(cond, bar) do { unsigned _sp = 0; while (cond) { __builtin_amdgcn_s_sleep(1); \
    if ((++_sp & 255u) == 0u) { if (xb_ld(&(bar)[XB_TMO])) break; if (_sp > XB_SPIN_CAP) { atomicAdd(&(bar)[XB_TMO], 1u); break; } } } } while (0)

struct XcdBarrier {
    int wave;
    unsigned* bar; unsigned x;
    volatile LAS unsigned* st;
};

__device__ __forceinline__ XcdBarrier xcd_barrier_post(unsigned* bar, volatile LAS unsigned* st) {
    XcdBarrier b; b.wave = 0; b.bar = bar; b.x = xb_xcc_id(); b.st = st;
    if (threadIdx.x == 0) (void)xb_add(&bar[XB_XCNT(b.x)], 1u);
    return b;
}
__device__ __forceinline__ void xcd_barrier_complete(unsigned* bar, unsigned x, unsigned& nloc, unsigned& nx) {
    const unsigned G = gridDim.x * gridDim.y * gridDim.z;
    unsigned sum, cnt, mine, sp = 0u;
    for (;;) {
        sum = 0u; cnt = 0u; mine = 0u;
#pragma unroll
        for (unsigned j = 0; j < 16; ++j) { const unsigned c = xb_ld(&bar[XB_XCNT(j)]); sum += c; cnt += (c > 0u) ? 1u : 0u; mine = (j == x) ? c : mine; }
        if (sum == G) break;
        __builtin_amdgcn_s_sleep(1);
        if ((++sp & 255u) == 0u) { if (xb_ld(&bar[XB_TMO])) break; if (sp > XB_SPIN_CAP) { atomicAdd(&bar[XB_TMO], 1u); break; } }
    }
    nloc = mine > 0u ? mine : 1u; nx = cnt > 0u ? cnt : 1u;
}

__device__ __forceinline__ void xcd_barrier(const XcdBarrier& b) {
    asm volatile("s_waitcnt vmcnt(0)" ::: "memory");
    __syncthreads();
    if (b.wave == 0 && pg8::lane_id_v() == 0) {
        GAS unsigned* gbar_ = (GAS unsigned*)b.bar; unsigned bx_ = b.x; asm volatile("" : "+s"(bx_), "+s"(gbar_)); unsigned* bar = (unsigned*)gbar_;
        __builtin_amdgcn_s_waitcnt(0);
        unsigned nloc = b.st[0], nx = b.st[1];
        if (nloc == 0u) { xcd_barrier_complete(bar, bx_, nloc, nx); b.st[0] = nloc; b.st[1] = nx; }
        const unsigned old = xb_add(&bar[XB_XSUB(bx_)], 1u);
        const unsigned gen = old / nloc;
        if (old + 1u == (gen + 1u) * nloc) {
            __builtin_amdgcn_fence(__ATOMIC_RELEASE, "agent");
            asm volatile("s_waitcnt vmcnt(0)" ::: "memory");
            const unsigned og = xb_add(&bar[XB_TOP], 1u);
            const unsigned tg = og / nx;
            if (og + 1u == (tg + 1u) * nx) xb_add(&bar[XB_TOPGEN], 1u);
            else XB_SPIN(xb_ld(&bar[XB_TOPGEN]) == tg, bar);
            __builtin_amdgcn_fence(__ATOMIC_ACQUIRE, "agent");
            xb_add(&bar[XB_XGEN(bx_)], 1u);
            asm volatile("s_waitcnt vmcnt(0)" ::: "memory");
        } else {
            XB_SPIN(xb_ld(&bar[XB_XGEN(bx_)]) == gen, bar);
            __builtin_amdgcn_fence(__ATOMIC_ACQUIRE, "agent");
            asm volatile("s_waitcnt vmcnt(0)" ::: "memory");
        }
    }
    __syncthreads();
}
#ifndef MK_FUSEC
#define MK_FUSEC 1
#endif
constexpr int NWAVES = 8;
constexpr int NB = 4, SEQ = 8192, T = NB * SEQ, D = 1024, DEPTH = 2;
constexpr int NCHUNK = 2, TC = T / NCHUNK, BPC = NB / NCHUNK;
constexpr int INC = 8192;
constexpr int MEML = 256, MH = 4, MHD = 128;
constexpr int NE = 16, FF = 512;
constexpr int XG_ROWS = 2 * T + NE * 256;
constexpr int MAXTILES = XG_ROWS / 256;
constexpr float LN_EPS = 1e-5f, RMS_EPS = 1e-5f;
constexpr float ALPHA = 1.4142135623730951f;
constexpr int GRID = 256;

constexpr size_t MiB = 1u << 20;
constexpr size_t WS_CTL = 0, CTL_ZERO_BYTES = 1 * MiB;
constexpr size_t WS_WRH = 1 * MiB, WS_WRL = WS_WRH + 32768;
constexpr size_t WS_XCH = 1 * MiB + 512 * 1024;
constexpr size_t WS_WKV = 2 * MiB;
constexpr size_t WS_MEMB = 6 * MiB;
constexpr size_t WS_MEMKV = 8 * MiB;
constexpr size_t WS_COS = 12 * MiB, WS_SIN = 16 * MiB;
constexpr size_t WS_TOKPOS = 20 * MiB;
constexpr size_t WS_TOKW = WS_TOKPOS + 256 * 1024;
constexpr int CAP = T;
constexpr size_t WS_ROWINFO = 508 * MiB;
constexpr size_t WS_W = 22 * MiB;
constexpr size_t WS_WIN = WS_W, WS_WA = WS_WIN + 16 * MiB, WS_WC = WS_WA + 2 * MiB, WS_WM = WS_WC + 1 * MiB, WS_WO = WS_WM + 1 * MiB, WS_WGU = WS_WO + 2 * MiB, WS_WD = WS_WGU + 32 * MiB;
constexpr size_t WS_XB = 92 * MiB;
static_assert(WS_WD + 16 * MiB == WS_XB, "weights end at xb");
constexpr size_t WS_AREA = 156 * MiB;
constexpr size_t WS_Q = WS_AREA, WS_K = WS_Q + 32 * MiB, WS_V = WS_K + 32 * MiB, WS_CB = WS_V + 32 * MiB, WS_Z = WS_CB + 16 * MiB, WS_QM = WS_Z + 16 * MiB, WS_G = WS_QM + 16 * MiB,
                 WS_O1 = WS_G + 96 * MiB, WS_O2 = WS_O1 + 32 * MiB, WS_CH_END = WS_O2 + 32 * MiB;
constexpr size_t WS_YATT = MK_FUSEC ? WS_O1 : WS_Q, WS_MERGED = WS_K, WS_MIX = WS_V;
constexpr size_t WS_MERGED0 = WS_CH_END;
constexpr size_t WS_MIXALL = WS_O1;
static_assert(WS_MERGED0 + (size_t)TC * 1024 * 2 <= 512 * MiB && WS_O2 == WS_O1 + 32 * MiB, "merged0 / mixall");
constexpr size_t WS_XB8 = WS_AREA;
constexpr size_t WS_XG = WS_AREA, WS_H = WS_XG + (size_t)XG_ROWS * 1024 * 2, WS_YC = 380 * MiB, WS_MOE_END = WS_YC + (size_t)2 * T * 1024 * 2;
constexpr size_t WS_XBIN8 = WS_G + 48 * MiB;
constexpr size_t WS_WING8 = WS_WGU + 16 * MiB;
static_assert(WS_XBIN8 + (size_t)T * 1024 <= WS_O1 && WS_XBIN8 + (size_t)T * 1024 <= WS_YC && WS_H + (size_t)XG_ROWS * 512 <= WS_XBIN8 && WS_WING8 + 3 * MiB <= WS_WD, "fp8 buffers");
constexpr size_t WS_END = 512 * MiB;
static_assert(WS_CH_END <= WS_END && WS_MOE_END <= WS_ROWINFO && WS_MERGED0 + (size_t)TC * 1024 * 2 <= WS_ROWINFO && WS_ROWINFO + (size_t)NE * CAP * 8 <= WS_END, "d_ws map");
static_assert(pg8::P1_COS == WS_COS && pg8::P1_SIN == WS_SIN && pg8::P1_Q == WS_Q && pg8::P1_K == WS_K && pg8::P1_V == WS_V && pg8::P1_CB == WS_CB && pg8::P1_Z == WS_Z && pg8::P1_QM == WS_QM && pg8::P1_G == WS_G, "EpiP1 offsets");
constexpr int CW_TMO = 0, CW_CODE = 1, CW_FAIL = 2;
constexpr int CW_BAR = 4096;
constexpr int CW_SEAM = 32768, SEAM_BANK = 64 * 64;
constexpr int CW_CNT = 16384;

namespace pg8 {
struct BranchOrder {
    static constexpr bool GATHER = false;
    StaticOrder so; const char* ws;
    __device__ __forceinline__ bool next(int i, Unit& u) const { if (i >= 3) return false; Unit v; if (!so.next(0, v)) return false; u.pm = v.pm; u.pn = v.pn | (i << 8); return true; }
    __device__ __forceinline__ void desc(const Unit& u, const char*& Ab, const char*& Bb, int& K) const {
        const int sub = u.pn >> 8, pn = u.pn & 255; K = sub == 0 ? 1024 : 512;
        const size_t ao = sub == 0 ? WS_YATT : (sub == 1 ? WS_CB : WS_QM), bo = sub == 0 ? WS_WA : (sub == 1 ? WS_WC : WS_WM);
        Ab = ws + ao + (size_t)u.pm * 256 * K * 2; Bb = ws + bo + (size_t)pn * 256 * K * 2; }
    __device__ __forceinline__ int arow(const Unit&, int r) const { return r; }
};
struct OutOrder {
    static constexpr bool GATHER = false;
    StaticOrder so; const char* ws;
    __device__ __forceinline__ bool next(int i, Unit& u) const { return so.next(i, u); }
    __device__ __forceinline__ void desc(const Unit& u, const char*& Ab, const char*& Bb, int& K) const { K = 1024;
        Ab = (u.pm < TC / 256) ? ws + WS_MERGED0 + (size_t)u.pm * 256 * 2048 : ws + WS_MERGED + (size_t)(u.pm - TC / 256) * 256 * 2048; Bb = ws + WS_WO + (size_t)u.pn * 256 * 2048; }
    __device__ __forceinline__ int arow(const Unit&, int r) const { return r; }
};
struct EpiMixAll {
    static constexpr bool PERM = true, AFTER_DRAIN = false, KEEP_ACC = false;
    bf16_t* O;
    __device__ __forceinline__ bool keep(const Unit&) const { return false; }
    __device__ __forceinline__ void operator()(const f32x4 (&acc)[2][2][4][2], const Unit& u, int wr, int wc, int fr, int fq) const {
        const int row0 = u.pm * BM + wr * 64 + fr; bf16_t* base = O + u.pn * BM + wc * 32 + 8 * fq;
#pragma unroll
        for (int ai = 0; ai < 2; ++ai)
#pragma unroll
            for (int m = 0; m < 4; ++m) { bf16_t* rp = base + (size_t)(row0 + ai * HALF + m * 16) * 1024;
#pragma unroll
                for (int bj = 0; bj < 2; ++bj) *(u32x4*)(rp + bj * HALF) = pack8(acc[ai][bj][m][0], acc[ai][bj][m][1]); }
    }
};
}
constexpr int RING_OFF = 0, RING_BYTES = 143360;
constexpr int LDSCTL_OFF = RING_BYTES, MISC_OFF = LDSCTL_OFF + 320, TILEE_OFF = LDSCTL_OFF + 1024, TILER_OFF = LDSCTL_OFF + 2304;
constexpr int LDS_BYTES = 147456;
static_assert(TILEE_OFF + MAXTILES * 4 + 256 <= LDS_BYTES, "LDS map");

struct Frame {
    LAS unsigned char* lds;
    unsigned char* ws;
    int wave, vcu;
};
__device__ __forceinline__ int lane_id() { return pg8::lane_id_v(); }
#define F_LANE lane_id()
#define F_TID (F.wave * 64 + lane_id())
#define F_G GRID
#define F_BX ((F.vcu & 31) * 8 + (F.vcu >> 5))
#define F_CTL ((gu32*)(F.ws + WS_CTL))
#define F_MISC ((volatile LAS unsigned*)(F.lds + MISC_OFF))
__device__ __forceinline__ float wave_sum(float v) {
    v += pg8::shx<1>(v); v += pg8::shx<2>(v); v += pg8::shx<4>(v); v += pg8::shx<8>(v); v += pg8::shx<16>(v); v += pg8::shx<32>(v);
    return v;
}
__device__ __forceinline__ f32x4 f8x4(unsigned w) {
    typedef float f32x2v __attribute__((ext_vector_type(2)));
    const f32x2v lo = __builtin_amdgcn_cvt_pk_f32_fp8((int)w, false), hi = __builtin_amdgcn_cvt_pk_f32_fp8((int)w, true); return (f32x4){lo.x, lo.y, hi.x, hi.y}; }
__device__ __forceinline__ float bfl(unsigned w) { return __uint_as_float(w << 16); }
__device__ __forceinline__ float bfh(unsigned w) { return __uint_as_float(w & 0xffff0000u); }

__device__ __forceinline__ void transpose_item(const float* W, int ldw, int k0, int nsrc, bf16* WT, int ldk, int ndst, LAS float* scr, int lane) {
    {
        f32x4 v[8]; const int kr = lane >> 3, nq = 4 * (lane & 7);
#pragma unroll
        for (int i = 0; i < 8; ++i) v[i] = *(const GAS f32x4*)(W + (size_t)(k0 + 8 * i + kr) * ldw + nsrc + nq);
#pragma unroll
        for (int i = 0; i < 8; ++i) { LAS float* d = scr + (8 * i + kr) * 33 + nq; d[0] = v[i].x; d[1] = v[i].y; d[2] = v[i].z; d[3] = v[i].w; }
    }
    LDS_WAIT(); asm volatile("" ::: "memory");
    const int c = lane & 7;
#pragma unroll
    for (int j = 0; j < 4; ++j) { const int n = (lane >> 3) + 8 * j; const LAS float* s = scr + (8 * c) * 33 + n;
        v4u o; o.x = pk2(s[0 * 33], s[1 * 33]); o.y = pk2(s[2 * 33], s[3 * 33]); o.z = pk2(s[4 * 33], s[5 * 33]); o.w = pk2(s[6 * 33], s[7 * 33]);
        *(GAS v4u*)(WT + (size_t)(ndst + n) * ldk + k0 + 8 * c) = o; }
    LDS_WAIT(); asm volatile("" ::: "memory");
}
__device__ __forceinline__ void transpose_item8(const float* W, int ldw, int k0, int nsrc, unsigned char* WT, int ldk, int ndst, float scale, LAS float* scr, int lane) {
    {   f32x4 v[8]; const int kr = lane >> 3, nq = 4 * (lane & 7);
#pragma unroll
        for (int i = 0; i < 8; ++i) v[i] = *(const GAS f32x4*)(W + (size_t)(k0 + 8 * i + kr) * ldw + nsrc + nq);
#pragma unroll
        for (int i = 0; i < 8; ++i) { LAS float* d = scr + (8 * i + kr) * 33 + nq; d[0] = v[i].x; d[1] = v[i].y; d[2] = v[i].z; d[3] = v[i].w; }
    }
    LDS_WAIT(); asm volatile("" ::: "memory");
    const int c = lane & 3;
#pragma unroll
    for (int j = 0; j < 2; ++j) { const int n = (lane >> 2) + 16 * j; const LAS float* q = scr + (16 * c) * 33 + n;
        v4u o; o.x = pg8::pk4_fp8(q[0 * 33] * scale, q[1 * 33] * scale, q[2 * 33] * scale, q[3 * 33] * scale); o.y = pg8::pk4_fp8(q[4 * 33] * scale, q[5 * 33] * scale, q[6 * 33] * scale, q[7 * 33] * scale);
        o.z = pg8::pk4_fp8(q[8 * 33] * scale, q[9 * 33] * scale, q[10 * 33] * scale, q[11 * 33] * scale); o.w = pg8::pk4_fp8(q[12 * 33] * scale, q[13 * 33] * scale, q[14 * 33] * scale, q[15 * 33] * scale);
        *(GAS v4u*)(WT + (size_t)(ndst + n) * ldk + k0 + 16 * c) = o; }
    LDS_WAIT(); asm volatile("" ::: "memory");
}
struct Args { const void* in[24]; float* out; unsigned char* ws; int ph_lo, ph_hi; };
static_assert(sizeof(Args) == 24 * 8 + 8 + 8 + 8, "no padding in Args");
__device__ __forceinline__ const void* lptr(const void* p) { const GAS unsigned char* g = (const GAS unsigned char*)p; asm volatile("" : "+s"(g)); return (const void*)g; }
__device__ __forceinline__ unsigned char* lws(unsigned char* p) { GAS unsigned char* g = (GAS unsigned char*)p; asm volatile("" : "+s"(g)); return (unsigned char*)g; }
#define INF(k) ((const float*)lptr(A.in[k]))
#define INI(k) ((const int*)lptr(A.in[k]))

__device__ __forceinline__ void convert_layer_weights(Frame& F, const Args& A, int l) {
    LAS float* scr = (LAS float*)(F.lds + RING_OFF + F.wave * 16384);
    const int gw = F.vcu * NWAVES + F.wave, NGW = F_G * NWAVES;
    unsigned char* const ws = lws(F.ws);
    bf16* Win_t = (bf16*)(ws + WS_WIN); bf16* Wa_t = (bf16*)(ws + WS_WA); bf16* Wc_t = (bf16*)(ws + WS_WC); bf16* Wm_t = (bf16*)(ws + WS_WM);
    bf16* Wo_t = (bf16*)(ws + WS_WO); bf16* Wgu_t = (bf16*)(ws + WS_WGU); bf16* Wd_t = (bf16*)(ws + WS_WD);
    const float* w_in = INF(3) + (size_t)l * D * INC;
    constexpr int I_IN = 16 * 256, I_A = 16 * 32, I_C = 8 * 32, I_O = 16 * 32, I_GU = NE * 16 * 32, I_D = NE * 8 * 32;
    constexpr int NITEMS = I_IN + I_A + 2 * I_C + I_O + I_GU + I_D;
    for (int it = gw; it < NITEMS; it += NGW) {
        int r = it;
        if (r < I_IN) { const int kb = r >> 8, n0 = (r & 255) * 32, pn = n0 >> 8, p = n0 & 255; int src;
            if (pn < 8) src = 256 * pn + 64 * ((p >> 5) & 3) + 32 * (p >> 7);
            else if (pn >= 14 && pn < 18) src = (p < 128 ? 3584 : 4096) + 128 * (pn - 14) + (p & 127);
            else src = n0;
            if (pn >= 20) transpose_item8(w_in, INC, kb * 64, src, (unsigned char*)(ws + WS_WING8), 1024, n0 - 5120, 32.0f, scr, F_LANE);
            else transpose_item(w_in, INC, kb * 64, src, Win_t, 1024, n0, scr, F_LANE);
            continue; }
        r -= I_IN;
        if (r < I_A) { transpose_item(INF(11) + (size_t)l * 1024 * 1024, 1024, (r >> 5) * 64, (r & 31) * 32, Wa_t, 1024, (r & 31) * 32, scr, F_LANE); continue; }
        r -= I_A;
        if (r < I_C) { transpose_item(INF(12) + (size_t)l * 512 * 1024, 1024, (r >> 5) * 64, (r & 31) * 32, Wc_t, 512, (r & 31) * 32, scr, F_LANE); continue; }
        r -= I_C;
        if (r < I_C) { transpose_item(INF(13) + (size_t)l * 512 * 1024, 1024, (r >> 5) * 64, (r & 31) * 32, Wm_t, 512, (r & 31) * 32, scr, F_LANE); continue; }
        r -= I_C;
        if (r < I_O) { transpose_item(INF(14) + (size_t)l * 1024 * 1024, 1024, (r >> 5) * 64, (r & 31) * 32, Wo_t, 1024, (r & 31) * 32, scr, F_LANE); continue; }
        r -= I_O;
        if (r < I_GU) { const int e = r >> 9, q = r & 511, kb = q >> 5, n0 = (q & 31) * 32, pnl = n0 >> 8, p = n0 & 255;
            const float* src = (p < 128 ? INF(21) : INF(22)) + (size_t)(l * NE + e) * 1024 * 512;
            transpose_item8(src, 512, kb * 64, 128 * pnl + (p & 127), (unsigned char*)Wgu_t + (size_t)e * 1024 * 1024, 1024, n0, pg8::F8_WSCALE, scr, F_LANE); continue; }
        r -= I_GU;
        { const int e = r >> 8, q = r & 255; transpose_item8(INF(23) + (size_t)(l * NE + e) * 512 * 1024, 1024, (q >> 5) * 64, (q & 31) * 32, (unsigned char*)Wd_t + (size_t)e * 1024 * 512, 512, (q & 31) * 32, pg8::F8_WSCALE, scr, F_LANE); }
    }
}

__device__ __forceinline__ void row_to_bf16(const float* xrow, bf16* orow, int lane) {
    const GAS f32x4* xr = (const GAS f32x4*)xrow + lane; GAS unsigned long long* o8 = (GAS unsigned long long*)orow + lane;
#pragma unroll
    for (int j = 0; j < 4; ++j) { const f32x4 v = xr[64 * j]; o8[64 * j] = (unsigned long long)pk2(v.x, v.y) | ((unsigned long long)pk2(v.z, v.w) << 32); }
}

__device__ __forceinline__ void p0_prologue(Frame& F, const Args& A) {
    const int gw = F.vcu * NWAVES + F.wave, NGW = F_G * NWAVES;
    unsigned char* const ws = lws(F.ws);
    convert_layer_weights(F, A, 0);
    {
        LAS float* scr = (LAS float*)(F.lds + RING_OFF + F.wave * 16384); bf16* Wkv_t = (bf16*)(ws + WS_WKV);
        for (int it = gw; it < 2 * 512; it += NGW) { const int l = it >> 9, r = it & 511;
            transpose_item(INF(10) + (size_t)l * 1024 * 1024, 1024, (r >> 5) * 64, (r & 31) * 32, Wkv_t + (size_t)l * 1024 * 1024, 1024, (r & 31) * 32, scr, F_LANE); }
    }
    bf16* XBp = (bf16*)(ws + WS_XB); bf16* MEMB = (bf16*)(ws + WS_MEMB);
    {
        const float* xsrc = INF(0); const int lane = F_LANE;
        for (int m0 = gw; m0 < T; m0 += 4 * NGW) {
            f32x4 v[4][4];
#pragma unroll
            for (int q = 0; q < 4; ++q) { const GAS f32x4* xr = (const GAS f32x4*)(xsrc + (size_t)(m0 + q * NGW) * D) + lane;
#pragma unroll
                for (int j = 0; j < 4; ++j) v[q][j] = xr[64 * j]; }
#pragma unroll
            for (int q = 0; q < 4; ++q) { GAS unsigned long long* o8 = (GAS unsigned long long*)(XBp + (size_t)(m0 + q * NGW) * D) + lane; GAS unsigned* x8 = (GAS unsigned*)(ws + WS_XBIN8 + (size_t)(m0 + q * NGW) * D) + lane;
#pragma unroll
                for (int j = 0; j < 4; ++j) { o8[64 * j] = (unsigned long long)pk2(v[q][j].x, v[q][j].y) | ((unsigned long long)pk2(v[q][j].z, v[q][j].w) << 32); x8[64 * j] = pg8::pk4_fp8(v[q][j].x, v[q][j].y, v[q][j].z, v[q][j].w); } }
        }
    }
    for (int m = gw; m < NB * MEML; m += NGW) row_to_bf16(INF(1) + (size_t)m * D, MEMB + (size_t)m * D, F_LANE);
    {
        float* cosT = (float*)(ws + WS_COS); float* sinT = (float*)(ws + WS_SIN);
        const int gt = F.vcu * (NWAVES * 64) + F_TID, NGT = F_G * NWAVES * 64;
        for (int i = gt; i < T * 32; i += NGT) { const int t = i >> 5, d = i & 31;
            const float inv = (float)exp2(-(double)d * (13.287712379549449 / 32.0));
            const float ang = (float)INI(2)[t] * inv;
            const double a = (double)ang; const double n = rint(a * 0.15915494309189535); const float r = (float)(a - n * 6.283185307179586);
            cosT[i] = cosf(r); sinT[i] = sinf(r); }
        bf16* WRH = (bf16*)(ws + WS_WRH); bf16* WRL = (bf16*)(ws + WS_WRL);
        for (int i = gt; i < 32 * 64 * 8; i += NGT) { const int j = i & 7, L = (i >> 3) & 63, ks = i >> 9;
            const float w = INF(19)[(size_t)(32 * ks + 8 * (L >> 4) + j) * NE + (L & 15)]; const unsigned h = f2bf(w); const float rem = w - __uint_as_float(h << 16);
            WRH[i] = (bf16)h; WRL[i] = (bf16)f2bf(rem); }
    }
}

namespace memattn {
typedef short bf16x8 __attribute__((ext_vector_type(8)));
typedef short s16x4 __attribute__((ext_vector_type(4)));
typedef float f32x16 __attribute__((ext_vector_type(16)));
constexpr int KS_STRIDE = 272, VT_STRIDE = 528, LDS_VT = 256 * KS_STRIDE, LDS_TOTAL = LDS_VT + 128 * VT_STRIDE;
__device__ __forceinline__ void unit(int bglob, int blocal, int hm, int qblk, bf16* QM, const bf16* KV, int ldkv, LAS unsigned char* lds, int wave_id) {
    int tid_ = wave_id * 64 + pg8::lane_id_v(); asm volatile("" : "+v"(tid_)); const int tid = tid_, lane = tid & 63, r32 = lane & 31, hi = lane >> 5, wid = tid >> 6;
#pragma unroll
    for (int j = 0; j < 8; ++j) { const int id = tid + 512 * j, key = id >> 4, ch = id & 15;
        const v4u v = *(const v4u*)(KV + (size_t)(bglob * MEML + key) * ldkv + hm * MHD + ch * 8);
        *(LAS v4u*)(lds + key * KS_STRIDE + ch * 16) = v; }
#pragma unroll
    for (int j = 0; j < 8; ++j) { const int id = tid + 512 * j, key = id >> 4, ch = id & 15;
        const v4u v = *(const v4u*)(KV + (size_t)(bglob * MEML + key) * ldkv + 512 + hm * MHD + ch * 8);
        const unsigned w[4] = {v.x, v.y, v.z, v.w};
#pragma unroll
        for (int e = 0; e < 8; ++e) *(LAS unsigned short*)(lds + LDS_VT + (ch * 8 + e) * VT_STRIDE + key * 2) = (unsigned short)((w[e >> 1] >> (16 * (e & 1))) & 0xffffu); }
    bf16* qrow = QM + (size_t)(blocal * SEQ + qblk * 256 + wid * 32 + r32) * 512 + hm * MHD;
    bf16x8 qf[8];
#pragma unroll
    for (int ks = 0; ks < 8; ++ks) qf[ks] = *(const bf16x8*)(qrow + 16 * ks + 8 * hi);
    __syncthreads();
    f32x16 p[8];
#pragma unroll
    for (int kb = 0; kb < 8; ++kb) { p[kb] = (f32x16){};
#pragma unroll
        for (int ks = 0; ks < 8; ++ks) { const bf16x8 kf = *(const LAS bf16x8*)(lds + (32 * kb + r32) * KS_STRIDE + (16 * ks + 8 * hi) * 2);
            p[kb] = __builtin_amdgcn_mfma_f32_32x32x16_bf16(kf, qf[ks], p[kb], 0, 0, 0); }
        __builtin_amdgcn_sched_barrier(0); }
    float m = -INFINITY;
#pragma unroll
    for (int kb = 0; kb < 8; ++kb)
#pragma unroll
        for (int r = 0; r < 16; ++r) m = fmaxf(m, p[kb][r]);
    m = fmaxf(m, pg8::shx<32>(m));
    float l = 0.f;
#pragma unroll
    for (int kb = 0; kb < 8; ++kb)
#pragma unroll
        for (int r = 0; r < 16; ++r) { const float e = __builtin_amdgcn_exp2f(p[kb][r] - m); p[kb][r] = e; l += e; }
    l += pg8::shx<32>(l);
    bf16x8 pf[8][2];
#pragma unroll
    for (int kb = 0; kb < 8; ++kb)
#pragma unroll
        for (int s = 0; s < 2; ++s) { v4u w; w.x = pg8::cvt_pk_bf16(p[kb][8 * s + 0], p[kb][8 * s + 1]); w.y = pg8::cvt_pk_bf16(p[kb][8 * s + 2], p[kb][8 * s + 3]);
            w.z = pg8::cvt_pk_bf16(p[kb][8 * s + 4], p[kb][8 * s + 5]); w.w = pg8::cvt_pk_bf16(p[kb][8 * s + 6], p[kb][8 * s + 7]); pf[kb][s] = __builtin_bit_cast(bf16x8, w); }
    f32x16 o[4];
#pragma unroll
    for (int db = 0; db < 4; ++db) { o[db] = (f32x16){};
#pragma unroll
        for (int kb = 0; kb < 8; ++kb)
#pragma unroll
            for (int s = 0; s < 2; ++s) { const LAS unsigned char* vp = lds + LDS_VT + (32 * db + r32) * VT_STRIDE + (32 * kb + 16 * s + 4 * hi) * 2;
                const s16x4 a = *(const LAS s16x4*)vp, b = *(const LAS s16x4*)(vp + 16);
                const bf16x8 vf = (bf16x8){a[0], a[1], a[2], a[3], b[0], b[1], b[2], b[3]};
                o[db] = __builtin_amdgcn_mfma_f32_32x32x16_bf16(vf, pf[kb][s], o[db], 0, 0, 0); }
        __builtin_amdgcn_sched_barrier(0); }
    const float rl = 1.0f / l;
    int qb2 = qblk; asm volatile("" : "+s"(qb2));
    bf16* orow = QM + (size_t)(blocal * SEQ + qb2 * 256 + wid * 32 + r32) * 512 + hm * MHD;
#pragma unroll
    for (int db = 0; db < 4; ++db)
#pragma unroll
        for (int g = 0; g < 4; ++g) { const unsigned lo = pk2(o[db][4 * g] * rl, o[db][4 * g + 1] * rl), hi2 = pk2(o[db][4 * g + 2] * rl, o[db][4 * g + 3] * rl);
            *(unsigned long long*)(orow + 32 * db + 8 * g + 4 * hi) = (unsigned long long)lo | ((unsigned long long)hi2 << 32); }
    __syncthreads();
}
}

#define XB ((bf16*)(ws + WS_XB))
#define Qb ((bf16*)(ws + WS_Q))
#define Kb ((bf16*)(ws + WS_K))
#define Vb ((bf16*)(ws + WS_V))
#define CBb ((bf16*)(ws + WS_CB))
#define Zb ((bf16*)(ws + WS_Z))
#define QMb ((bf16*)(ws + WS_QM))
#define Gb ((bf16*)(ws + WS_G))
#define O1b ((bf16*)(ws + WS_O1))
#define O2b ((bf16*)(ws + WS_O2))
#define YATT ((bf16*)(ws + WS_YATT))
#define MERGED ((bf16*)(ws + WS_MERGED))
#define MIX ((bf16*)(ws + WS_MIX))
#define XG ((bf16*)(ws + WS_XG))
#define Hb ((bf16*)(ws + WS_H))
#define YC ((bf16*)(ws + WS_YC))
#define TOKPOS ((unsigned*)(ws + WS_TOKPOS))
#define TOKW ((float*)(ws + WS_TOKW))
#define ROWINFO ((int*)(ws + WS_ROWINFO))
typedef int v2i __attribute__((ext_vector_type(2)));
#define MEMKV ((const bf16*)(ws + WS_MEMKV))
__global__ void __launch_bounds__(NWAVES * 64, 2) mega_fwd(Args A) {
    extern __shared__ __attribute__((aligned(16))) unsigned char lds[];
    Frame F;
    F.lds = (LAS unsigned char*)lds;
    F.wave = __builtin_amdgcn_readfirstlane((int)threadIdx.x >> 6);
    { const int bx = blockIdx.x; F.vcu = (bx % 8) * (GRID / 8) + bx / 8; }
    F.ws = A.ws;
    if (gridDim.x != GRID) return;
    for (int u = threadIdx.x; u < (LDS_BYTES - LDSCTL_OFF) / 4; u += NWAVES * 64) ((LAS unsigned*)(F.lds + LDSCTL_OFF))[u] = 0u;
    __syncthreads();
    const int lo = A.ph_lo, hi = A.ph_hi;
    const bool single = (hi - lo) > 1;
    XcdBarrier bar; bar.wave = F.wave; bar.bar = (unsigned*)(F_CTL + CW_BAR); bar.x = 0; bar.st = nullptr;
    if (single) { bar = xcd_barrier_post((unsigned*)(F_CTL + CW_BAR), F_MISC + 8); bar.wave = F.wave; }
    int ph = 0;
#ifdef MK_TIME_SITE
#ifdef MK_TIME_CLK
#define MK_NOW() __builtin_amdgcn_s_memtime()
#else
#define MK_NOW() __builtin_amdgcn_s_memrealtime()
#endif
#define PH_T0 const unsigned long long tph0 = MK_NOW(); (void)tph0;
    unsigned long long tsum = 0;
#else
#define PH_T0
#endif
#ifndef MK_DOUBLE
#define MK_DOUBLE (-99)
#endif
#define NREP(site) (((site) == (MK_DOUBLE)) ? 2 : 1)
#define PH_BEGIN(site) if (ph >= lo && ph < hi) { for (int rep_ = 0; rep_ < NREP(site); ++rep_) { asm volatile("" : "+s"(F.wave), "+s"(F.vcu), "+s"(F.lds)); unsigned char* const ws = lws(F.ws); float* const OUT = (float*)lptr(A.out); const int gw = F.vcu * NWAVES + F.wave, NGW = F_G * NWAVES; (void)ws; (void)OUT; (void)gw; (void)NGW; PH_T0
#ifdef MK_TIME_SITE
#define PH_END(site)   if (rep_ + 1 < NREP(site) || ph + 1 < hi) xcd_barrier(bar); if ((site) == (MK_TIME_SITE) || (MK_TIME_SITE) < 0) tsum += MK_NOW() - tph0; } } ++ph;
#else
#define PH_END(site)   if (rep_ + 1 < NREP(site) || ph + 1 < hi) xcd_barrier(bar); } } ++ph;
#endif

    PH_BEGIN(0) p0_prologue(F, A); PH_END(0)

    for (int lc = 0; lc < DEPTH * NCHUNK; ++lc) {
        const int l = lc >> 1, c = lc & 1;
        const size_t tok0 = (size_t)c * TC;
        const float lam_init = (l == 0) ? 0.2f : 0.35550906758f;

        PH_BEGIN(1)
            {
                pg8::Gemm g{XB + tok0 * D, (const bf16*)(ws + WS_WIN), TC, 5120, D}; pg8::StaticOrder S; S.init(TC, 5120, F_G, F_BX);
                pg8::EpiP1 E{ws, (int)tok0};
                pg8::gemm_phase<pg8::EpiP1, pg8::StaticOrder, true, true>(F.lds + RING_OFF, g, S, E, F.wave);
            }
            __syncthreads();
            {
                pg8::GateOrder S; S.so.init(TC, 3072, F_G, F_BX); S.X8 = (const char*)(ws + WS_XBIN8) + tok0 * D; S.W8 = (const char*)(ws + WS_WING8);
                pg8::EpiGates8 E{(unsigned char*)Gb};
                pg8::gemm_phase2<pg8::EpiGates8, pg8::GateOrder, true>(F.lds + RING_OFF, S, E, F.wave);
            }
            if (lc == 0) {
                __syncthreads();
                pg8::Gemm g{(const bf16*)(ws + WS_MEMB), (const bf16*)(ws + WS_WKV), NB * MEML, 2048, D}; pg8::StaticOrder S; S.init(NB * MEML, 2048, F_G, F_BX);
                pg8::EpiBf16<0> E{(bf16*)(ws + WS_MEMKV), 2048, nullptr, 0, 0, 1.f};
                pg8::gemm_phase<pg8::EpiBf16<0>, pg8::StaticOrder, true, true>(F.lds + RING_OFF, g, S, E, F.wave);
            }
        PH_END(1)

        PH_BEGIN(2)
            {
                const float a1 = wave_sum(INF(4)[l * 64 + F_LANE] * INF(5)[l * 64 + F_LANE]), a2 = wave_sum(INF(6)[l * 64 + F_LANE] * INF(7)[l * 64 + F_LANE]);
                const float lam = expf(a1) - expf(a2) + lam_init;
                const dattn::DiffTensors AT{(const dattn::bf16*)Qb, (const dattn::bf16*)Kb, (const dattn::bf16*)Vb, (dattn::bf16*)O1b, (dattn::bf16*)O2b, (dattn::bf16*)YATT, INF(8) + l * 128, lam, 1.0f - lam_init};
#if MK_FUSEC
                dattn::diff_attn_phase<8>((char*)lds + RING_OFF, AT, F.vcu, F.wave);
#else
                dattn::diff_attn_phase_sep<8>((char*)lds + RING_OFF, AT, F.vcu, F.wave);
#endif
            }
            __syncthreads();
            if (rep_ == 0) { const int v = F.vcu; memattn::unit(c * BPC + (v >> 7), v >> 7, (v >> 5) & 3, v & 31, QMb, MEMKV + l * 1024, 2048, F.lds + RING_OFF, F.wave); }
            if (rep_ == 0) {
                const int L = F_LANE;
                float cw0[8], cw1[8], cw2[8];
#pragma unroll
                for (int j = 0; j < 8; ++j) { cw0[j] = INF(9)[(l * 3 + 0) * 512 + 8 * L + j]; cw1[j] = INF(9)[(l * 3 + 1) * 512 + 8 * L + j]; cw2[j] = INF(9)[(l * 3 + 2) * 512 + 8 * L + j]; }
                v4u z0[8], z1[8], z2[8], cbv[8];
#pragma unroll
                for (int i = 0; i < 8; ++i) { const int r = gw * 8 + i, s = r & (SEQ - 1);
                    z0[i] = *(const v4u*)(Zb + (size_t)r * 512 + 8 * L); z1[i] = (v4u){0u, 0u, 0u, 0u}; z2[i] = (v4u){0u, 0u, 0u, 0u};
                    if (s >= 1) z1[i] = *(const v4u*)(Zb + (size_t)(r - 1) * 512 + 8 * L);
                    if (s >= 2) z2[i] = *(const v4u*)(Zb + (size_t)(r - 2) * 512 + 8 * L);
                    cbv[i] = *(const v4u*)(CBb + (size_t)r * 512 + 8 * L); }
#pragma unroll
                for (int i = 0; i < 8; ++i) { const int r = gw * 8 + i;
                    const unsigned z0w[4] = {z0[i].x, z0[i].y, z0[i].z, z0[i].w}, z1w[4] = {z1[i].x, z1[i].y, z1[i].z, z1[i].w}, z2w[4] = {z2[i].x, z2[i].y, z2[i].z, z2[i].w}, cbw[4] = {cbv[i].x, cbv[i].y, cbv[i].z, cbv[i].w};
                    unsigned ow[4];
#pragma unroll
                    for (int j = 0; j < 4; ++j) {
                        const float ylo = bfl(cbw[j]) * (cw0[2 * j] * bfl(z2w[j]) + cw1[2 * j] * bfl(z1w[j]) + cw2[2 * j] * bfl(z0w[j]));
                        const float yhi = bfh(cbw[j]) * (cw0[2 * j + 1] * bfh(z2w[j]) + cw1[2 * j + 1] * bfh(z1w[j]) + cw2[2 * j + 1] * bfh(z0w[j]));
                        ow[j] = pk2(ylo, yhi); }
                    *(v4u*)(CBb + (size_t)r * 512 + 8 * L) = (v4u){ow[0], ow[1], ow[2], ow[3]}; }
                if (c == 0) { const int gt = F.vcu * (NWAVES * 64) + F_TID; int m1_ = -1, z_ = 0; asm volatile("" : "+v"(m1_), "+v"(z_)); for (int i = gt; i < NE * CAP; i += F_G * NWAVES * 64) ((v2i*)ROWINFO)[i] = (v2i){m1_, z_}; }
            }
        PH_END(2)

#if !MK_FUSEC
        PH_BEGIN(3)
            {
                const float a1 = wave_sum(INF(4)[l * 64 + F_LANE] * INF(5)[l * 64 + F_LANE]), a2 = wave_sum(INF(6)[l * 64 + F_LANE] * INF(7)[l * 64 + F_LANE]);
                const float lam = expf(a1) - expf(a2) + lam_init, osc = 1.0f - lam_init;
                const int L = F_LANE;
                float gs[16];
#pragma unroll
                for (int j = 0; j < 16; ++j) gs[j] = INF(8)[l * 128 + ((16 * L + j) & 127)] * osc;
                for (int r0 = gw; r0 < TC; r0 += 8 * NGW) {
                    v4u a0[8], a1v[8], b0[8], b1v[8];
#pragma unroll
                    for (int q = 0; q < 8; ++q) { const size_t r = (size_t)r0 + (size_t)q * NGW;
                        a0[q] = *(const v4u*)(O1b + r * 1024 + 16 * L); a1v[q] = *(const v4u*)(O1b + r * 1024 + 16 * L + 8); b0[q] = *(const v4u*)(O2b + r * 1024 + 16 * L); b1v[q] = *(const v4u*)(O2b + r * 1024 + 16 * L + 8); }
#pragma unroll
                    for (int q = 0; q < 8; ++q) { const size_t r = (size_t)r0 + (size_t)q * NGW;
                        const unsigned aw[8] = {a0[q].x, a0[q].y, a0[q].z, a0[q].w, a1v[q].x, a1v[q].y, a1v[q].z, a1v[q].w}, bw[8] = {b0[q].x, b0[q].y, b0[q].z, b0[q].w, b1v[q].x, b1v[q].y, b1v[q].z, b1v[q].w};
                        float o[16]; float ss = 0.f;
#pragma unroll
                        for (int j = 0; j < 8; ++j) { o[2 * j] = bfl(aw[j]) - lam * bfl(bw[j]); o[2 * j + 1] = bfh(aw[j]) - lam * bfh(bw[j]); ss += o[2 * j] * o[2 * j] + o[2 * j + 1] * o[2 * j + 1]; }
                        ss += pg8::shx<1>(ss); ss += pg8::shx<2>(ss); ss += pg8::shx<4>(ss);
                        const float rs = 1.0f / sqrtf(ss * (1.0f / 128.0f) + RMS_EPS);
                        v4u w0, w1;
                        w0.x = pk2(o[0] * rs * gs[0], o[1] * rs * gs[1]); w0.y = pk2(o[2] * rs * gs[2], o[3] * rs * gs[3]); w0.z = pk2(o[4] * rs * gs[4], o[5] * rs * gs[5]); w0.w = pk2(o[6] * rs * gs[6], o[7] * rs * gs[7]);
                        w1.x = pk2(o[8] * rs * gs[8], o[9] * rs * gs[9]); w1.y = pk2(o[10] * rs * gs[10], o[11] * rs * gs[11]); w1.z = pk2(o[12] * rs * gs[12], o[13] * rs * gs[13]); w1.w = pk2(o[14] * rs * gs[14], o[15] * rs * gs[15]);
                        *(v4u*)(YATT + r * 1024 + 16 * L) = w0; *(v4u*)(YATT + r * 1024 + 16 * L + 8) = w1; }
                }
            }
        PH_END(3)
#endif

        PH_BEGIN(4)
            {
                pg8::BranchOrder S; S.so.init(TC, D, F_G, F_BX); S.ws = (const char*)ws;
                pg8::EpiGate3 E{c == 0 ? (bf16*)(ws + WS_MERGED0) : MERGED, (const unsigned char*)Gb};
                pg8::gemm_phase2<pg8::EpiGate3, pg8::BranchOrder>(F.lds + RING_OFF, S, E, F.wave);
            }
        PH_END(4)


        if (c == NCHUNK - 1) {
            PH_BEGIN(5)
            {
                pg8::OutOrder S; S.so.init(T, D, F_G, F_BX); S.ws = (const char*)ws;
                pg8::EpiMixAll E{(bf16*)(ws + WS_MIXALL)};
                pg8::gemm_phase2<pg8::EpiMixAll, pg8::OutOrder>(F.lds + RING_OFF, S, E, F.wave);
            }
            PH_END(5)

            PH_BEGIN(6)
            {
                LAS unsigned* lcnt = (LAS unsigned*)(F.lds + RING_OFF);
                LAS unsigned* rec = (LAS unsigned*)(F.lds + RING_OFF + 256);
                if (F_TID < 32) lcnt[F_TID] = 0u;
                __syncthreads();
                const float* xin = INF(0);
                const float* g1 = INF(15) + l * D; const float* b1 = INF(16) + l * D;
                const int rbase = gw * 16;
                const bf16* mixb = (const bf16*)(ws + WS_MIXALL) + (size_t)rbase * D;
                f32x4 gg4[4], bb4[4];
#pragma unroll
                for (int j = 0; j < 4; ++j) { gg4[j] = *((const GAS f32x4*)g1 + F_LANE + 64 * j); bb4[j] = *((const GAS f32x4*)b1 + F_LANE + 64 * j); }
                f32x4 xvA[2][4], xvB[2][4]; unsigned long long mwA[2][4], mwB[2][4];
#define F_LD(X_, M_, k_) do { _Pragma("unroll") for (int q = 0; q < 2; ++q) { const size_t t = (size_t)rbase + (k_) + q; \
                        const GAS unsigned long long* mr = (const GAS unsigned long long*)(mixb + (size_t)((k_) + q) * D) + F_LANE; \
                        if (l == 0) { const GAS f32x4* xr = (const GAS f32x4*)(xin + t * D) + F_LANE; \
                            _Pragma("unroll") for (int j = 0; j < 4; ++j) X_[q][j] = xr[64 * j]; } \
                        else { const GAS unsigned long long* xr = (const GAS unsigned long long*)(XB + t * D) + F_LANE; \
                            _Pragma("unroll") for (int j = 0; j < 4; ++j) { const unsigned long long w = xr[64 * j]; const unsigned w0 = (unsigned)w, w1 = (unsigned)(w >> 32); X_[q][j] = (f32x4){bfl(w0), bfh(w0), bfl(w1), bfh(w1)}; } } \
                        _Pragma("unroll") for (int j = 0; j < 4; ++j) M_[q][j] = mr[64 * j]; } } while (0)
#define F_CS(X_, M_, k_) do { _Pragma("unroll") for (int q = 0; q < 2; ++q) { const size_t t = (size_t)rbase + (k_) + q; \
                        f32x4 v[4]; float sm = 0.f; \
                        _Pragma("unroll") for (int j = 0; j < 4; ++j) { const f32x4 x4 = X_[q][j]; const unsigned m0 = (unsigned)M_[q][j], m1 = (unsigned)(M_[q][j] >> 32); \
                            v[j] = (f32x4){ALPHA * x4.x + bfl(m0), ALPHA * x4.y + bfh(m0), ALPHA * x4.z + bfl(m1), ALPHA * x4.w + bfh(m1)}; sm += (v[j].x + v[j].y) + (v[j].z + v[j].w); } \
                        const float mean = wave_sum(sm) * (1.f / D); float s2 = 0.f; \
                        _Pragma("unroll") for (int j = 0; j < 4; ++j) { v[j] = v[j] - mean; s2 += (v[j].x * v[j].x + v[j].y * v[j].y) + (v[j].z * v[j].z + v[j].w * v[j].w); } \
                        const float rstd = 1.f / sqrtf(wave_sum(s2) * (1.f / D) + LN_EPS); \
                        GAS unsigned long long* o8 = (GAS unsigned long long*)(XB + t * D) + F_LANE; GAS unsigned* x8 = (GAS unsigned*)(ws + WS_XB8 + t * D) + F_LANE; \
                        _Pragma("unroll") for (int j = 0; j < 4; ++j) { const f32x4 y = v[j] * rstd * gg4[j] + bb4[j]; o8[64 * j] = (unsigned long long)pk2(y.x, y.y) | ((unsigned long long)pk2(y.z, y.w) << 32); x8[64 * j] = pg8::pk4_fp8(y.x, y.y, y.z, y.w); } } } while (0)
                F_LD(xvA, mwA, 0);
                for (int k = 0; k < 16; k += 4) {
                    F_LD(xvB, mwB, k + 2); F_CS(xvA, mwA, k);
                    if (k + 4 < 16) F_LD(xvA, mwA, k + 4);
                    F_CS(xvB, mwB, k + 2);
                }
#undef F_LD
#undef F_CS
                asm volatile("s_waitcnt vmcnt(0)" ::: "memory");
                {
                    const int tt = F_LANE & 15, kg = F_LANE >> 4; const size_t t = (size_t)rbase + tt;
                    const bf16* yrow = XB + t * D + 8 * kg; const bf16* WRH = (const bf16*)(ws + WS_WRH) + F_LANE * 8; const bf16* WRL = (const bf16*)(ws + WS_WRL) + F_LANE * 8;
                    f32x4 acc = (f32x4){0.f, 0.f, 0.f, 0.f};
#pragma unroll 8
                    for (int ks = 0; ks < 32; ++ks) {
                        const bf16x8 yb = __builtin_bit_cast(bf16x8, __builtin_nontemporal_load((const v4u*)(yrow + 32 * ks)));
                        const bf16x8 wh = *(const bf16x8*)(WRH + ks * 512), wl = *(const bf16x8*)(WRL + ks * 512);
                        acc = __builtin_amdgcn_mfma_f32_16x16x32_bf16(wh, yb, acc, 0, 0, 0);
                        acc = __builtin_amdgcn_mfma_f32_16x16x32_bf16(wl, yb, acc, 0, 0, 0);
                    }
                    float lg[4];
#pragma unroll
                    for (int j = 0; j < 4; ++j) lg[j] = acc[j] + INF(20)[4 * kg + j];
                    int a1i = 0; float l1 = lg[0];
#pragma unroll
                    for (int j = 1; j < 4; ++j) if (lg[j] > l1) { l1 = lg[j]; a1i = j; }
                    int a2i = -1; float l2 = -INFINITY;
#pragma unroll
                    for (int j = 0; j < 4; ++j) if (j != a1i && lg[j] > l2) { l2 = lg[j]; a2i = j; }
                    bool win = true;
#pragma unroll
                    for (int x = 1; x < 4; ++x) { const float om = (x == 1) ? pg8::shx<16>(l1) : (x == 2) ? pg8::shx<32>(l1) : pg8::shx<48>(l1); const int og = kg ^ x; if (om > l1 || (om == l1 && og < kg)) win = false; }
                    if (win) {
                        const int e1 = 4 * kg + a1i, e2 = 4 * kg + a2i; const float ex = expf(l2 - l1), w1 = 1.0f / (1.0f + ex), w2 = ex / (1.0f + ex);
                        const unsigned p1 = atomicAdd((unsigned*)&lcnt[e1], 1u), p2 = atomicAdd((unsigned*)&lcnt[e2], 1u);
                        LAS unsigned* rc = rec + (F.wave * 16 + tt) * 6; rc[0] = (unsigned)e1; rc[1] = p1; rc[2] = (unsigned)e2; rc[3] = p2; rc[4] = __float_as_uint(w1); rc[5] = __float_as_uint(w2);
                    }
                }
                __syncthreads();
                if (F_TID < 16) lcnt[16 + F_TID] = __hip_atomic_fetch_add(F_CTL + CW_CNT + (l * 16 + F_TID) * 64, lcnt[F_TID], __ATOMIC_RELAXED, __HIP_MEMORY_SCOPE_AGENT);
                __syncthreads();
                if (F_TID < 128) { const LAS unsigned* rc = rec + F_TID * 6; const size_t t = (size_t)(F.vcu * NWAVES + (F_TID >> 4)) * 16 + (F_TID & 15);
                    const unsigned r1 = rc[0] * (unsigned)CAP + lcnt[16 + rc[0]] + rc[1], r2 = rc[2] * (unsigned)CAP + lcnt[16 + rc[2]] + rc[3];
                    ((v2i*)ROWINFO)[r1] = (v2i){(int)(2 * t), (int)rc[4]}; ((v2i*)ROWINFO)[r2] = (v2i){(int)(2 * t + 1), (int)rc[5]}; }
                __syncthreads();
            }
            PH_END(6)


            PH_BEGIN(8)
                {
                    LAS int* tile_e = (LAS int*)(F.lds + TILEE_OFF); LAS int* tile_r = (LAS int*)(F.lds + TILER_OFF);
                    if (F_TID == 0) { unsigned a = 0;
#pragma unroll 1
                        for (int e_ = 0; e_ < NE; ++e_) { int e = e_; asm volatile("" : "+s"(e));
                            const unsigned n = __hip_atomic_load(F_CTL + CW_CNT + (l * 16 + e) * 64, __ATOMIC_RELAXED, __HIP_MEMORY_SCOPE_AGENT); const unsigned nt = (n + 255u) >> 8;
                            for (unsigned i = 0; i < nt; ++i) { tile_e[a + i] = e; tile_r[a + i] = e * CAP + (int)i * 256; } a += nt; } tile_e[MAXTILES] = (int)a; }
                    __syncthreads();
                    pg8::MoeGatherOrder S{tile_e[MAXTILES], F.vcu, F_G, tile_e, tile_r, ROWINFO, (const char*)(ws + WS_XB8), (const char*)(ws + WS_WGU)};
                    pg8::EpiSwiglu8 E{(unsigned char*)Hb};
                    pg8::gemm_phase2<pg8::EpiSwiglu8, pg8::MoeGatherOrder, true>(F.lds + RING_OFF, S, E, F.wave);
                }
            PH_END(8)

            PH_BEGIN(9)
                {
                    LAS int* tile_e = (LAS int*)(F.lds + TILEE_OFF); LAS int* tile_r = (LAS int*)(F.lds + TILER_OFF);
                    __syncthreads();
                    if (F_TID == 0) { unsigned a = 0;
#pragma unroll 1
                        for (int e_ = 0; e_ < NE; ++e_) { int e = e_; asm volatile("" : "+s"(e));
                            const unsigned n = __hip_atomic_load(F_CTL + CW_CNT + (l * 16 + e) * 64, __ATOMIC_RELAXED, __HIP_MEMORY_SCOPE_AGENT); const unsigned nt = (n + 255u) >> 8;
                            for (unsigned i = 0; i < nt; ++i) { tile_e[a + i] = e; tile_r[a + i] = e * CAP + (int)i * 256; } a += nt; } tile_e[MAXTILES] = (int)a; }
                    __syncthreads();
                    pg8::MoeDownOrder S{tile_e[MAXTILES], F.vcu, F_G, tile_e, (const char*)Hb, (const char*)(ws + WS_WD)};
                    pg8::EpiScatter8 E{YC, ROWINFO, tile_r};
                    pg8::gemm_phase2<pg8::EpiScatter8, pg8::MoeDownOrder, true>(F.lds + RING_OFF, S, E, F.wave);
                }
            PH_END(9)

            PH_BEGIN(10)
                {
                    const float* g2 = INF(17) + l * D; const float* b2 = INF(18) + l * D;
                    f32x4 gg4[4], bb4[4];
#pragma unroll
                    for (int j = 0; j < 4; ++j) { gg4[j] = *((const GAS f32x4*)g2 + F_LANE + 64 * j); bb4[j] = *((const GAS f32x4*)b2 + F_LANE + 64 * j); }
                    unsigned long long xvA[2][4], yaA[2][4], ybA[2][4], xvB[2][4], yaB[2][4], ybB[2][4];
#define J_LD(X_, YA_, YB_, k_) do { _Pragma("unroll") for (int q = 0; q < 2; ++q) { const size_t t = (size_t)gw + (size_t)((k_) + q) * NGW; \
                            const GAS unsigned long long* xr = (const GAS unsigned long long*)(XB + t * D) + F_LANE; \
                            const GAS unsigned long long* y0 = (const GAS unsigned long long*)(YC + (2 * t) * D) + F_LANE; const GAS unsigned long long* y1 = (const GAS unsigned long long*)(YC + (2 * t + 1) * D) + F_LANE; \
                            _Pragma("unroll") for (int j = 0; j < 4; ++j) { X_[q][j] = xr[64 * j]; YA_[q][j] = y0[64 * j]; YB_[q][j] = y1[64 * j]; } } } while (0)
#define J_CS(X_, YA_, YB_, k_) do { _Pragma("unroll") for (int q = 0; q < 2; ++q) { const size_t t = (size_t)gw + (size_t)((k_) + q) * NGW; \
                            f32x4 v[4]; float sm = 0.f; \
                            _Pragma("unroll") for (int j = 0; j < 4; ++j) { const unsigned x0 = (unsigned)X_[q][j], x1 = (unsigned)(X_[q][j] >> 32); const f32x4 x4 = (f32x4){bfl(x0), bfh(x0), bfl(x1), bfh(x1)}; \
                                const unsigned a0 = (unsigned)YA_[q][j], a1 = (unsigned)(YA_[q][j] >> 32), b0 = (unsigned)YB_[q][j], b1 = (unsigned)(YB_[q][j] >> 32); \
                                v[j] = (f32x4){ALPHA * x4.x + (bfl(a0) + bfl(b0)), ALPHA * x4.y + (bfh(a0) + bfh(b0)), ALPHA * x4.z + (bfl(a1) + bfl(b1)), ALPHA * x4.w + (bfh(a1) + bfh(b1))}; sm += (v[j].x + v[j].y) + (v[j].z + v[j].w); } \
                            const float mean = wave_sum(sm) * (1.f / D); float s2 = 0.f; \
                            _Pragma("unroll") for (int j = 0; j < 4; ++j) { v[j] = v[j] - mean; s2 += (v[j].x * v[j].x + v[j].y * v[j].y) + (v[j].z * v[j].z + v[j].w * v[j].w); } \
                            const float rstd = 1.f / sqrtf(wave_sum(s2) * (1.f / D) + LN_EPS); \
                            GAS f32x4* xw = (GAS f32x4*)(OUT + t * D) + F_LANE; GAS unsigned long long* o8 = (GAS unsigned long long*)(XB + t * D) + F_LANE; \
                            _Pragma("unroll") for (int j = 0; j < 4; ++j) { const f32x4 y = v[j] * rstd * gg4[j] + bb4[j]; if (l + 1 < DEPTH) { o8[64 * j] = (unsigned long long)pk2(y.x, y.y) | ((unsigned long long)pk2(y.z, y.w) << 32); ((GAS unsigned*)(ws + WS_XBIN8 + t * D) + F_LANE)[64 * j] = pg8::pk4_fp8(y.x, y.y, y.z, y.w); } else xw[64 * j] = y; } } } while (0)
                    static_assert(T == 16 * GRID * NWAVES, "16 rows per wave");
                    J_LD(xvA, yaA, ybA, 0);
                    for (int k = 0; k < 16; k += 4) {
                        J_LD(xvB, yaB, ybB, k + 2); J_CS(xvA, yaA, ybA, k);
                        if (k + 4 < 16) J_LD(xvA, yaA, ybA, k + 4);
                        J_CS(xvB, yaB, ybB, k + 2);
                    }
#undef J_LD
#undef J_CS
                    if (l + 1 < DEPTH) convert_layer_weights(F, A, l + 1);
                }
            PH_END(10)
        }
    }
#undef PH_BEGIN
#undef PH_END
#ifdef MK_TIME_SITE
    {
#ifdef MK_GPROBE
        tsum += *(LAS unsigned*)(F.lds + LDSCTL_OFF + 3584);
#endif
#ifdef MK_TIME_CLK
        tsum /= 16;
#endif
        if (blockIdx.x == 0) { const unsigned long long t_end = __builtin_amdgcn_s_memrealtime() + tsum * (unsigned long long)(MK_TIME_MULT);
            while (__builtin_amdgcn_s_memrealtime() < t_end) __builtin_amdgcn_s_sleep(20); }
    }
#endif
}

__global__ void dump_bf16_kernel(const unsigned char* ws, size_t off, float* out) {
    const bf16* src = (const bf16*)(ws + off); const size_t n = (size_t)T * D;
#ifndef MK_DUMP_N
#define MK_DUMP_N n
#endif
    for (size_t i = (size_t)blockIdx.x * blockDim.x + threadIdx.x; i < n; i += (size_t)gridDim.x * blockDim.x) out[i] = i < (size_t)(MK_DUMP_N) ? __uint_as_float((unsigned)src[i] << 16) : 0.f;
}
constexpr int N_PHASES = 1 + DEPTH * (NCHUNK * (MK_FUSEC ? 3 : 4) + 5);
#ifndef MK_PER_PHASE
#define MK_PER_PHASE 0
#endif
extern "C" void kernel_launch(void* const* d_in, const int* in_sizes, int n_in, void* d_out, int out_size, void* d_ws, size_t ws_size, hipStream_t stream) {
    static int grid = 0;
    if (grid == 0) {
        if (n_in != 24 || in_sizes[0] != T * D || out_size != T * D || ws_size < WS_END) { fprintf(stderr, "kernel_launch: unexpected shapes / workspace (n_in %d, in0 %d, out %d, ws %zu); nothing launched\n", n_in, n_in > 0 ? in_sizes[0] : -1, out_size, ws_size); grid = -1; return; }
        int dev = 0, cus = 0, per_cu = 0;
        if (hipGetDevice(&dev) != hipSuccess || hipDeviceGetAttribute(&cus, hipDeviceAttributeMultiprocessorCount, dev) != hipSuccess) { grid = -1; return; }
        if (hipFuncSetAttribute((const void*)mega_fwd, hipFuncAttributeMaxDynamicSharedMemorySize, LDS_BYTES) != hipSuccess) { fprintf(stderr, "kernel_launch: hipFuncSetAttribute failed\n"); grid = -1; return; }
        if (hipOccupancyMaxActiveBlocksPerMultiprocessor(&per_cu, (const void*)mega_fwd, NWAVES * 64, LDS_BYTES) != hipSuccess || per_cu < 1) { fprintf(stderr, "kernel_launch: occupancy query says %d blocks per CU\n", per_cu); }
        (void)hipGetLastError();
        if (cus != GRID) { fprintf(stderr, "kernel_launch: built for %d CUs, device has %d; nothing launched\n", GRID, cus); grid = -1; return; }
        grid = cus;
    }
    if (grid < 0) return;
    if (hipMemsetAsync((char*)d_ws + WS_CTL, 0, CTL_ZERO_BYTES, stream) != hipSuccess) return;
    Args a{};
    for (int i = 0; i < 24; ++i) a.in[i] = d_in[i];
    a.out = (float*)d_out; a.ws = (unsigned char*)d_ws;
#ifndef MK_STOP
#define MK_STOP N_PHASES
#endif
#if MK_PER_PHASE
    for (int p = 0; p < MK_STOP; ++p) { a.ph_lo = p; a.ph_hi = p + 1; hipLaunchKernelGGL(mega_fwd, dim3(grid), dim3(NWAVES * 64), LDS_BYTES, stream, a); }
#ifdef MK_DUMP_OFF
    hipLaunchKernelGGL(dump_bf16_kernel, dim3(2048), dim3(256), 0, stream, (const unsigned char*)d_ws, (size_t)(MK_DUMP_OFF), (float*)d_out);
#endif
#else
    a.ph_lo = 0; a.ph_hi = N_PHASES;
    hipLaunchKernelGGL(mega_fwd, dim3(grid), dim3(NWAVES * 64), LDS_BYTES, stream, a);
#endif
}
```
